# Optimizing an MI355X kernel written in HIP

```python
import math
import jax
import jax.numpy as jnp
from jax import lax
import numpy as np

D_MODEL = 1024
BATCH = 4
SEQ = 8192
DEPTH = 1

GRID_W = 64
CTX_LEN = 256
NA_HEADS = 8
NA_HEAD_DIM = 64
NA_WIDTH = NA_HEADS * NA_HEAD_DIM
NA_KH = 8
NA_KW = 16
DN_HEADS = 8
DN_DK = 64
DN_DV = 64
DN_QK_W = DN_HEADS * DN_DK
DN_WIDTH = DN_HEADS * DN_DV
DN_CONV_W = 2 * DN_QK_W + DN_WIDTH
DN_CHUNK = 64
CONV_K = 3
ROPE_BASE = 10000.0
EPS = 1e-6
PROJ_WIDTH = 4 * NA_WIDTH + DN_CONV_W + DN_WIDTH + 4 * DN_HEADS + 2 * D_MODEL

kernel_name = 'hybrid_na_gdn_prefix_block'


def _rmsnorm(x, w):
    xf = x.astype(jnp.float32)
    y = xf * lax.rsqrt(jnp.mean(xf * xf, axis=-1, keepdims=True) + EPS)
    return (y * w.astype(jnp.float32)).astype(x.dtype)


def _l2norm(x):
    xf = x.astype(jnp.float32)
    return (xf * lax.rsqrt(jnp.sum(xf * xf, axis=-1, keepdims=True) + EPS)).astype(x.dtype)


def _heads(a, n_heads):
    return a.reshape(a.shape[:-1] + (n_heads, a.shape[-1] // n_heads))


def _rope_1d(x, pos):
    half = x.shape[-1] // 2
    freqs = ROPE_BASE ** (-jnp.arange(half, dtype=jnp.float32) / half)
    ang = pos.astype(jnp.float32)[:, None] * freqs[None, :]
    cos = jnp.concatenate([jnp.cos(ang), jnp.cos(ang)], -1)[None, :, None, :]
    sin = jnp.concatenate([jnp.sin(ang), jnp.sin(ang)], -1)[None, :, None, :]
    xf = x.astype(jnp.float32)
    rot = jnp.concatenate([-xf[..., half:], xf[..., :half]], -1)
    return (xf * cos + rot * sin).astype(x.dtype)


def _rope_2d(x, pos_row, pos_col):
    d = x.shape[-1] // 2
    return jnp.concatenate([_rope_1d(x[..., :d], pos_row), _rope_1d(x[..., d:], pos_col)], -1)


def _short_conv(x, w):
    return lax.conv_general_dilated(
        x, w.astype(x.dtype)[:, None, :], window_strides=(1,),
        padding=[(CONV_K // 2, CONV_K // 2)],
        dimension_numbers=('NWC', 'WIO', 'NWC'),
        feature_group_count=x.shape[-1])


def _split_proj(p):
    sizes = (NA_WIDTH, NA_WIDTH, NA_WIDTH, NA_WIDTH, DN_CONV_W, DN_WIDTH,
             2 * DN_HEADS, 2 * DN_HEADS, D_MODEL, D_MODEL)
    return jnp.split(p, np.cumsum(sizes)[:-1].tolist(), axis=-1)


def _na_latent(q, k, v, kc, vc, rpb):
    B, T, H, Dh = q.shape
    rows = T // GRID_W
    kh = min(NA_KH, rows)
    kg = k.reshape(B, rows, GRID_W, H, Dh)
    vg = v.reshape(B, rows, GRID_W, H, Dh)
    qg = q.reshape(B, rows, GRID_W, H, Dh)
    cq = jnp.arange(GRID_W)
    c0 = jnp.clip(cq - NA_KW // 2, 0, GRID_W - NA_KW)
    col_in = (cq[None, :] >= c0[:, None]) & (cq[None, :] < c0[:, None] + NA_KW)
    dx = jnp.clip(cq[None, :] - cq[:, None], -(NA_KW - 1), NA_KW - 1) + (NA_KW - 1)
    rpb_cols = rpb[:, :, dx]

    def row_step(args):
        r, q_r = args
        r0 = jnp.clip(r - kh // 2, 0, rows - kh)
        k_band = lax.dynamic_slice_in_dim(kg, r0, kh, axis=1)
        v_band = lax.dynamic_slice_in_dim(vg, r0, kh, axis=1)
        dy = r0 + jnp.arange(kh) - r + (NA_KH - 1)
        bias = jnp.take(rpb_cols, dy, axis=1).transpose(0, 2, 1, 3)
        s_win = jnp.einsum('bqhd,bywhd->bhqyw', q_r, k_band).astype(jnp.float32) + bias[None].astype(jnp.float32)
        s_win = jnp.where(col_in[:, None, :], s_win, -jnp.inf)
        s_ctx = jnp.einsum('bqhd,bchd->bhqc', q_r, kc).astype(jnp.float32)
        s = jnp.concatenate([s_win.reshape(B, H, GRID_W, kh * GRID_W), s_ctx], axis=-1)
        pr = jax.nn.softmax(s, axis=-1).astype(v.dtype)
        p_win = pr[..., :kh * GRID_W].reshape(B, H, GRID_W, kh, GRID_W)
        p_ctx = pr[..., kh * GRID_W:]
        return (jnp.einsum('bhqyw,bywhd->bqhd', p_win, v_band)
                + jnp.einsum('bhqc,bchd->bqhd', p_ctx, vc))

    o = lax.map(row_step, (jnp.arange(rows), jnp.moveaxis(qg, 1, 0)))
    return jnp.moveaxis(o, 0, 1).reshape(B, T, H, Dh)


def _dense_attention(q, k, v):
    s = jnp.einsum('bqhd,bkhd->bhqk', q, k).astype(jnp.float32)
    p = jax.nn.softmax(s, axis=-1).astype(v.dtype)
    return jnp.einsum('bhqk,bkhd->bqhd', p, v)


def _gdn_chunked(q, k, v, g, beta, s0):
    out_dtype = v.dtype
    f32 = jnp.float32
    B, T, H, DK = q.shape
    DV = v.shape[-1]
    C = DN_CHUNK
    N = T // C

    def blk(a):
        a = a.astype(f32).reshape((B, N, C, H) + a.shape[3:])
        return jnp.swapaxes(a, 2, 3)

    q, k, v, g, beta = blk(q), blk(k), blk(v), blk(g), blk(beta)
    gc = jnp.cumsum(g, axis=-1)
    incl = jnp.tril(jnp.ones((C, C), bool))
    strict = jnp.tril(jnp.ones((C, C), bool), -1)
    decay = jnp.exp(jnp.where(incl, gc[..., :, None] - gc[..., None, :], -jnp.inf))
    kb = k * beta[..., None]
    lower = jnp.where(strict, jnp.einsum('bnhid,bnhjd->bnhij', kb, k) * decay, 0.0)
    a_mat = lower + jnp.eye(C, dtype=f32)
    rhs = jnp.concatenate([v * beta[..., None], kb * jnp.exp(gc)[..., None]], axis=-1)
    sol = lax.linalg.triangular_solve(a_mat, rhs, left_side=True, lower=True, unit_diagonal=True)
    u, wk = sol[..., :DV], sol[..., DV:]
    qk = jnp.einsum('bnhid,bnhjd->bnhij', q, k) * decay
    q_dec = q * jnp.exp(gc)[..., None]
    k_dec = k * jnp.exp(gc[..., -1:] - gc)[..., None]
    g_tot = jnp.exp(gc[..., -1])

    def step(S, xs):
        qk_i, qd_i, kd_i, u_i, w_i, gt_i = xs
        v_new = u_i - jnp.einsum('bhck,bhkv->bhcv', w_i, S)
        o_i = jnp.einsum('bhck,bhkv->bhcv', qd_i, S) + jnp.einsum('bhij,bhjv->bhiv', qk_i, v_new)
        S = S * gt_i[..., None, None] + jnp.einsum('bhck,bhcv->bhkv', kd_i, v_new)
        return S, o_i

    xs = (jnp.moveaxis(qk, 1, 0), jnp.moveaxis(q_dec, 1, 0), jnp.moveaxis(k_dec, 1, 0),
          jnp.moveaxis(u, 1, 0), jnp.moveaxis(wk, 1, 0), jnp.moveaxis(g_tot, 1, 0))
    s_fin, o = lax.scan(step, s0.astype(f32), xs)
    o = jnp.transpose(o, (1, 0, 3, 2, 4)).reshape(B, T, H, DV)
    return o.astype(out_dtype), s_fin


def _dn_prepare(qkv_raw, b_raw, a_raw, w, pos):
    B, T, _ = qkv_raw.shape
    f32 = jnp.float32
    qkv = jax.nn.silu(_short_conv(qkv_raw, w['conv_w']))
    q, k, v = jnp.split(qkv, [DN_QK_W, 2 * DN_QK_W], axis=-1)
    q = _l2norm(_heads(q, DN_HEADS))
    k = _l2norm(_heads(k, DN_HEADS))
    v = _heads(v, DN_HEADS)
    if pos is not None:
        q = _rope_2d(q, pos[0], pos[1])
        k = _rope_2d(k, pos[0], pos[1])
    q = q * DN_DK ** -0.5
    beta = jax.nn.sigmoid(b_raw.astype(f32)).reshape(B, T, 2, DN_HEADS)
    g = -jnp.exp(w['dn_A_log'].astype(f32)) * jax.nn.softplus(
        a_raw.astype(f32).reshape(B, T, 2, DN_HEADS) + w['dn_dt_bias'].astype(f32))
    return q, k, v, beta, g


def _bidir_delta(q, k, v, beta, g, s0_f, s0_b):
    rev = lambda a: jnp.flip(a, axis=1)
    o_f, s_f = _gdn_chunked(q, k, v, g[:, :, 0], beta[:, :, 0], s0_f)
    o_b, s_b = _gdn_chunked(rev(q), rev(k), rev(v), rev(g[:, :, 1]), rev(beta[:, :, 1]), s0_b)
    return o_f + rev(o_b), s_f, s_b


def _merge(o_na, z_na, o_dn, z_dn, g_na, g_dn, w):
    B, T = o_na.shape[:2]
    u_na = (o_na.reshape(B, T, NA_WIDTH) * jax.nn.silu(z_na)) @ w['w_o_na']
    o_dn = _rmsnorm(o_dn, w['dn_norm_w']).reshape(B, T, DN_WIDTH)
    u_dn = (o_dn * jax.nn.silu(z_dn)) @ w['w_o_dn']
    y = jax.nn.sigmoid(g_na) * u_na + jax.nn.sigmoid(g_dn) * u_dn
    return y @ w['w_out']


def _layer(x, ctx, c, c_ctx, w, last):
    B, T, _ = x.shape
    t = jnp.arange(T)
    pos = (t // GRID_W, t % GRID_W)
    shift, scale, gate = jnp.split(jax.nn.silu(c) @ w['mod_w'] + w['mod_b'], 3, axis=-1)
    shift_c, scale_c, gate_c = jnp.split(jax.nn.silu(c_ctx) @ w['mod_w'] + w['mod_b'], 3, axis=-1)
    h = _rmsnorm(x, w['norm_w']) * (1.0 + scale[:, None]) + shift[:, None]
    hc = _rmsnorm(ctx, w['norm_w']) * (1.0 + scale_c) + shift_c
    na_q, na_k, na_v, na_z, dn_qkv, dn_z, dn_b, dn_a, g_na, g_dn = _split_proj(h @ w['w_in'])
    na_qc, na_kc, na_vc, na_zc, dn_qkvc, dn_zc, dn_bc, dn_ac, g_nac, g_dnc = _split_proj(hc @ w['w_in'])

    q = _rmsnorm(_heads(na_q, NA_HEADS), w['na_q_norm']) * NA_HEAD_DIM ** -0.5
    k = _rmsnorm(_heads(na_k, NA_HEADS), w['na_k_norm'])
    v = _heads(na_v, NA_HEADS)
    kc = _rmsnorm(_heads(na_kc, NA_HEADS), w['na_k_norm'])
    vc = _heads(na_vc, NA_HEADS)
    o_na = _na_latent(q, k, v, kc, vc, w['na_rpb'])

    dq, dk, dv, dbeta, dg = _dn_prepare(dn_qkv, dn_b, dn_a, w, pos)
    dqc, dkc, dvc, dbetac, dgc = _dn_prepare(dn_qkvc, dn_bc, dn_ac, w, None)
    zeros = jnp.zeros((ctx.shape[0], DN_HEADS, DN_DK, DN_DV), jnp.float32)
    o_dnc, s_f, s_b = _bidir_delta(dqc, dkc, dvc, dbetac, dgc, zeros, zeros)
    o_dn, _, _ = _bidir_delta(dq, dk, dv, dbeta, dg, s_f, s_b)

    x = x + gate[:, None] * _merge(o_na, na_z, o_dn, dn_z, g_na, g_dn, w)
    if not last:
        qc = _rmsnorm(_heads(na_qc, NA_HEADS), w['na_q_norm']) * NA_HEAD_DIM ** -0.5
        o_nac = _dense_attention(qc, kc, vc)
        ctx = ctx + gate_c * _merge(o_nac, na_zc, o_dnc, dn_zc, g_nac, g_dnc, w)
    return x, ctx


def setup_inputs(seed: int = 0) -> dict:
    key = jax.random.key(seed)
    ks = jax.random.split(key, 20)
    f32 = jnp.float32

    def nrm(k, shape, s):
        return jax.random.normal(k, shape, f32) * s

    x = nrm(ks[0], (BATCH, SEQ, D_MODEL), 1.0)
    c = nrm(ks[1], (BATCH, D_MODEL), 1.0)
    ctx = nrm(ks[2], (BATCH, CTX_LEN, D_MODEL), 1.0)
    c_ctx = nrm(ks[3], (D_MODEL,), 1.0)
    mod_w = nrm(ks[4], (DEPTH, D_MODEL, 3 * D_MODEL), 0.5 * D_MODEL ** -0.5)
    mod_b = nrm(ks[5], (DEPTH, 3 * D_MODEL), 0.01)
    norm_w = 1.0 + nrm(ks[6], (DEPTH, D_MODEL), 0.01)
    w_in = nrm(ks[7], (DEPTH, D_MODEL, PROJ_WIDTH), D_MODEL ** -0.5)
    conv_w = nrm(ks[8], (DEPTH, CONV_K, DN_CONV_W), CONV_K ** -0.5)
    na_q_norm = 1.0 + nrm(ks[9], (DEPTH, NA_HEAD_DIM), 0.01)
    na_k_norm = 1.0 + nrm(ks[10], (DEPTH, NA_HEAD_DIM), 0.01)
    na_rpb = nrm(ks[11], (DEPTH, NA_HEADS, 2 * NA_KH - 1, 2 * NA_KW - 1), 0.1)
    dn_A_log = jnp.log(jax.random.uniform(ks[12], (DEPTH, 2, DN_HEADS), f32, 1.0, 16.0))
    dt = jnp.exp(jax.random.uniform(ks[13], (DEPTH, 2, DN_HEADS), f32, math.log(1e-3), math.log(1e-1)))
    dn_dt_bias = dt + jnp.log(-jnp.expm1(-dt))
    dn_norm_w = 1.0 + nrm(ks[14], (DEPTH, DN_DV), 0.01)
    w_o_na = nrm(ks[15], (DEPTH, NA_WIDTH, D_MODEL), NA_WIDTH ** -0.5)
    w_o_dn = nrm(ks[16], (DEPTH, DN_WIDTH, D_MODEL), DN_WIDTH ** -0.5)
    w_out = nrm(ks[17], (DEPTH, D_MODEL, D_MODEL), D_MODEL ** -0.5)
    return {'x': x, 'c': c, 'ctx': ctx, 'c_ctx': c_ctx, 'mod_w': mod_w, 'mod_b': mod_b,
            'norm_w': norm_w, 'w_in': w_in, 'conv_w': conv_w, 'na_q_norm': na_q_norm,
            'na_k_norm': na_k_norm, 'na_rpb': na_rpb, 'dn_A_log': dn_A_log, 'dn_dt_bias': dn_dt_bias,
            'dn_norm_w': dn_norm_w, 'w_o_na': w_o_na, 'w_o_dn': w_o_dn, 'w_out': w_out}


def reference(x, c, ctx, c_ctx, mod_w, mod_b, norm_w, w_in, conv_w, na_q_norm, na_k_norm, na_rpb,
              dn_A_log, dn_dt_bias, dn_norm_w, w_o_na, w_o_dn, w_out):
    for l in range(DEPTH):
        w = {'mod_w': mod_w[l], 'mod_b': mod_b[l], 'norm_w': norm_w[l], 'w_in': w_in[l],
             'conv_w': conv_w[l], 'na_q_norm': na_q_norm[l], 'na_k_norm': na_k_norm[l],
             'na_rpb': na_rpb[l], 'dn_A_log': dn_A_log[l], 'dn_dt_bias': dn_dt_bias[l],
             'dn_norm_w': dn_norm_w[l], 'w_o_na': w_o_na[l], 'w_o_dn': w_o_dn[l], 'w_out': w_out[l]}
        x, ctx = _layer(x, ctx, c, c_ctx, w, l == DEPTH - 1)
    return x
```

```cpp
#include <hip/hip_runtime.h>
#include <hip/hip_cooperative_groups.h>
#include <cstdio>
#include <cstdint>
namespace cg = cooperative_groups;
namespace pg8 {
#define PG8_LAS __attribute__((address_space(3)))
typedef unsigned short bf16_t;
typedef short bf16x8 __attribute__((ext_vector_type(8)));
typedef float f32x4 __attribute__((ext_vector_type(4)));
typedef unsigned u32x4 __attribute__((ext_vector_type(4)));
constexpr int BM = 256, BK = 64, HALF = 128, HTB = HALF * BK * 2  , STAGE_BYTES = 8 * HTB, NXCD = 8, WGM = 8;

__host__ __device__ __forceinline__ int lds_byte(int r, int c) { const int st = (r >> 4) * 2 + (c >> 5), rr = r & 15, cc = c & 31, ob = rr * 64 + cc * 2; return st * 1024 + (ob ^ (((ob >> 9) & 1) << 5)); }
__host__ __device__ __forceinline__ void stage_rc(int b, int& R, int& C) { const int st = b / 1024, sb = b % 1024, swz = sb ^ (((sb >> 9) & 1) << 5); R = (st >> 1) * 16 + swz / 64; C = (st & 1) * 32 + (swz % 64) / 2; }
__host__ __device__ __forceinline__ int perm32(int rho) { const int n = rho >> 4, i = rho & 15; return 8 * (i >> 2) + 4 * n + (i & 3); }

struct Unit { int pm, pn; };
struct Gemm { const bf16_t* A; const bf16_t* Bt; int M, N, K; };

struct StaticOrder {
    int nM, nN, nwg, G, c;
    __host__ __device__ void init(int M, int N, int G_, int c_) { nM = M / BM; nN = N / BM; nwg = nM * nN; G = G_; c = c_; }
    __host__ __device__ bool next(int i, Unit& u) const {
        const long L = (long)i * G + c; if (L >= nwg) return false;
        int wgid = (int)L; { const int q = nwg / NXCD, r = nwg % NXCD, xcd = wgid % NXCD, off = wgid / NXCD; wgid = (xcd < r ? xcd * (q + 1) : r * (q + 1) + (xcd - r) * q) + off; }
        const int nig = WGM * nN, gid = wgid / nig, fm = gid * WGM, gsz = (nM - fm) < WGM ? (nM - fm) : WGM;
        u.pm = fm + ((wgid % nig) % gsz); u.pn = (wgid % nig) / gsz; return true;
    }
    __device__ __forceinline__ void a_ready(const Unit&) const {}
    __device__ __forceinline__ void done(const Unit&) const {}
};

__device__ __forceinline__ unsigned cvt_pk_bf16(float lo, float hi) { unsigned r; asm volatile("v_cvt_pk_bf16_f32 %0, %1, %2" : "=v"(r) : "v"(lo), "v"(hi)); return r; }
__device__ __forceinline__ float bflo(unsigned w) { return __builtin_bit_cast(float, w << 16); }
__device__ __forceinline__ float bfhi(unsigned w) { return __builtin_bit_cast(float, w & 0xffff0000u); }
__device__ __forceinline__ float sigmoidf_(float v) { return __builtin_amdgcn_rcpf(1.0f + __expf(-v)); }
constexpr size_t EPI_MiB = 1u << 20, EPI_BA = 18 * EPI_MiB, EPI_ZNA = 24 * EPI_MiB, EPI_ZDN = 56 * EPI_MiB, EPI_GNA = 88 * EPI_MiB, EPI_GDN = 152 * EPI_MiB, EPI_NAK = 216 * EPI_MiB, EPI_NAV = 249 * EPI_MiB, EPI_DNQKV = 282 * EPI_MiB;
struct EpiIn {
    static constexpr bool PERM = true, AFTER_DRAIN = false;
    unsigned char* ws; unsigned char* dout;
    __device__ __forceinline__ void operator()(const f32x4 (&acc)[2][2][4][2], const Unit& u, int wr, int wc, int fr, int fq) const {
        const int pn = u.pn; size_t boff; int ldc, colt, act = 0; bool latent_only = false; float* ba = (float*)(ws + EPI_BA);
        if (pn < 2) { boff = 0; ldc = 512; colt = pn * 256; latent_only = true; }
        else if (pn < 4) { boff = EPI_NAK; ldc = 512; colt = (pn - 2) * 256; }
        else if (pn < 6) { boff = EPI_NAV; ldc = 512; colt = (pn - 4) * 256; }
        else if (pn < 8) { boff = EPI_ZNA; ldc = 512; colt = (pn - 6) * 256; act = 2; latent_only = true; }
        else if (pn < 14) { boff = EPI_DNQKV; ldc = 1536; colt = (pn - 8) * 256; }
        else if (pn < 16) { boff = EPI_ZDN; ldc = 512; colt = (pn - 14) * 256; act = 2; latent_only = true; }
        else if (pn < 20) { boff = EPI_GNA; ldc = 1024; colt = (pn - 16) * 256; act = 1; latent_only = true; }
        else if (pn < 24) { boff = EPI_GDN; ldc = 1024; colt = (pn - 20) * 256; act = 1; latent_only = true; }
        else {
            if (wc == 0) {
#pragma unroll
                for (int ai = 0; ai < 2; ++ai)
#pragma unroll
                    for (int m = 0; m < 4; ++m) { float* rowp = ba + (size_t)(u.pm * BM + ai * HALF + wr * 64 + m * 16 + fr) * 32 + 8 * fq;
                        *(f32x4*)(rowp) = acc[ai][0][m][0]; *(f32x4*)(rowp + 4) = acc[ai][0][m][1]; }
            }
            return;
        }
        if (latent_only && u.pm >= 128) return;
        bf16_t* base = (pn < 2) ? (bf16_t*)dout : (bf16_t*)(ws + boff);
        const int row0 = u.pm * BM + wr * 64 + fr, col0 = colt + wc * 32 + 8 * fq;
#pragma unroll
        for (int ai = 0; ai < 2; ++ai)
#pragma unroll
            for (int m = 0; m < 4; ++m) { bf16_t* rowp = base + (size_t)(row0 + ai * HALF + m * 16) * ldc + col0;
#pragma unroll
                for (int bj = 0; bj < 2; ++bj) { f32x4 v0 = acc[ai][bj][m][0], v1 = acc[ai][bj][m][1];
                    if (act != 0) {
#pragma unroll
                        for (int e = 0; e < 4; ++e) { const float s0 = sigmoidf_(v0[e]), s1 = sigmoidf_(v1[e]); v0[e] = (act == 1) ? s0 : v0[e] * s0; v1[e] = (act == 1) ? s1 : v1[e] * s1; }
                    }
                    u32x4 w; w.x = cvt_pk_bf16(v0[0], v0[1]); w.y = cvt_pk_bf16(v0[2], v0[3]); w.z = cvt_pk_bf16(v1[0], v1[1]); w.w = cvt_pk_bf16(v1[2], v1[3]);
                    *(u32x4*)(rowp + bj * HALF) = w; } }
    }
};
template <int MODE> struct EpiGate {
    static constexpr bool PERM = true, AFTER_DRAIN = false;
    const bf16_t* G; const bf16_t* T1; bf16_t* O;
    __device__ __forceinline__ void operator()(const f32x4 (&acc)[2][2][4][2], const Unit& u, int wr, int wc, int fr, int fq) const {
        const int row0 = u.pm * BM + wr * 64 + fr, col0 = u.pn * BM + wc * 32 + 8 * fq;
#pragma unroll
        for (int ai = 0; ai < 2; ++ai)
#pragma unroll
            for (int m = 0; m < 4; ++m) { const size_t off = (size_t)(row0 + ai * HALF + m * 16) * 1024 + col0;
#pragma unroll
                for (int bj = 0; bj < 2; ++bj) { const f32x4 v0 = acc[ai][bj][m][0], v1 = acc[ai][bj][m][1];
                    const u32x4 g = *(const u32x4*)(G + off + bj * HALF);
                    float o[8] = { v0[0] * bflo(g.x), v0[1] * bfhi(g.x), v0[2] * bflo(g.y), v0[3] * bfhi(g.y), v1[0] * bflo(g.z), v1[1] * bfhi(g.z), v1[2] * bflo(g.w), v1[3] * bfhi(g.w) };
                    if (MODE == 1) { const u32x4 t = *(const u32x4*)(T1 + off + bj * HALF);
                        o[0] += bflo(t.x); o[1] += bfhi(t.x); o[2] += bflo(t.y); o[3] += bfhi(t.y); o[4] += bflo(t.z); o[5] += bfhi(t.z); o[6] += bflo(t.w); o[7] += bfhi(t.w); }
                    u32x4 w; w.x = cvt_pk_bf16(o[0], o[1]); w.y = cvt_pk_bf16(o[2], o[3]); w.z = cvt_pk_bf16(o[4], o[5]); w.w = cvt_pk_bf16(o[6], o[7]);
                    *(u32x4*)(O + off + bj * HALF) = w; } }
    }
};
struct EpiOut {
    static constexpr bool PERM = true, AFTER_DRAIN = false;
    const float* x; const float* modv; float* out;
    __device__ __forceinline__ void operator()(const f32x4 (&acc)[2][2][4][2], const Unit& u, int wr, int wc, int fr, int fq) const {
        const int row0 = u.pm * BM + wr * 64 + fr, col0 = u.pn * BM + wc * 32 + 8 * fq;
        const float* gp = modv + (size_t)(u.pm / 32) * 3072 + 2048 + col0;
        f32x4 gv[2][2];
#pragma unroll
        for (int bj = 0; bj < 2; ++bj)
#pragma unroll
            for (int n = 0; n < 2; ++n) gv[bj][n] = *(const f32x4*)(gp + bj * HALF + 4 * n);
#pragma unroll
        for (int ai = 0; ai < 2; ++ai)
#pragma unroll
            for (int m = 0; m < 4; ++m) { const size_t off = (size_t)(row0 + ai * HALF + m * 16) * 1024 + col0;
#pragma unroll
                for (int bj = 0; bj < 2; ++bj)
#pragma unroll
                    for (int n = 0; n < 2; ++n) { const f32x4 xv = *(const f32x4*)(x + off + bj * HALF + 4 * n);
                        *(f32x4*)(out + off + bj * HALF + 4 * n) = xv + gv[bj][n] * acc[ai][bj][m][n]; } }
    }
};
template <class Epi, class Sched, bool ALIGN_EPI = false, bool SP2 = false>
__device__ __forceinline__ void gemm_phase(PG8_LAS unsigned char* lds, const Gemm g, const Sched& S, const Epi& E) {
    const int tid = threadIdx.x, wid = __builtin_amdgcn_readfirstlane(tid >> 6), lane = tid & 63, wr = wid >> 2, wc = wid & 3, fr = lane & 15, fq = lane >> 4;
    const int K = g.K, nt = K / BK;
    unsigned voffA[2], voffB[2];
#pragma unroll
    for (int i = 0; i < 2; ++i) { int R, C; stage_rc(tid * 16 + i * 8192, R, C); const int Rb = Epi::PERM ? ((R & ~31) + perm32(R & 31)) : R;
        voffA[i] = (unsigned)(R * K + C) * 2u; voffB[i] = (unsigned)(Rb * K + C) * 2u; }
    const size_t kstep = (size_t)(BK * 2);
    const size_t hstep = (size_t)HALF * K * 2;
    const size_t tstep = 2 * hstep;
    const unsigned ldsw = (unsigned)wid * 1024u;
    const int aoff = lds_byte(wr * 64 + fr, fq * 8), boff = lds_byte(wc * 32 + fr, fq * 8);
#define PG8_SA(b, h) (((b) * 2 + (h)) * HTB)
#define PG8_SB(b, h) ((4 + (b) * 2 + (h)) * HTB)
#define PG8_STAGE(bufoff, gbase, voff) do { _Pragma("unroll") for (int _i = 0; _i < 2; ++_i) \
        __builtin_amdgcn_global_load_lds((const unsigned*)((const char*)(gbase) + (voff)[_i]), (PG8_LAS unsigned*)(lds + (bufoff) + ldsw + _i * 8192), 16, 0, 0); } while (0)
#define PG8_LDA(dst, b, h) do { _Pragma("unroll") for (int m = 0; m < 4; ++m) _Pragma("unroll") for (int k = 0; k < 2; ++k) dst[m][k] = *(const PG8_LAS bf16x8*)(lds + PG8_SA(b, h) + aoff + m * 2048 + k * 1024); } while (0)
#define PG8_LDB(dst, b, h) do { _Pragma("unroll") for (int n = 0; n < 2; ++n) _Pragma("unroll") for (int k = 0; k < 2; ++k) dst[n][k] = *(const PG8_LAS bf16x8*)(lds + PG8_SB(b, h) + boff + n * 2048 + k * 1024); } while (0)
#define PG8_MMA(ai, bj, At, Bt) do { __builtin_amdgcn_s_setprio(1); _Pragma("unroll") for (int m = 0; m < 4; ++m) _Pragma("unroll") for (int n = 0; n < 2; ++n) _Pragma("unroll") for (int k = 0; k < 2; ++k) \
        acc[ai][bj][m][n] = __builtin_amdgcn_mfma_f32_16x16x32_bf16(Bt[n][k], At[m][k], acc[ai][bj][m][n], 0, 0, 0); __builtin_amdgcn_s_setprio(0); } while (0)
#define PG8_WAIT_V(n) asm volatile("s_waitcnt vmcnt(" #n ")" ::: "memory")
#define PG8_WAIT_L(n) asm volatile("s_waitcnt lgkmcnt(" #n ")" ::: "memory")
#define PG8_BAR __builtin_amdgcn_s_barrier()
#define PG8_SCHED __builtin_amdgcn_sched_barrier(0)
    Unit cur, nxt; int ui = 0;
    if (!S.next(0, cur)) return;
    f32x4 acc[2][2][4][2];
#pragma unroll
    for (int a = 0; a < 2; ++a)
#pragma unroll
        for (int b = 0; b < 2; ++b)
#pragma unroll
            for (int m = 0; m < 4; ++m)
#pragma unroll
                for (int n = 0; n < 2; ++n) acc[a][b][m][n] = (f32x4){0.f, 0.f, 0.f, 0.f};
    bf16x8 At[4][2], B0[2][2], B1[2][2];
    const char* cA = (const char*)g.A + (size_t)cur.pm * tstep; const char* cB = (const char*)g.Bt + (size_t)cur.pn * tstep;
    S.a_ready(cur);
    if constexpr (SP2) {
        PG8_STAGE(PG8_SB(0, 0), cB, voffB); PG8_STAGE(PG8_SB(0, 1), cB + hstep, voffB); PG8_STAGE(PG8_SA(0, 0), cA, voffA); PG8_STAGE(PG8_SA(0, 1), cA + hstep, voffA);
        if (wr == 1) PG8_BAR;
        PG8_WAIT_V(2); PG8_BAR;
        PG8_STAGE(PG8_SB(1, 0), cB + kstep, voffB); PG8_STAGE(PG8_SA(1, 0), cA + kstep, voffA); PG8_STAGE(PG8_SB(1, 1), cB + hstep + kstep, voffB);
        PG8_WAIT_V(6); PG8_BAR;
    } else {
        PG8_STAGE(PG8_SB(0, 0), cB, voffB); PG8_STAGE(PG8_SA(0, 0), cA, voffA); PG8_STAGE(PG8_SB(0, 1), cB + hstep, voffB); PG8_STAGE(PG8_SA(0, 1), cA + hstep, voffA);
        if (wr == 1) PG8_BAR;
        PG8_WAIT_V(4); PG8_BAR;
        PG8_STAGE(PG8_SB(1, 0), cB + kstep, voffB); PG8_STAGE(PG8_SA(1, 0), cA + kstep, voffA); PG8_STAGE(PG8_SB(1, 1), cB + hstep + kstep, voffB);
        PG8_WAIT_V(6); PG8_BAR;
    }
    for (;;) {
        const bool has_next = S.next(ui + 1, nxt);
        const char* nA = has_next ? (const char*)g.A + (size_t)nxt.pm * tstep : cA; const char* nB = has_next ? (const char*)g.Bt + (size_t)nxt.pn * tstep : cB;
        for (int t = 0; t < nt; t += 2) {
            const bool last = (t == nt - 2);
            const char* a1 = cA + (size_t)(t + 1) * kstep;
            const char* a2 = last ? nA : cA + (size_t)(t + 2) * kstep; const char* b2 = last ? nB : cB + (size_t)(t + 2) * kstep;
            const char* a3 = a2 + kstep; const char* b3 = b2 + kstep;
            if (last && has_next) S.a_ready(nxt);
            if constexpr (SP2) {
            PG8_LDB(B0, 0, 0); PG8_LDB(B1, 0, 1); PG8_SCHED; PG8_LDA(At, 0, 0); PG8_STAGE(PG8_SA(1, 1), a1 + hstep, voffA);
            PG8_WAIT_V(8); PG8_WAIT_L(0); PG8_BAR; PG8_MMA(0, 0, At, B0); PG8_MMA(0, 1, At, B1); PG8_BAR; PG8_SCHED;
            PG8_LDA(At, 0, 1); PG8_STAGE(PG8_SB(0, 0), b2, voffB); PG8_STAGE(PG8_SB(0, 1), b2 + hstep, voffB); PG8_STAGE(PG8_SA(0, 0), a2, voffA);
            PG8_WAIT_V(8); PG8_WAIT_L(0); PG8_BAR; PG8_MMA(1, 0, At, B0); PG8_MMA(1, 1, At, B1); PG8_BAR; PG8_SCHED;
            PG8_LDB(B0, 1, 0); PG8_LDB(B1, 1, 1); PG8_SCHED; PG8_LDA(At, 1, 0); PG8_STAGE(PG8_SA(0, 1), a2 + hstep, voffA);
            PG8_WAIT_V(8); PG8_WAIT_L(0); PG8_BAR; PG8_MMA(0, 0, At, B0); PG8_MMA(0, 1, At, B1); PG8_BAR; PG8_SCHED;
            PG8_LDA(At, 1, 1); PG8_STAGE(PG8_SB(1, 0), b3, voffB); PG8_STAGE(PG8_SB(1, 1), b3 + hstep, voffB); PG8_STAGE(PG8_SA(1, 0), a3, voffA);
            PG8_WAIT_V(8); PG8_WAIT_L(0); PG8_BAR; PG8_MMA(1, 0, At, B0); PG8_MMA(1, 1, At, B1); PG8_BAR; PG8_SCHED;
            } else {
            PG8_LDB(B0, 0, 0); PG8_SCHED; PG8_LDA(At, 0, 0); PG8_STAGE(PG8_SA(1, 1), a1 + hstep, voffA);
            PG8_WAIT_L(8); PG8_BAR; PG8_WAIT_L(0); PG8_MMA(0, 0, At, B0); PG8_BAR; PG8_SCHED;
            PG8_LDB(B1, 0, 1); PG8_STAGE(PG8_SB(0, 0), b2, voffB);
            PG8_BAR; PG8_WAIT_L(0); PG8_MMA(0, 1, At, B1); PG8_BAR;
            PG8_LDA(At, 0, 1); PG8_STAGE(PG8_SA(0, 0), a2, voffA);
            PG8_BAR; PG8_WAIT_L(0); PG8_MMA(1, 0, At, B0); PG8_BAR; PG8_SCHED;
            PG8_STAGE(PG8_SB(0, 1), b2 + hstep, voffB);
            PG8_WAIT_V(6); PG8_BAR; PG8_MMA(1, 1, At, B1); PG8_BAR;
            PG8_LDB(B0, 1, 0); PG8_SCHED; PG8_LDA(At, 1, 0); PG8_STAGE(PG8_SA(0, 1), a2 + hstep, voffA);
            PG8_WAIT_L(8); PG8_BAR; PG8_WAIT_L(0); PG8_MMA(0, 0, At, B0); PG8_BAR; PG8_SCHED;
            PG8_LDB(B1, 1, 1); PG8_STAGE(PG8_SB(1, 0), b3, voffB);
            PG8_BAR; PG8_WAIT_L(0); PG8_MMA(0, 1, At, B1); PG8_BAR;
            PG8_LDA(At, 1, 1); PG8_STAGE(PG8_SA(1, 0), a3, voffA);
            PG8_BAR; PG8_WAIT_L(0); PG8_MMA(1, 0, At, B0); PG8_BAR; PG8_SCHED;
            PG8_STAGE(PG8_SB(1, 1), b3 + hstep, voffB);
            PG8_WAIT_V(6); PG8_BAR; PG8_MMA(1, 1, At, B1); PG8_BAR;
            }
        }
        if constexpr (ALIGN_EPI) { if (wr == 0) PG8_BAR; }
        if constexpr (!Epi::AFTER_DRAIN) { E(acc, cur, wr, wc, fr, fq); S.done(cur); }
        if (!has_next) break;
#pragma unroll
        for (int a = 0; a < 2; ++a)
#pragma unroll
            for (int b = 0; b < 2; ++b)
#pragma unroll
                for (int m = 0; m < 4; ++m)
#pragma unroll
                    for (int n = 0; n < 2; ++n) acc[a][b][m][n] = (f32x4){0.f, 0.f, 0.f, 0.f};
        cur = nxt; cA = nA; cB = nB; ++ui;
        if constexpr (ALIGN_EPI) { if (wr == 1) PG8_BAR; }
    }
    PG8_WAIT_V(0);
    if constexpr (!ALIGN_EPI) { if (wr == 0) PG8_BAR; }
    PG8_BAR;
    if constexpr (Epi::AFTER_DRAIN) { E.fused(acc, cur, wr, wc, fr, fq, lds, wid, lane); S.done(cur); }
#undef PG8_SA
#undef PG8_SB
#undef PG8_STAGE
#undef PG8_LDA
#undef PG8_LDB
#undef PG8_MMA
#undef PG8_WAIT_V
#undef PG8_WAIT_L
#undef PG8_BAR
#undef PG8_SCHED
}
}
constexpr int DM = 1024, NB = 4, SEQ = 8192, CTXL = 256, NH = 8;
constexpr int ML = NB * SEQ, MC = NB * CTXL, MT = ML + MC;
constexpr int NPROJ = 6176, NPAD = 6400;
constexpr int NSTEP = 132;
constexpr float EPSF = 1e-6f;
constexpr int NWAVES = 8, NTHREADS = 512;
constexpr int LDS_BYTES = 135168;
constexpr size_t MiB = 1u << 20;
constexpr size_t WS_MODV = 4096;
constexpr size_t WS_WIN = 1 * MiB;
constexpr size_t WS_WONA = 14 * MiB, WS_WODN = 15 * MiB, WS_WOUT = 16 * MiB;
constexpr size_t WS_BA = 18 * MiB;
constexpr size_t WS_VT8C = 22 * MiB + 512 * 1024;
constexpr size_t WS_ZNA = 24 * MiB, WS_ZDN = 56 * MiB, WS_GNA = 88 * MiB, WS_GDN = 152 * MiB;
constexpr size_t WS_NAK = 216 * MiB, WS_NAV = 249 * MiB, WS_DNQKV = 282 * MiB;
constexpr size_t WS_TB = 282 * MiB, WS_GC = 354 * MiB;
constexpr size_t WS_XN = 381 * MiB;
constexpr size_t WS_DQ = 381 * MiB, WS_DK = 413 * MiB, WS_DKT = 445 * MiB, WS_DV = 477 * MiB;
constexpr size_t WS_DKC = 509 * MiB, WS_DKTC = 510 * MiB, WS_DVC = 511 * MiB;
constexpr size_t WS_T1 = 381 * MiB, WS_Y = 445 * MiB;
constexpr size_t WS_END = 512 * MiB;
constexpr size_t DO_Q = 0, DO_VT8 = 32 * MiB, DO_OF = 64 * MiB, DO_OB = 96 * MiB;

#define LAS __attribute__((address_space(3)))
typedef unsigned short bf16;
typedef unsigned u32x4 __attribute__((ext_vector_type(4)));
typedef unsigned u32x2 __attribute__((ext_vector_type(2)));
typedef float f32x4 __attribute__((ext_vector_type(4)));
typedef short bf16x8 __attribute__((ext_vector_type(8)));
#define LDS_WAIT() asm volatile("s_waitcnt lgkmcnt(0)" ::: "memory")
__device__ __forceinline__ unsigned f2bf(float f) { unsigned u = __builtin_bit_cast(unsigned, f); return (u + 0x7fffu + ((u >> 16) & 1u)) >> 16; }
__device__ __forceinline__ unsigned pk2(float lo, float hi) { return f2bf(lo) | (f2bf(hi) << 16); }
__device__ __forceinline__ float blo(unsigned w) { return __builtin_bit_cast(float, w << 16); }
__device__ __forceinline__ float bhi(unsigned w) { return __builtin_bit_cast(float, w & 0xffff0000u); }
__device__ __forceinline__ float bf1(unsigned short h) { return __builtin_bit_cast(float, ((unsigned)h) << 16); }
__device__ __forceinline__ void unpack8(const u32x4 v, float (&f)[8]) { f[0] = blo(v.x); f[1] = bhi(v.x); f[2] = blo(v.y); f[3] = bhi(v.y); f[4] = blo(v.z); f[5] = bhi(v.z); f[6] = blo(v.w); f[7] = bhi(v.w); }
__device__ __forceinline__ u32x4 pack8(const float (&f)[8]) { u32x4 w; w.x = pk2(f[0], f[1]); w.y = pk2(f[2], f[3]); w.z = pk2(f[4], f[5]); w.w = pk2(f[6], f[7]); return w; }
__device__ __forceinline__ bf16x8 pack_frag(const f32x4 a, const f32x4 b) { u32x4 w; w.x = pk2(a[0], a[1]); w.y = pk2(a[2], a[3]); w.z = pk2(b[0], b[1]); w.w = pk2(b[2], b[3]); return __builtin_bit_cast(bf16x8, w); }
__device__ __forceinline__ float sigm(float v) { return __builtin_amdgcn_rcpf(1.0f + __expf(-v)); }
#define MFMA16(a, b, c) __builtin_amdgcn_mfma_f32_16x16x32_bf16((a), (b), (c), 0, 0, 0)
__device__ __forceinline__ void tr8x8(const u32x4 (&in)[8], u32x4 (&out)[8]) {
#pragma unroll
    for (int e = 0; e < 8; ++e) {
        unsigned w[4];
#pragma unroll
        for (int p = 0; p < 4; ++p) { const unsigned a = in[2 * p][e >> 1], b = in[2 * p + 1][e >> 1];
            w[p] = (e & 1) ? ((a >> 16) | (b & 0xffff0000u)) : ((a & 0xffffu) | (b << 16)); }
        out[e] = (u32x4){w[0], w[1], w[2], w[3]};
    }
}

struct Args { const float* in[18]; float* out; unsigned char* ws; };

struct Ctx {
    LAS unsigned char* lds; int tid, lane, wave, G, gw, NGW;
    unsigned char* ws; unsigned char* dout;
};

__device__ __forceinline__ void p0_transpose_item(const float* W, int K, int N, bf16* WT, int k0, int n0, int dst_row, LAS float* scr, int lane) {
#pragma unroll 8
    for (int i = 0; i < 32; ++i) { const int kk = 2 * i + (lane >> 5); scr[kk * 33 + (lane & 31)] = W[(size_t)(k0 + kk) * N + n0 + (lane & 31)]; }
    LDS_WAIT();
    const int c = lane & 7;
#pragma unroll
    for (int j = 0; j < 4; ++j) { const int n = (lane >> 3) + 8 * j; const LAS float* s = scr + (8 * c) * 33 + n;
        u32x4 o; o.x = pk2(s[0 * 33], s[1 * 33]); o.y = pk2(s[2 * 33], s[3 * 33]); o.z = pk2(s[4 * 33], s[5 * 33]); o.w = pk2(s[6 * 33], s[7 * 33]);
        *(u32x4*)(WT + (size_t)(dst_row + n) * K + k0 + 8 * c) = o; }
    LDS_WAIT();
}
__device__ __forceinline__ void phase0(Ctx& F, const Args& A) {
    if (blockIdx.x < 48) {
        LAS float* sc = (LAS float*)F.lds;
        LAS float* red = (LAS float*)(F.lds + 20480);
        for (int i = F.tid; i < 5 * 1024; i += NTHREADS) { const int v = i >> 10, k = i & 1023; const float cv = (v < 4) ? A.in[1][v * 1024 + k] : A.in[3][k]; sc[i] = cv * sigm(cv); }
        __syncthreads();
        const int n0 = blockIdx.x * 64, kc = F.tid >> 4, c4 = F.tid & 15;
        float acc[5][4];
#pragma unroll
        for (int v = 0; v < 5; ++v)
#pragma unroll
            for (int e = 0; e < 4; ++e) acc[v][e] = 0.f;
#pragma unroll 4
        for (int i = 0; i < 32; ++i) { const int k = kc * 32 + i; const f32x4 w = *(const f32x4*)(A.in[4] + (size_t)k * 3072 + n0 + 4 * c4);
#pragma unroll
            for (int v = 0; v < 5; ++v) { const float s = sc[v * 1024 + k]; acc[v][0] += s * w[0]; acc[v][1] += s * w[1]; acc[v][2] += s * w[2]; acc[v][3] += s * w[3]; } }
#pragma unroll
        for (int v = 0; v < 5; ++v)
#pragma unroll
            for (int e = 0; e < 4; ++e) red[(kc * 5 + v) * 64 + 4 * c4 + e] = acc[v][e];
        __syncthreads();
        if (F.tid < 320) { const int v = F.tid >> 6, col = F.tid & 63; float s = A.in[5][n0 + col];
            for (int k = 0; k < 32; ++k) s += red[(k * 5 + v) * 64 + col];
            ((float*)(F.ws + WS_MODV))[v * 3072 + n0 + col] = s; }
        __syncthreads();
    }
    { u32x4* z = (u32x4*)(F.ws + WS_WIN + (size_t)NPROJ * 1024 * 2); const int n16 = (NPAD - NPROJ) * 1024 * 2 / 16;
      for (int i = blockIdx.x * NTHREADS + F.tid; i < n16; i += F.G * NTHREADS) z[i] = (u32x4){0u, 0u, 0u, 0u}; }
    LAS float* scr = (LAS float*)(F.lds + F.wave * 16384);
    constexpr int I_IN = 16 * 193, I_ONA = 8 * 32, I_ODN = 8 * 32, I_OUT = 16 * 32;
    for (int it = F.gw; it < I_IN + I_ONA + I_ODN + I_OUT; it += F.NGW) {
        int r = it;
        if (r < I_IN) { const int kb = r / 193, nb = r % 193, c0 = 32 * nb; const int dst = (c0 < 4096) ? c0 : ((c0 < 4128) ? 6144 + (c0 - 4096) : c0 - 32);
            p0_transpose_item(A.in[7], 1024, NPROJ, (bf16*)(F.ws + WS_WIN), 64 * kb, c0, dst, scr, F.lane); continue; }
        r -= I_IN;
        if (r < I_ONA) { p0_transpose_item(A.in[15], 512, 1024, (bf16*)(F.ws + WS_WONA), 64 * (r / 32), 32 * (r % 32), 32 * (r % 32), scr, F.lane); continue; }
        r -= I_ONA;
        if (r < I_ODN) { p0_transpose_item(A.in[16], 512, 1024, (bf16*)(F.ws + WS_WODN), 64 * (r / 32), 32 * (r % 32), 32 * (r % 32), scr, F.lane); continue; }
        r -= I_ODN;
        p0_transpose_item(A.in[17], 1024, 1024, (bf16*)(F.ws + WS_WOUT), 64 * (r / 32), 32 * (r % 32), 32 * (r % 32), scr, F.lane);
    }
}
__device__ __forceinline__ float wave_sum(float v) {
#pragma unroll
    for (int o = 1; o < 64; o <<= 1) v += __shfl_xor(v, o);
    return v;
}
__device__ __forceinline__ void phase1(Ctx& F, const Args& A) {
    const float* modv = (const float*)(F.ws + WS_MODV); bf16* XN = (bf16*)(F.ws + WS_XN);
    for (int ch = F.gw; ch < MT / 16; ch += F.NGW) {
        const int row0 = ch * 16; const int b = (row0 < ML) ? row0 / SEQ : 4;
        f32x4 mul[4], add[4];
#pragma unroll
        for (int j = 0; j < 4; ++j) { const int col = 4 * F.lane + 256 * j; const f32x4 nw = *(const f32x4*)(A.in[6] + col), sc = *(const f32x4*)(modv + b * 3072 + 1024 + col);
            mul[j] = nw * (sc + 1.0f); add[j] = *(const f32x4*)(modv + b * 3072 + col); }
        for (int rr = 0; rr < 16; ++rr) {
            const int row = row0 + rr; const float* src = (row < ML) ? A.in[0] + (size_t)row * DM : A.in[2] + (size_t)(row - ML) * DM;
            f32x4 v[4]; float s = 0.f;
#pragma unroll
            for (int j = 0; j < 4; ++j) { v[j] = *(const f32x4*)(src + 4 * F.lane + 256 * j); s += (v[j][0] * v[j][0] + v[j][1] * v[j][1]) + (v[j][2] * v[j][2] + v[j][3] * v[j][3]); }
            const float r = rsqrtf(wave_sum(s) * (1.f / DM) + EPSF);
#pragma unroll
            for (int j = 0; j < 4; ++j) { const f32x4 o = v[j] * r * mul[j] + add[j];
                *(u32x2*)(XN + (size_t)row * DM + 4 * F.lane + 256 * j) = (u32x2){pk2(o[0], o[1]), pk2(o[2], o[3])}; }
        }
    }
}
__device__ __forceinline__ float red8(float v) { v += __shfl_xor(v, 1); v += __shfl_xor(v, 2); v += __shfl_xor(v, 4); return v; }
__device__ __forceinline__ void item_pos(int it, bool& lat, int& m0, int& b, int& t0, int& Tseq) {
    lat = it < ML / 8;
    if (lat) { m0 = it * 8; b = m0 / SEQ; t0 = m0 % SEQ; Tseq = SEQ; } else { const int ci = it - ML / 8; m0 = ML + ci * 8; b = ci / 32; t0 = (ci % 32) * 8; Tseq = CTXL; }
}
__device__ __forceinline__ void phase3(Ctx& F, const Args& A) {
    const int l = F.lane, h = l >> 3, j = l & 7;
    {
        bf16* NAQ = (bf16*)(F.dout + DO_Q); bf16* NAK = (bf16*)(F.ws + WS_NAK); const bf16* NAV = (const bf16*)(F.ws + WS_NAV);
        float wq8[8], wk8[8];
#pragma unroll
        for (int e = 0; e < 8; ++e) { wq8[e] = A.in[9][8 * j + e] * 0.125f; wk8[e] = A.in[10][8 * j + e]; }
        for (int it = F.gw; it < MT / 8; it += F.NGW) {
            bool lat; int m0, b, t0, Tseq; item_pos(it, lat, m0, b, t0, Tseq);
            const int bh = b * 8 + h;
            if (lat) {
#pragma unroll 2
                for (int t = 0; t < 8; ++t) { u32x4* p = (u32x4*)(NAQ + (size_t)(m0 + t) * 512 + 8 * l); float f[8]; unpack8(*p, f); float ss = 0.f;
#pragma unroll
                    for (int e = 0; e < 8; ++e) ss += f[e] * f[e];
                    const float r = rsqrtf(red8(ss) * (1.f / 64.f) + EPSF);
#pragma unroll
                    for (int e = 0; e < 8; ++e) f[e] = f[e] * r * wq8[e];
                    *p = pack8(f); }
            }
#pragma unroll 2
            for (int t = 0; t < 8; ++t) { u32x4* p = (u32x4*)(NAK + (size_t)(m0 + t) * 512 + 8 * l); float f[8]; unpack8(*p, f); float ss = 0.f;
#pragma unroll
                for (int e = 0; e < 8; ++e) ss += f[e] * f[e];
                const float r = rsqrtf(red8(ss) * (1.f / 64.f) + EPSF);
#pragma unroll
                for (int e = 0; e < 8; ++e) f[e] = f[e] * r * wk8[e];
                *p = pack8(f); }
            { u32x4 vin[8], vout[8];
#pragma unroll
              for (int t = 0; t < 8; ++t) vin[t] = *(const u32x4*)(NAV + (size_t)(m0 + t) * 512 + 8 * l);
              tr8x8(vin, vout);
              u32x4* dst = lat ? (u32x4*)(F.dout + DO_VT8) + ((size_t)bh * (SEQ / 8) + t0 / 8) * 64 + 8 * j : (u32x4*)(F.ws + WS_VT8C) + ((size_t)bh * (CTXL / 8) + t0 / 8) * 64 + 8 * j;
#pragma unroll
              for (int e = 0; e < 8; ++e) dst[e] = vout[e]; }
        }
    }
    {
        const bf16* DNQKV = (const bf16*)(F.ws + WS_DNQKV);
        float fr8[8];
#pragma unroll
        for (int e = 0; e < 8; ++e) fr8[e] = exp2f(-(float)(8 * (j & 1) + e) * (13.287712379549449f / 16.0f));
        for (int it2 = F.gw; it2 < 3 * (MT / 8); it2 += F.NGW) {
            const int seg = it2 % 3, it = it2 / 3;
            bool lat; int m0, b, t0, Tseq; item_pos(it, lat, m0, b, t0, Tseq);
            if (seg == 0 && !lat) continue;
            const int bh = b * 8 + h;
            float cw[3][8];
#pragma unroll
            for (int tp = 0; tp < 3; ++tp) { const f32x4 a = *(const f32x4*)(A.in[8] + tp * 1536 + seg * 512 + 8 * l), bq = *(const f32x4*)(A.in[8] + tp * 1536 + seg * 512 + 8 * l + 4);
                cw[tp][0] = a[0]; cw[tp][1] = a[1]; cw[tp][2] = a[2]; cw[tp][3] = a[3]; cw[tp][4] = bq[0]; cw[tp][5] = bq[1]; cw[tp][6] = bq[2]; cw[tp][7] = bq[3]; }
            bf16* dst; if (seg == 0) dst = (bf16*)(F.ws + WS_DQ); else if (seg == 1) dst = lat ? (bf16*)(F.ws + WS_DK) : (bf16*)(F.ws + WS_DKC); else dst = lat ? (bf16*)(F.ws + WS_DV) : (bf16*)(F.ws + WS_DVC);
            const bf16* src = DNQKV + (size_t)m0 * 1536 + seg * 512 + 8 * l;
            u32x4 r0 = (t0 > 0) ? *(const u32x4*)(src - 1536) : (u32x4){0u, 0u, 0u, 0u};
            u32x4 r1 = *(const u32x4*)(src);
#pragma unroll 1
            for (int t = 0; t < 8; ++t) {
                const u32x4 r2 = (t0 + t + 1 < Tseq) ? *(const u32x4*)(src + (size_t)(t + 1) * 1536) : (u32x4){0u, 0u, 0u, 0u};
                float a[8], bq[8], cq[8], y[8]; unpack8(r0, a); unpack8(r1, bq); unpack8(r2, cq);
#pragma unroll
                for (int e = 0; e < 8; ++e) { const float s = cw[0][e] * a[e] + cw[1][e] * bq[e] + cw[2][e] * cq[e]; y[e] = s * sigm(s); }
                if (seg < 2) {
                    float ss = 0.f;
#pragma unroll
                    for (int e = 0; e < 8; ++e) ss += y[e] * y[e];
                    const float r = rsqrtf(red8(ss) + EPSF);
#pragma unroll
                    for (int e = 0; e < 8; ++e) y[e] *= r;
                    if (lat) {
                        const int tok = t0 + t; const float pos = (float)((j < 4) ? (tok >> 6) : (tok & 63));
#pragma unroll
                        for (int e = 0; e < 8; ++e) { const float ang = pos * fr8[e]; const float cs = __cosf(ang), sn = __sinf(ang); const float pr = __shfl_xor(y[e], 2);
                            y[e] = (j & 2) ? (y[e] * cs + pr * sn) : (y[e] * cs - pr * sn); }
                    }
                    if (seg == 0) {
#pragma unroll
                        for (int e = 0; e < 8; ++e) y[e] *= 0.125f;
                    }
                }
                *(u32x4*)(dst + ((size_t)bh * Tseq + t0 + t) * 64 + 8 * j) = pack8(y);
                r0 = r1; r1 = r2;
            }
            if (seg == 1) {
                asm volatile("s_waitcnt vmcnt(0)" ::: "memory");
                u32x4 res[8], kt[8];
#pragma unroll
                for (int t = 0; t < 8; ++t) res[t] = __builtin_nontemporal_load((const u32x4*)(dst + ((size_t)bh * Tseq + t0 + t) * 64 + 8 * j));
                tr8x8(res, kt);
                bf16* kd = lat ? (bf16*)(F.ws + WS_DKT) : (bf16*)(F.ws + WS_DKTC);
#pragma unroll
                for (int e = 0; e < 8; ++e) *(u32x4*)(kd + (((size_t)bh * (Tseq / 64) + t0 / 64) * 64 + 8 * j + e) * 64 + (t0 & 63)) = kt[e];
            }
        }
    }
}
__device__ __forceinline__ void step_chunk(int step, int dir, bool& lat, int& chunk) { if (step < 4) { lat = false; chunk = dir ? 3 - step : step; } else { lat = true; chunk = dir ? 131 - step : step - 4; } }
__host__ __device__ constexpr int tri_off(int i) { return i == 0 ? 0 : (8 * ((i - 1) >> 2) * (((i - 1) >> 2) + 1) + (i - 1 - 4 * ((i - 1) >> 2)) * 4 * (((i - 1) >> 2) + 1)); }
__host__ __device__ constexpr int tri_len(int i) { return i == 0 ? 0 : 4 * (((i - 1) >> 2) + 1); }
constexpr int TRI_FLOATS = 2176;
template <int I> struct SubstRow {
    static __device__ __forceinline__ void run(float (&t)[64], const LAS float* L, float lanef) {
        SubstRow<I - 1>::run(t, L, lanef);
        float s = fmaxf(0.f, 1.f - fabsf(lanef - (float)I));
#pragma unroll
        for (int q = 0; q < tri_len(I) / 4; ++q) { const f32x4 lv = *(const LAS f32x4*)(L + tri_off(I) + 4 * q);
            if (4 * q + 0 < I) s -= lv[0] * t[4 * q + 0];
            if (4 * q + 1 < I) s -= lv[1] * t[4 * q + 1];
            if (4 * q + 2 < I) s -= lv[2] * t[4 * q + 2];
            if (4 * q + 3 < I) s -= lv[3] * t[4 * q + 3]; }
        t[I] = s;
        if ((I & 3) == 3) asm volatile("" ::: "memory");
    }
};
template <> struct SubstRow<-1> { static __device__ __forceinline__ void run(float (&)[64], const LAS float*, float) {} };

__device__ __forceinline__ void phase4(Ctx& F, const Args& A) {
    LAS float* Lt = (LAS float*)(F.lds + F.wave * (TRI_FLOATS * 4));
    const float* BA = (const float*)(F.ws + WS_BA);
    for (int id = F.gw; id < 64 * NSTEP; id += F.NGW) {
        int l = F.lane; asm volatile("" : "+v"(l));
        const int g = l >> 4, i16 = l & 15;
        const int step = id % NSTEP, sd = id / NSTEP, dir = sd & 1, bh = sd >> 1, b = bh >> 3, h = bh & 7;
        bool lat; int chunk; step_chunk(step, dir, lat, chunk);
        const int tl = dir ? 63 - l : l;
        const int m = lat ? b * SEQ + chunk * 64 + tl : ML + b * CTXL + chunk * 64 + tl;
        const float braw = BA[(size_t)m * 32 + dir * 8 + h], araw = BA[(size_t)m * 32 + 16 + dir * 8 + h];
        const float beta = sigm(braw);
        const float xs = araw + A.in[13][dir * 8 + h];
        const float sp = (xs > 15.f) ? xs : log1pf(expf(xs));
        float gc = -expf(A.in[12][dir * 8 + h]) * sp;
#pragma unroll
        for (int o = 1; o < 64; o <<= 1) { const float v = __shfl_up(gc, o); if (l >= o) gc += v; }
        ((float*)(F.ws + WS_GC))[(size_t)id * 64 + tl] = gc;
        const bf16* Kt = lat ? (const bf16*)(F.ws + WS_DK) + ((size_t)bh * SEQ + chunk * 64) * 64 : (const bf16*)(F.ws + WS_DKC) + ((size_t)bh * CTXL + chunk * 64) * 64;
        bf16x8 Kf[4][2];
#pragma unroll
        for (int it = 0; it < 4; ++it)
#pragma unroll
            for (int kk = 0; kk < 2; ++kk) { const int li = 16 * it + i16; const int tk = dir ? 63 - li : li; Kf[it][kk] = *(const bf16x8*)(Kt + tk * 64 + 8 * g + 32 * kk); }
#pragma unroll
        for (int it = 0; it < 4; ++it) {
            float gci[4], bti[4];
#pragma unroll
            for (int r = 0; r < 4; ++r) { gci[r] = __shfl(gc, 16 * it + 4 * g + r); bti[r] = __shfl(beta, 16 * it + 4 * g + r); }
#pragma unroll
            for (int jt = 0; jt <= it; ++jt) {
                f32x4 a = {0.f, 0.f, 0.f, 0.f};
                a = MFMA16(Kf[it][0], Kf[jt][0], a); a = MFMA16(Kf[it][1], Kf[jt][1], a);
                const int jj = 16 * jt + i16; const float gcj = __shfl(gc, jj);
#pragma unroll
                for (int r = 0; r < 4; ++r) { const int ii = 16 * it + 4 * g + r; const int q = (ii - 1) >> 2; const int len = (ii == 0) ? 0 : 4 * (q + 1);
                    const int off = (ii == 0) ? 0 : (8 * q * (q + 1) + (ii - 1 - 4 * q) * 4 * (q + 1));
                    if (jj < len) Lt[off + jj] = (jj < ii) ? bti[r] * a[r] * __expf(gci[r] - gcj) : 0.f; }
            }
        }
        LDS_WAIT();
        float t[64];
        SubstRow<63>::run(t, Lt, (float)l);
        asm volatile("" ::: "memory");
        bf16* TB = (bf16*)(F.ws + WS_TB) + (size_t)id * 4096;
#pragma unroll
        for (int i = 0; i < 64; ++i) { const int ti = dir ? 63 - i : i; TB[ti * 64 + tl] = (bf16)f2bf(t[i] * beta); }
        LDS_WAIT();
    }
}
__device__ __forceinline__ void phase_na(Ctx& F, const Args& A) {
    const int l = F.lane, g = l >> 4, i16 = l & 15;
    LAS float* rp = (LAS float*)F.lds;
    for (int i = F.tid; i < 8 * 465; i += NTHREADS) rp[i] = A.in[11][i];
    float mq = fabsf(A.in[9][l]), mk = fabsf(A.in[10][l]), mr = 0.f;
    for (int i = l; i < 8 * 465; i += 64) mr = fmaxf(mr, fabsf(A.in[11][i]));
#pragma unroll
    for (int o = 1; o < 64; o <<= 1) { mq = fmaxf(mq, __shfl_xor(mq, o)); mk = fmaxf(mk, __shfl_xor(mk, o)); mr = fmaxf(mr, __shfl_xor(mr, o)); }
    const float mb = 8.0f * mq * mk + mr;
    __syncthreads();
    bf16* Q = (bf16*)(F.dout + DO_Q); const bf16* Kn = (const bf16*)(F.ws + WS_NAK); const bf16* ZNA = (const bf16*)(F.ws + WS_ZNA);
    const u32x4* VTL = (const u32x4*)(F.dout + DO_VT8); const u32x4* VTC = (const u32x4*)(F.ws + WS_VT8C);
    const int key0 = 8 * (i16 >> 2) + (i16 & 3);
    for (int task = F.gw; task < NB * NH * 128 * 4; task += F.NGW) {
        const int jq = task & 3, r = (task >> 2) & 127, bh = task >> 9, b = bh >> 3, h = bh & 7;
        const int q0 = 16 * jq, kc0 = (jq == 0) ? 0 : ((jq == 1) ? 8 : ((jq == 2) ? 24 : 32));
        const int r0 = min(max(r - 4, 0), 120);
        const size_t mq_row = (size_t)b * SEQ + r * 64 + q0 + i16;
        bf16x8 Qf[2];
#pragma unroll
        for (int kk = 0; kk < 2; ++kk) Qf[kk] = *(const bf16x8*)(Q + mq_row * 512 + h * 64 + 8 * g + 32 * kk);
        const int cq = q0 + i16, c0 = min(max(cq - 8, 0), 48);
        f32x4 O[4]; float lsum = 0.f;
#pragma unroll
        for (int dt = 0; dt < 4; ++dt) O[dt] = (f32x4){0.f, 0.f, 0.f, 0.f};
        const LAS float* rph = rp + h * 465;
#pragma unroll 2
        for (int y = 0; y < 8; ++y) {
            const int trow = r0 + y; const size_t tk0 = (size_t)b * SEQ + trow * 64 + kc0;
            const bf16* kp = Kn + (tk0 + key0) * 512 + h * 64 + 8 * g;
            const bf16x8 ka0 = *(const bf16x8*)(kp), ka1 = *(const bf16x8*)(kp + 32), kb0 = *(const bf16x8*)(kp + 4 * 512), kb1 = *(const bf16x8*)(kp + 4 * 512 + 32);
            const u32x4* vp = VTL + ((size_t)bh * (SEQ / 8) + (trow * 64 + kc0) / 8 + g) * 64 + i16;
            bf16x8 vf[4];
#pragma unroll
            for (int dt = 0; dt < 4; ++dt) vf[dt] = __builtin_bit_cast(bf16x8, vp[16 * dt]);
            f32x4 s0 = {0.f, 0.f, 0.f, 0.f}, s1 = {0.f, 0.f, 0.f, 0.f};
            s0 = MFMA16(ka0, Qf[0], s0); s0 = MFMA16(ka1, Qf[1], s0); s1 = MFMA16(kb0, Qf[0], s1); s1 = MFMA16(kb1, Qf[1], s1);
            const LAS float* rrow = rph + (trow - r + 7) * 31 + 15;
#pragma unroll
            for (int rr = 0; rr < 4; ++rr) {
                const int ck0 = kc0 + 8 * g + rr, ck1 = ck0 + 4;
                const int dx0 = min(max(ck0 - cq, -15), 15), dx1 = min(max(ck1 - cq, -15), 15);
                const float p0 = (ck0 >= c0 && ck0 < c0 + 16) ? __expf(s0[rr] + rrow[dx0] - mb) : 0.f;
                const float p1 = (ck1 >= c0 && ck1 < c0 + 16) ? __expf(s1[rr] + rrow[dx1] - mb) : 0.f;
                s0[rr] = p0; s1[rr] = p1; lsum += p0 + p1;
            }
            const bf16x8 pf = pack_frag(s0, s1);
#pragma unroll
            for (int dt = 0; dt < 4; ++dt) O[dt] = MFMA16(vf[dt], pf, O[dt]);
        }
#pragma unroll 2
        for (int cb = 0; cb < 8; ++cb) {
            const size_t tk0 = (size_t)ML + b * CTXL + cb * 32;
            const bf16* kp = Kn + (tk0 + key0) * 512 + h * 64 + 8 * g;
            const bf16x8 ka0 = *(const bf16x8*)(kp), ka1 = *(const bf16x8*)(kp + 32), kb0 = *(const bf16x8*)(kp + 4 * 512), kb1 = *(const bf16x8*)(kp + 4 * 512 + 32);
            const u32x4* vp = VTC + ((size_t)bh * (CTXL / 8) + cb * 4 + g) * 64 + i16;
            bf16x8 vf[4];
#pragma unroll
            for (int dt = 0; dt < 4; ++dt) vf[dt] = __builtin_bit_cast(bf16x8, vp[16 * dt]);
            f32x4 s0 = {0.f, 0.f, 0.f, 0.f}, s1 = {0.f, 0.f, 0.f, 0.f};
            s0 = MFMA16(ka0, Qf[0], s0); s0 = MFMA16(ka1, Qf[1], s0); s1 = MFMA16(kb0, Qf[0], s1); s1 = MFMA16(kb1, Qf[1], s1);
#pragma unroll
            for (int rr = 0; rr < 4; ++rr) { const float p0 = __expf(s0[rr] - mb), p1 = __expf(s1[rr] - mb); s0[rr] = p0; s1[rr] = p1; lsum += p0 + p1; }
            const bf16x8 pf = pack_frag(s0, s1);
#pragma unroll
            for (int dt = 0; dt < 4; ++dt) O[dt] = MFMA16(vf[dt], pf, O[dt]);
        }
        lsum += __shfl_xor(lsum, 16); lsum += __shfl_xor(lsum, 32);
        const float inv = 1.0f / lsum;
#pragma unroll
        for (int dt = 0; dt < 4; ++dt) { const size_t off = mq_row * 512 + h * 64 + 16 * dt + 4 * g; const u32x2 z = *(const u32x2*)(ZNA + off);
            *(u32x2*)(Q + off) = (u32x2){pk2(O[dt][0] * inv * blo(z.x), O[dt][1] * inv * bhi(z.x)), pk2(O[dt][2] * inv * blo(z.y), O[dt][3] * inv * bhi(z.y))}; }
    }
}
constexpr int SROW = 144;
constexpr int SM_K = 0, SM_KT = 9216, SM_Q = 18432, SM_V = 27648, SM_TB = 36864, SM_QK = 46080, SM_EG = 55296, SM_ED = 55552, SM_STAGE = 56320;
__device__ __forceinline__ int rowmap(int tau, int g, int r) { return 32 * (tau >> 1) + 8 * g + 4 * (tau & 1) + r; }
__device__ __forceinline__ void phase_scan(Ctx& F, const Args& A) {
    if (blockIdx.x >= 64) return;
    const int l = F.lane, g = l >> 4, i16 = l & 15, w = F.wave, tid = F.tid;
    const int sd = blockIdx.x, dir = sd & 1, bh = sd >> 1, b = bh >> 3, h = bh & 7;
    const float* GC = (const float*)(F.ws + WS_GC) + (size_t)sd * NSTEP * 64;
    const bf16* TBg = (const bf16*)(F.ws + WS_TB) + (size_t)sd * NSTEP * 4096;
    bf16* OD = (bf16*)(F.dout + (dir ? DO_OB : DO_OF));
    const int srow = tid >> 3, spc = tid & 7; const int sdst = srow * SROW + spc * 16;
    u32x4 stg[5]; float sgc = 0.f, sgl = 0.f;
    auto issue = [&](int step) {
        bool lat; int chunk; step_chunk(step, dir, lat, chunk);
        const u32x4* pk = lat ? (const u32x4*)((const bf16*)(F.ws + WS_DK) + ((size_t)bh * SEQ + chunk * 64) * 64) : (const u32x4*)((const bf16*)(F.ws + WS_DKC) + ((size_t)bh * CTXL + chunk * 64) * 64);
        const u32x4* pkt = lat ? (const u32x4*)((const bf16*)(F.ws + WS_DKT) + ((size_t)bh * 128 + chunk) * 4096) : (const u32x4*)((const bf16*)(F.ws + WS_DKTC) + ((size_t)bh * 4 + chunk) * 4096);
        const u32x4* pv = lat ? (const u32x4*)((const bf16*)(F.ws + WS_DV) + ((size_t)bh * SEQ + chunk * 64) * 64) : (const u32x4*)((const bf16*)(F.ws + WS_DVC) + ((size_t)bh * CTXL + chunk * 64) * 64);
        stg[0] = pk[tid]; stg[1] = pkt[tid]; stg[3] = pv[tid]; stg[4] = ((const u32x4*)(TBg + (size_t)step * 4096))[tid];
        stg[2] = lat ? ((const u32x4*)((const bf16*)(F.ws + WS_DQ) + ((size_t)bh * SEQ + chunk * 64) * 64))[tid] : (u32x4){0u, 0u, 0u, 0u};
        if (tid < 64) { sgc = GC[step * 64 + tid]; sgl = GC[step * 64 + (dir ? 0 : 63)]; }
    };
    auto commit = [&](int buf) {
        LAS unsigned char* sb = F.lds + buf * SM_STAGE;
        *(LAS u32x4*)(sb + SM_K + sdst) = stg[0]; *(LAS u32x4*)(sb + SM_KT + sdst) = stg[1]; *(LAS u32x4*)(sb + SM_Q + sdst) = stg[2]; *(LAS u32x4*)(sb + SM_V + sdst) = stg[3]; *(LAS u32x4*)(sb + SM_TB + sdst) = stg[4];
        if (tid < 64) { ((LAS float*)(sb + SM_EG))[tid] = __expf(sgc); ((LAS float*)(sb + SM_ED))[tid] = __expf(sgl - sgc); if (tid == 0) ((LAS float*)(sb + SM_ED))[64] = __expf(sgl); }
    };
    auto helper_qk = [&](int step, int buf) {
        bool lat; int chunk; step_chunk(step, dir, lat, chunk);
        if (!lat) return;
        const int hw = w - 4;
        const bf16* Kt = (const bf16*)(F.ws + WS_DK) + ((size_t)bh * SEQ + chunk * 64) * 64; const bf16* Qt = (const bf16*)(F.ws + WS_DQ) + ((size_t)bh * SEQ + chunk * 64) * 64;
        const int tq = 16 * hw + i16;
        const bf16x8 q0 = *(const bf16x8*)(Qt + tq * 64 + 8 * g), q1 = *(const bf16x8*)(Qt + tq * 64 + 8 * g + 32);
        const float gct = GC[step * 64 + tq];
        LAS unsigned char* sb = F.lds + buf * SM_STAGE;
#pragma unroll
        for (int kk = 0; kk < 2; ++kk) {
            f32x4 a[2];
#pragma unroll
            for (int hf = 0; hf < 2; ++hf) { const int tau = 2 * kk + hf; const int tr = 32 * kk + 8 * (i16 >> 2) + 4 * hf + (i16 & 3);
                const bf16x8 k0 = *(const bf16x8*)(Kt + tr * 64 + 8 * g), k1 = *(const bf16x8*)(Kt + tr * 64 + 8 * g + 32);
                f32x4 s = {0.f, 0.f, 0.f, 0.f}; s = MFMA16(k0, q0, s); s = MFMA16(k1, q1, s);
                const f32x4 gk = *(const f32x4*)(GC + step * 64 + rowmap(tau, g, 0));
#pragma unroll
                for (int r = 0; r < 4; ++r) { const int tp = rowmap(tau, g, r); const bool ok = dir ? (tq <= tp) : (tq >= tp); s[r] = ok ? s[r] * __expf(gct - gk[r]) : 0.f; }
                a[hf] = s; }
            *(LAS bf16x8*)(sb + SM_QK + tq * SROW + (32 * kk + 8 * g) * 2) = pack_frag(a[0], a[1]);
        }
    };
    f32x4 S[4]; bf16x8 Sb[2];
#pragma unroll
    for (int t = 0; t < 4; ++t) S[t] = (f32x4){0.f, 0.f, 0.f, 0.f};
    Sb[0] = (bf16x8){0, 0, 0, 0, 0, 0, 0, 0}; Sb[1] = Sb[0];
    issue(0); commit(0);
    if (w >= 4) helper_qk(0, 0);
    __syncthreads();
    for (int step = 0; step < NSTEP; ++step) {
        const int buf = step & 1; LAS unsigned char* sb = F.lds + buf * SM_STAGE;
        if (step + 1 < NSTEP) issue(step + 1);
        if (w < 4) {
            bool lat; int chunk; step_chunk(step, dir, lat, chunk);
            const int vc = 16 * w + i16;
            const LAS float* EG = (const LAS float*)(sb + SM_EG); const LAS float* ED = (const LAS float*)(sb + SM_ED);
            const float gtot = ED[64];
            f32x4 X[4], VN[4], eg[4], ed[4];
            int arow[4];
#pragma unroll
            for (int tau = 0; tau < 4; ++tau) { arow[tau] = 32 * (tau >> 1) + 8 * (i16 >> 2) + 4 * (tau & 1) + (i16 & 3); eg[tau] = *(const LAS f32x4*)(EG + rowmap(tau, g, 0)); ed[tau] = *(const LAS f32x4*)(ED + rowmap(tau, g, 0)); }
#define LDSA(mat, row, kk) (*(const LAS bf16x8*)(sb + (mat) + (row) * SROW + (8 * g + 32 * (kk)) * 2))
#pragma unroll
            for (int tau = 0; tau < 4; ++tau) { f32x4 a = {0.f, 0.f, 0.f, 0.f}; a = MFMA16(LDSA(SM_K, arow[tau], 0), Sb[0], a); a = MFMA16(LDSA(SM_K, arow[tau], 1), Sb[1], a);
#pragma unroll
                for (int r = 0; r < 4; ++r) { const int t = rowmap(tau, g, r); const float v = bf1(*(const LAS unsigned short*)(sb + SM_V + t * SROW + vc * 2)); a[r] = v - eg[tau][r] * a[r]; }
                X[tau] = a; }
            bf16x8 Rb[2]; Rb[0] = pack_frag(X[0], X[1]); Rb[1] = pack_frag(X[2], X[3]);
#pragma unroll
            for (int tau = 0; tau < 4; ++tau) { f32x4 a = {0.f, 0.f, 0.f, 0.f}; a = MFMA16(LDSA(SM_TB, arow[tau], 0), Rb[0], a); a = MFMA16(LDSA(SM_TB, arow[tau], 1), Rb[1], a); VN[tau] = a; }
            bf16x8 Vb[2], Vs[2]; Vb[0] = pack_frag(VN[0], VN[1]); Vb[1] = pack_frag(VN[2], VN[3]);
            Vs[0] = pack_frag(VN[0] * ed[0], VN[1] * ed[1]); Vs[1] = pack_frag(VN[2] * ed[2], VN[3] * ed[3]);
            if (lat) {
#pragma unroll
                for (int tau = 0; tau < 4; ++tau) { f32x4 a = {0.f, 0.f, 0.f, 0.f}; a = MFMA16(LDSA(SM_Q, arow[tau], 0), Sb[0], a); a = MFMA16(LDSA(SM_Q, arow[tau], 1), Sb[1], a);
                    a = a * eg[tau]; a = MFMA16(LDSA(SM_QK, arow[tau], 0), Vb[0], a); a = MFMA16(LDSA(SM_QK, arow[tau], 1), Vb[1], a);
#pragma unroll
                    for (int r = 0; r < 4; ++r) { const int t = rowmap(tau, g, r); OD[((size_t)b * SEQ + chunk * 64 + t) * 512 + h * 64 + vc] = (bf16)f2bf(a[r]); } }
            }
#pragma unroll
            for (int tau = 0; tau < 4; ++tau) { f32x4 a = S[tau] * gtot; a = MFMA16(LDSA(SM_KT, arow[tau], 0), Vs[0], a); a = MFMA16(LDSA(SM_KT, arow[tau], 1), Vs[1], a); S[tau] = a; }
            Sb[0] = pack_frag(S[0], S[1]); Sb[1] = pack_frag(S[2], S[3]);
#undef LDSA
        } else {
            if (step + 1 < NSTEP) helper_qk(step + 1, buf ^ 1);
        }
        if (step + 1 < NSTEP) commit(buf ^ 1);
        __syncthreads();
    }
}
__device__ __forceinline__ void phase_mp(Ctx& F, const Args& A) {
    const int l = F.lane, j = l & 7;
    bf16* OF = (bf16*)(F.dout + DO_OF); const bf16* OB = (const bf16*)(F.dout + DO_OB); const bf16* ZDN = (const bf16*)(F.ws + WS_ZDN);
    float w8[8];
#pragma unroll
    for (int e = 0; e < 8; ++e) w8[e] = A.in[14][8 * j + e];
    for (int m = F.gw; m < ML; m += F.NGW) {
        const size_t off = (size_t)m * 512 + 8 * l; float a[8], bq[8], z[8]; unpack8(*(const u32x4*)(OF + off), a); unpack8(*(const u32x4*)(OB + off), bq); unpack8(*(const u32x4*)(ZDN + off), z);
        float ss = 0.f;
#pragma unroll
        for (int e = 0; e < 8; ++e) { a[e] += bq[e]; ss += a[e] * a[e]; }
        const float r = rsqrtf(red8(ss) * (1.f / 64.f) + EPSF);
#pragma unroll
        for (int e = 0; e < 8; ++e) a[e] = a[e] * r * w8[e] * z[e];
        *(u32x4*)(OF + off) = pack8(a);
    }
}
#define REFRESH(F) do { int t_ = threadIdx.x; asm volatile("" : "+v"(t_)); (F).tid = t_; (F).lane = t_ & 63; } while (0)
__global__ void __launch_bounds__(NTHREADS, 2) fwd_kernel(Args args) {
    extern __shared__ __attribute__((aligned(16))) unsigned char lds_raw[];
    cg::grid_group grid = cg::this_grid();
    Ctx F;
    F.lds = (LAS unsigned char*)lds_raw; F.tid = threadIdx.x; F.lane = F.tid & 63; F.wave = __builtin_amdgcn_readfirstlane(F.tid >> 6);
    F.G = gridDim.x; F.gw = blockIdx.x * NWAVES + F.wave; F.NGW = F.G * NWAVES;
    F.ws = args.ws; F.dout = (unsigned char*)args.out;
    unsigned char* ws = args.ws;

#ifndef SK0
    REFRESH(F); phase0(F, args);
#endif
    grid.sync();
#ifndef SK1
    REFRESH(F); phase1(F, args);
#endif
    grid.sync();
#ifndef SK2
    {
        pg8::Gemm gm{(const pg8::bf16_t*)(ws + WS_XN), (const pg8::bf16_t*)(ws + WS_WIN), MT, NPAD, DM}; pg8::StaticOrder S; S.init(MT, NPAD, F.G, (int)blockIdx.x);
        static_assert(pg8::EPI_BA == WS_BA && pg8::EPI_ZNA == WS_ZNA && pg8::EPI_ZDN == WS_ZDN && pg8::EPI_GNA == WS_GNA && pg8::EPI_GDN == WS_GDN && pg8::EPI_NAK == WS_NAK && pg8::EPI_NAV == WS_NAV && pg8::EPI_DNQKV == WS_DNQKV && DO_Q == 0, "epilogue map");
        pg8::EpiIn E{ws, F.dout};
        pg8::gemm_phase<pg8::EpiIn, pg8::StaticOrder, true, true>(F.lds, gm, S, E);
    }
#endif
    grid.sync();
#ifndef SK3
    REFRESH(F); phase3(F, args);
#endif
    grid.sync();
#ifndef SK4
    REFRESH(F); phase4(F, args);
#endif
    __syncthreads();
#ifndef SK5
    REFRESH(F); phase_na(F, args);
#endif
    grid.sync();
#ifndef SK6
    REFRESH(F); phase_scan(F, args);
#endif
    grid.sync();
#ifndef SK7
    REFRESH(F); phase_mp(F, args);
#endif
    grid.sync();
#ifndef SK8
    {
        pg8::StaticOrder S; S.init(ML, DM, F.G, (int)blockIdx.x);
        pg8::Gemm g1{(const pg8::bf16_t*)(F.dout + DO_Q), (const pg8::bf16_t*)(ws + WS_WONA), ML, DM, 512};
        pg8::EpiGate<0> E1{(const pg8::bf16_t*)(ws + WS_GNA), nullptr, (pg8::bf16_t*)(ws + WS_T1)};
        pg8::gemm_phase<pg8::EpiGate<0>, pg8::StaticOrder, true, true>(F.lds, g1, S, E1);
        __syncthreads();
        pg8::Gemm g2{(const pg8::bf16_t*)(F.dout + DO_OF), (const pg8::bf16_t*)(ws + WS_WODN), ML, DM, 512};
        pg8::EpiGate<1> E2{(const pg8::bf16_t*)(ws + WS_GDN), (const pg8::bf16_t*)(ws + WS_T1), (pg8::bf16_t*)(ws + WS_Y)};
        pg8::gemm_phase<pg8::EpiGate<1>, pg8::StaticOrder, true, true>(F.lds, g2, S, E2);
    }
#endif
    grid.sync();
#ifndef SK9
    {
        pg8::StaticOrder S; S.init(ML, DM, F.G, (int)blockIdx.x);
        pg8::Gemm g3{(const pg8::bf16_t*)(ws + WS_Y), (const pg8::bf16_t*)(ws + WS_WOUT), ML, DM, DM};
        pg8::EpiOut E3{args.in[0], (const float*)(ws + WS_MODV), args.out};
        pg8::gemm_phase<pg8::EpiOut, pg8::StaticOrder, true, true>(F.lds, g3, S, E3);
    }
#endif
}

extern "C" void kernel_launch(void* const* d_in, const int* in_sizes, int n_in, void* d_out, int out_size, void* d_ws, size_t ws_size, hipStream_t stream) {
    static int grid = 0;
    if (grid == 0) {
        if (n_in != 18 || out_size != ML * DM || ws_size < WS_END) { fprintf(stderr, "kernel_launch: unexpected problem (n_in %d, out %d, ws %zu)\n", n_in, out_size, ws_size); grid = -1; return; }
        int dev = 0, cus = 0, per_cu = 0;
        hipGetDevice(&dev); hipDeviceGetAttribute(&cus, hipDeviceAttributeMultiprocessorCount, dev);
        if (hipFuncSetAttribute((const void*)fwd_kernel, hipFuncAttributeMaxDynamicSharedMemorySize, LDS_BYTES) != hipSuccess) { fprintf(stderr, "kernel_launch: hipFuncSetAttribute failed\n"); grid = -1; return; }
        hipOccupancyMaxActiveBlocksPerMultiprocessor(&per_cu, (const void*)fwd_kernel, NTHREADS, LDS_BYTES);
        if (per_cu < 1) { fprintf(stderr, "kernel_launch: occupancy query says %d blocks per CU\n", per_cu); per_cu = 1; }
        (void)hipGetLastError();
        grid = cus;
        if (grid < 64) { fprintf(stderr, "kernel_launch: needs >= 64 CUs\n"); grid = -1; return; }
    }
    if (grid < 0) return;
    Args a{};
    for (int i = 0; i < 18; ++i) a.in[i] = (const float*)d_in[i];
    a.out = (float*)d_out; a.ws = (unsigned char*)d_ws;
    void* kargs[] = {&a};
    hipError_t e = hipLaunchCooperativeKernel((const void*)fwd_kernel, dim3(grid), dim3(NTHREADS), kargs, LDS_BYTES, stream);
    if (e != hipSuccess) fprintf(stderr, "kernel_launch: cooperative launch failed: %s (grid %d)\n", hipGetErrorString(e), grid);
}
```

```cpp
#include <hip/hip_runtime.h>
#include <hip/hip_cooperative_groups.h>
#include <cstdio>
#include <cstdint>
namespace cg = cooperative_groups;
namespace pg8 {
#define PG8_LAS __attribute__((address_space(3)))
typedef unsigned short bf16_t;
typedef short bf16x8 __attribute__((ext_vector_type(8)));
typedef float f32x4 __attribute__((ext_vector_type(4)));
typedef unsigned u32x4 __attribute__((ext_vector_type(4)));
constexpr int BM = 256, BK = 64, HALF = 128, HTB = HALF * BK * 2  , STAGE_BYTES = 8 * HTB, NXCD = 8, WGM = 8;

__host__ __device__ __forceinline__ int lds_byte(int r, int c) { const int st = (r >> 4) * 2 + (c >> 5), rr = r & 15, cc = c & 31, ob = rr * 64 + cc * 2; return st * 1024 + (ob ^ (((ob >> 9) & 1) << 5)); }
__host__ __device__ __forceinline__ void stage_rc(int b, int& R, int& C) { const int st = b / 1024, sb = b % 1024, swz = sb ^ (((sb >> 9) & 1) << 5); R = (st >> 1) * 16 + swz / 64; C = (st & 1) * 32 + (swz % 64) / 2; }
__host__ __device__ __forceinline__ int perm32(int rho) { const int n = rho >> 4, i = rho & 15; return 8 * (i >> 2) + 4 * n + (i & 3); }

struct Unit { int pm, pn; };
struct Gemm { const bf16_t* A; const bf16_t* Bt; int M, N, K; };

struct StaticOrder {
    int nM, nN, nwg, G, c;
    __host__ __device__ void init(int M, int N, int G_, int c_) { nM = M / BM; nN = N / BM; nwg = nM * nN; G = G_; c = c_; }
    __host__ __device__ bool next(int i, Unit& u) const {
        const long L = (long)i * G + c; if (L >= nwg) return false;
        int wgid = (int)L; { const int q = nwg / NXCD, r = nwg % NXCD, xcd = wgid % NXCD, off = wgid / NXCD; wgid = (xcd < r ? xcd * (q + 1) : r * (q + 1) + (xcd - r) * q) + off; }
        const int nig = WGM * nN, gid = wgid / nig, fm = gid * WGM, gsz = (nM - fm) < WGM ? (nM - fm) : WGM;
        u.pm = fm + ((wgid % nig) % gsz); u.pn = (wgid % nig) / gsz; return true;
    }
    __device__ __forceinline__ void a_ready(const Unit&) const {}
    __device__ __forceinline__ void done(const Unit&) const {}
};

__device__ __forceinline__ unsigned cvt_pk_bf16(float lo, float hi) { unsigned r; asm volatile("v_cvt_pk_bf16_f32 %0, %1, %2" : "=v"(r) : "v"(lo), "v"(hi)); return r; }
__device__ __forceinline__ float bflo(unsigned w) { return __builtin_bit_cast(float, w << 16); }
__device__ __forceinline__ float bfhi(unsigned w) { return __builtin_bit_cast(float, w & 0xffff0000u); }
__device__ __forceinline__ float sigmoidf_(float v) { return __builtin_amdgcn_rcpf(1.0f + __expf(-v)); }
constexpr size_t EPI_MiB = 1u << 20, EPI_BA = 18 * EPI_MiB, EPI_ZNA = 24 * EPI_MiB, EPI_ZDN = 56 * EPI_MiB, EPI_GNA = 88 * EPI_MiB, EPI_GDN = 152 * EPI_MiB, EPI_NAK = 216 * EPI_MiB, EPI_NAV = 249 * EPI_MiB, EPI_DNQKV = 282 * EPI_MiB;
struct EpiIn {
    static constexpr bool PERM = true, AFTER_DRAIN = false;
    unsigned char* ws; unsigned char* dout;
    __device__ __forceinline__ void operator()(const f32x4 (&acc)[2][2][4][2], const Unit& u, int wr, int wc, int fr, int fq) const {
        const int pn = u.pn; size_t boff; int ldc, colt, act = 0; bool latent_only = false; float* ba = (float*)(ws + EPI_BA);
        if (pn < 2) { boff = 0; ldc = 512; colt = pn * 256; latent_only = true; }
        else if (pn < 4) { boff = EPI_NAK; ldc = 512; colt = (pn - 2) * 256; }
        else if (pn < 6) { boff = EPI_NAV; ldc = 512; colt = (pn - 4) * 256; }
        else if (pn < 8) { boff = EPI_ZNA; ldc = 512; colt = (pn - 6) * 256; act = 2; latent_only = true; }
        else if (pn < 14) { boff = EPI_DNQKV; ldc = 1536; colt = (pn - 8) * 256; }
        else if (pn < 16) { boff = EPI_ZDN; ldc = 512; colt = (pn - 14) * 256; act = 2; latent_only = true; }
        else if (pn < 20) { boff = EPI_GNA; ldc = 1024; colt = (pn - 16) * 256; act = 1; latent_only = true; }
        else if (pn < 24) { boff = EPI_GDN; ldc = 1024; colt = (pn - 20) * 256; act = 1; latent_only = true; }
        else {
            if (wc == 0) {
#pragma unroll
                for (int ai = 0; ai < 2; ++ai)
#pragma unroll
                    for (int m = 0; m < 4; ++m) { float* rowp = ba + (size_t)(u.pm * BM + ai * HALF + wr * 64 + m * 16 + fr) * 32 + 8 * fq;
                        *(f32x4*)(rowp) = acc[ai][0][m][0]; *(f32x4*)(rowp + 4) = acc[ai][0][m][1]; }
            }
            return;
        }
        if (latent_only && u.pm >= 128) return;
        bf16_t* base = (pn < 2) ? (bf16_t*)dout : (bf16_t*)(ws + boff);
        const int row0 = u.pm * BM + wr * 64 + fr, col0 = colt + wc * 32 + 8 * fq;
#pragma unroll
        for (int ai = 0; ai < 2; ++ai)
#pragma unroll
            for (int m = 0; m < 4; ++m) { bf16_t* rowp = base + (size_t)(row0 + ai * HALF + m * 16) * ldc + col0;
#pragma unroll
                for (int bj = 0; bj < 2; ++bj) { f32x4 v0 = acc[ai][bj][m][0], v1 = acc[ai][bj][m][1];
                    if (act != 0) {
#pragma unroll
                        for (int e = 0; e < 4; ++e) { const float s0 = sigmoidf_(v0[e]), s1 = sigmoidf_(v1[e]); v0[e] = (act == 1) ? s0 : v0[e] * s0; v1[e] = (act == 1) ? s1 : v1[e] * s1; }
                    }
                    u32x4 w; w.x = cvt_pk_bf16(v0[0], v0[1]); w.y = cvt_pk_bf16(v0[2], v0[3]); w.z = cvt_pk_bf16(v1[0], v1[1]); w.w = cvt_pk_bf16(v1[2], v1[3]);
                    *(u32x4*)(rowp + bj * HALF) = w; } }
    }
};
template <int MODE> struct EpiGate {
    static constexpr bool PERM = true, AFTER_DRAIN = false;
    const bf16_t* G; const bf16_t* T1; bf16_t* O;
    __device__ __forceinline__ void operator()(const f32x4 (&acc)[2][2][4][2], const Unit& u, int wr, int wc, int fr, int fq) const {
        const int row0 = u.pm * BM + wr * 64 + fr, col0 = u.pn * BM + wc * 32 + 8 * fq;
#pragma unroll
        for (int ai = 0; ai < 2; ++ai)
#pragma unroll
            for (int m = 0; m < 4; ++m) { const size_t off = (size_t)(row0 + ai * HALF + m * 16) * 1024 + col0;
#pragma unroll
                for (int bj = 0; bj < 2; ++bj) { const f32x4 v0 = acc[ai][bj][m][0], v1 = acc[ai][bj][m][1];
                    const u32x4 g = *(const u32x4*)(G + off + bj * HALF);
                    float o[8] = { v0[0] * bflo(g.x), v0[1] * bfhi(g.x), v0[2] * bflo(g.y), v0[3] * bfhi(g.y), v1[0] * bflo(g.z), v1[1] * bfhi(g.z), v1[2] * bflo(g.w), v1[3] * bfhi(g.w) };
                    if (MODE == 1) { const u32x4 t = *(const u32x4*)(T1 + off + bj * HALF);
                        o[0] += bflo(t.x); o[1] += bfhi(t.x); o[2] += bflo(t.y); o[3] += bfhi(t.y); o[4] += bflo(t.z); o[5] += bfhi(t.z); o[6] += bflo(t.w); o[7] += bfhi(t.w); }
                    u32x4 w; w.x = cvt_pk_bf16(o[0], o[1]); w.y = cvt_pk_bf16(o[2], o[3]); w.z = cvt_pk_bf16(o[4], o[5]); w.w = cvt_pk_bf16(o[6], o[7]);
                    *(u32x4*)(O + off + bj * HALF) = w; } }
    }
};
struct EpiOut {
    static constexpr bool PERM = true, AFTER_DRAIN = false;
    const float* x; const float* modv; float* out;
    __device__ __forceinline__ void operator()(const f32x4 (&acc)[2][2][4][2], const Unit& u, int wr, int wc, int fr, int fq) const {
        const int row0 = u.pm * BM + wr * 64 + fr, col0 = u.pn * BM + wc * 32 + 8 * fq;
        const float* gp = modv + (size_t)(u.pm / 32) * 3072 + 2048 + col0;
        f32x4 gv[2][2];
#pragma unroll
        for (int bj = 0; bj < 2; ++bj)
#pragma unroll
            for (int n = 0; n < 2; ++n) gv[bj][n] = *(const f32x4*)(gp + bj * HALF + 4 * n);
#pragma unroll
        for (int ai = 0; ai < 2; ++ai)
#pragma unroll
            for (int m = 0; m < 4; ++m) { const size_t off = (size_t)(row0 + ai * HALF + m * 16) * 1024 + col0;
#pragma unroll
                for (int bj = 0; bj < 2; ++bj)
#pragma unroll
                    for (int n = 0; n < 2; ++n) { const f32x4 xv = *(const f32x4*)(x + off + bj * HALF + 4 * n);
                        *(f32x4*)(out + off + bj * HALF + 4 * n) = xv + gv[bj][n] * acc[ai][bj][m][n]; } }
    }
};
template <class Epi, class Sched, bool ALIGN_EPI = false, bool SP2 = false>
__device__ __forceinline__ void gemm_phase(PG8_LAS unsigned char* lds, const Gemm g, const Sched& S, const Epi& E) {
    const int tid = threadIdx.x, wid = __builtin_amdgcn_readfirstlane(tid >> 6), lane = tid & 63, wr = wid >> 2, wc = wid & 3, fr = lane & 15, fq = lane >> 4;
    const int K = g.K, nt = K / BK;
    unsigned voffA[2], voffB[2];
#pragma unroll
    for (int i = 0; i < 2; ++i) { int R, C; stage_rc(tid * 16 + i * 8192, R, C); const int Rb = Epi::PERM ? ((R & ~31) + perm32(R & 31)) : R;
        voffA[i] = (unsigned)(R * K + C) * 2u; voffB[i] = (unsigned)(Rb * K + C) * 2u; }
    const size_t kstep = (size_t)(BK * 2);
    const size_t hstep = (size_t)HALF * K * 2;
    const size_t tstep = 2 * hstep;
    const unsigned ldsw = (unsigned)wid * 1024u;
    const int aoff = lds_byte(wr * 64 + fr, fq * 8), boff = lds_byte(wc * 32 + fr, fq * 8);
#define PG8_SA(b, h) (((b) * 2 + (h)) * HTB)
#define PG8_SB(b, h) ((4 + (b) * 2 + (h)) * HTB)
#define PG8_STAGE(bufoff, gbase, voff) do { _Pragma("unroll") for (int _i = 0; _i < 2; ++_i) \
        __builtin_amdgcn_global_load_lds((const unsigned*)((const char*)(gbase) + (voff)[_i]), (PG8_LAS unsigned*)(lds + (bufoff) + ldsw + _i * 8192), 16, 0, 0); } while (0)
#define PG8_LDA(dst, b, h) do { _Pragma("unroll") for (int m = 0; m < 4; ++m) _Pragma("unroll") for (int k = 0; k < 2; ++k) dst[m][k] = *(const PG8_LAS bf16x8*)(lds + PG8_SA(b, h) + aoff + m * 2048 + k * 1024); } while (0)
#define PG8_LDB(dst, b, h) do { _Pragma("unroll") for (int n = 0; n < 2; ++n) _Pragma("unroll") for (int k = 0; k < 2; ++k) dst[n][k] = *(const PG8_LAS bf16x8*)(lds + PG8_SB(b, h) + boff + n * 2048 + k * 1024); } while (0)
#define PG8_MMA(ai, bj, At, Bt) do { __builtin_amdgcn_s_setprio(1); _Pragma("unroll") for (int m = 0; m < 4; ++m) _Pragma("unroll") for (int n = 0; n < 2; ++n) _Pragma("unroll") for (int k = 0; k < 2; ++k) \
        acc[ai][bj][m][n] = __builtin_amdgcn_mfma_f32_16x16x32_bf16(Bt[n][k], At[m][k], acc[ai][bj][m][n], 0, 0, 0); __builtin_amdgcn_s_setprio(0); } while (0)
#define PG8_WAIT_V(n) asm volatile("s_waitcnt vmcnt(" #n ")" ::: "memory")
#define PG8_WAIT_L(n) asm volatile("s_waitcnt lgkmcnt(" #n ")" ::: "memory")
#define PG8_BAR __builtin_amdgcn_s_barrier()
#define PG8_SCHED __builtin_amdgcn_sched_barrier(0)
    Unit cur, nxt; int ui = 0;
    if (!S.next(0, cur)) return;
    f32x4 acc[2][2][4][2];
#pragma unroll
    for (int a = 0; a < 2; ++a)
#pragma unroll
        for (int b = 0; b < 2; ++b)
#pragma unroll
            for (int m = 0; m < 4; ++m)
#pragma unroll
                for (int n = 0; n < 2; ++n) acc[a][b][m][n] = (f32x4){0.f, 0.f, 0.f, 0.f};
    bf16x8 At[4][2], B0[2][2], B1[2][2];
    const char* cA = (const char*)g.A + (size_t)cur.pm * tstep; const char* cB = (const char*)g.Bt + (size_t)cur.pn * tstep;
    S.a_ready(cur);
    if constexpr (SP2) {
        PG8_STAGE(PG8_SB(0, 0), cB, voffB); PG8_STAGE(PG8_SB(0, 1), cB + hstep, voffB); PG8_STAGE(PG8_SA(0, 0), cA, voffA); PG8_STAGE(PG8_SA(0, 1), cA + hstep, voffA);
        if (wr == 1) PG8_BAR;
        PG8_WAIT_V(2); PG8_BAR;
        PG8_STAGE(PG8_SB(1, 0), cB + kstep, voffB); PG8_STAGE(PG8_SA(1, 0), cA + kstep, voffA); PG8_STAGE(PG8_SB(1, 1), cB + hstep + kstep, voffB);
        PG8_WAIT_V(6); PG8_BAR;
    } else {
        PG8_STAGE(PG8_SB(0, 0), cB, voffB); PG8_STAGE(PG8_SA(0, 0), cA, voffA); PG8_STAGE(PG8_SB(0, 1), cB + hstep, voffB); PG8_STAGE(PG8_SA(0, 1), cA + hstep, voffA);
        if (wr == 1) PG8_BAR;
        PG8_WAIT_V(4); PG8_BAR;
        PG8_STAGE(PG8_SB(1, 0), cB + kstep, voffB); PG8_STAGE(PG8_SA(1, 0), cA + kstep, voffA); PG8_STAGE(PG8_SB(1, 1), cB + hstep + kstep, voffB);
        PG8_WAIT_V(6); PG8_BAR;
    }
    for (;;) {
        const bool has_next = S.next(ui + 1, nxt);
        const char* nA = has_next ? (const char*)g.A + (size_t)nxt.pm * tstep : cA; const char* nB = has_next ? (const char*)g.Bt + (size_t)nxt.pn * tstep : cB;
        for (int t = 0; t < nt; t += 2) {
            const bool last = (t == nt - 2);
            const char* a1 = cA + (size_t)(t + 1) * kstep;
            const char* a2 = last ? nA : cA + (size_t)(t + 2) * kstep; const char* b2 = last ? nB : cB + (size_t)(t + 2) * kstep;
            const char* a3 = a2 + kstep; const char* b3 = b2 + kstep;
            if (last && has_next) S.a_ready(nxt);
            if constexpr (SP2) {
            PG8_LDB(B0, 0, 0); PG8_LDB(B1, 0, 1); PG8_SCHED; PG8_LDA(At, 0, 0); PG8_STAGE(PG8_SA(1, 1), a1 + hstep, voffA);
            PG8_WAIT_V(8); PG8_WAIT_L(0); PG8_BAR; PG8_MMA(0, 0, At, B0); PG8_MMA(0, 1, At, B1); PG8_BAR; PG8_SCHED;
            PG8_LDA(At, 0, 1); PG8_STAGE(PG8_SB(0, 0), b2, voffB); PG8_STAGE(PG8_SB(0, 1), b2 + hstep, voffB); PG8_STAGE(PG8_SA(0, 0), a2, voffA);
            PG8_WAIT_V(8); PG8_WAIT_L(0); PG8_BAR; PG8_MMA(1, 0, At, B0); PG8_MMA(1, 1, At, B1); PG8_BAR; PG8_SCHED;
            PG8_LDB(B0, 1, 0); PG8_LDB(B1, 1, 1); PG8_SCHED; PG8_LDA(At, 1, 0); PG8_STAGE(PG8_SA(0, 1), a2 + hstep, voffA);
            PG8_WAIT_V(8); PG8_WAIT_L(0); PG8_BAR; PG8_MMA(0, 0, At, B0); PG8_MMA(0, 1, At, B1); PG8_BAR; PG8_SCHED;
            PG8_LDA(At, 1, 1); PG8_STAGE(PG8_SB(1, 0), b3, voffB); PG8_STAGE(PG8_SB(1, 1), b3 + hstep, voffB); PG8_STAGE(PG8_SA(1, 0), a3, voffA);
            PG8_WAIT_V(8); PG8_WAIT_L(0); PG8_BAR; PG8_MMA(1, 0, At, B0); PG8_MMA(1, 1, At, B1); PG8_BAR; PG8_SCHED;
            } else {
            PG8_LDB(B0, 0, 0); PG8_SCHED; PG8_LDA(At, 0, 0); PG8_STAGE(PG8_SA(1, 1), a1 + hstep, voffA);
            PG8_WAIT_L(8); PG8_BAR; PG8_WAIT_L(0); PG8_MMA(0, 0, At, B0); PG8_BAR; PG8_SCHED;
            PG8_LDB(B1, 0, 1); PG8_STAGE(PG8_SB(0, 0), b2, voffB);
            PG8_BAR; PG8_WAIT_L(0); PG8_MMA(0, 1, At, B1); PG8_BAR;
            PG8_LDA(At, 0, 1); PG8_STAGE(PG8_SA(0, 0), a2, voffA);
            PG8_BAR; PG8_WAIT_L(0); PG8_MMA(1, 0, At, B0); PG8_BAR; PG8_SCHED;
            PG8_STAGE(PG8_SB(0, 1), b2 + hstep, voffB);
            PG8_WAIT_V(6); PG8_BAR; PG8_MMA(1, 1, At, B1); PG8_BAR;
            PG8_LDB(B0, 1, 0); PG8_SCHED; PG8_LDA(At, 1, 0); PG8_STAGE(PG8_SA(0, 1), a2 + hstep, voffA);
            PG8_WAIT_L(8); PG8_BAR; PG8_WAIT_L(0); PG8_MMA(0, 0, At, B0); PG8_BAR; PG8_SCHED;
            PG8_LDB(B1, 1, 1); PG8_STAGE(PG8_SB(1, 0), b3, voffB);
            PG8_BAR; PG8_WAIT_L(0); PG8_MMA(0, 1, At, B1); PG8_BAR;
            PG8_LDA(At, 1, 1); PG8_STAGE(PG8_SA(1, 0), a3, voffA);
            PG8_BAR; PG8_WAIT_L(0); PG8_MMA(1, 0, At, B0); PG8_BAR; PG8_SCHED;
            PG8_STAGE(PG8_SB(1, 1), b3 + hstep, voffB);
            PG8_WAIT_V(6); PG8_BAR; PG8_MMA(1, 1, At, B1); PG8_BAR;
            }
        }
        if constexpr (ALIGN_EPI) { if (wr == 0) PG8_BAR; }
        if constexpr (!Epi::AFTER_DRAIN) { E(acc, cur, wr, wc, fr, fq); S.done(cur); }
        if (!has_next) break;
#pragma unroll
        for (int a = 0; a < 2; ++a)
#pragma unroll
            for (int b = 0; b < 2; ++b)
#pragma unroll
                for (int m = 0; m < 4; ++m)
#pragma unroll
                    for (int n = 0; n < 2; ++n) acc[a][b][m][n] = (f32x4){0.f, 0.f, 0.f, 0.f};
        cur = nxt; cA = nA; cB = nB; ++ui;
        if constexpr (ALIGN_EPI) { if (wr == 1) PG8_BAR; }
    }
    PG8_WAIT_V(0);
    if constexpr (!ALIGN_EPI) { if (wr == 0) PG8_BAR; }
    PG8_BAR;
    if constexpr (Epi::AFTER_DRAIN) { E.fused(acc, cur, wr, wc, fr, fq, lds, wid, lane); S.done(cur); }
#undef PG8_SA
#undef PG8_SB
#undef PG8_STAGE
#undef PG8_LDA
#undef PG8_LDB
#undef PG8_MMA
#undef PG8_WAIT_V
#undef PG8_WAIT_L
#undef PG8_BAR
#undef PG8_SCHED
}
}
constexpr int DM = 1024, NB = 4, SEQ = 8192, CTXL = 256, NH = 8;
constexpr int ML = NB * SEQ, MC = NB * CTXL, MT = ML + MC;
constexpr int NPROJ = 6176, NPAD = 6400;
constexpr int NSTEP = 132;
constexpr float EPSF = 1e-6f;
constexpr int NWAVES = 8, NTHREADS = 512;
constexpr int LDS_BYTES = 135168;
constexpr size_t MiB = 1u << 20;
constexpr size_t WS_MODV = 4096;
constexpr size_t WS_WIN = 1 * MiB;
constexpr size_t WS_WONA = 14 * MiB, WS_WODN = 15 * MiB, WS_WOUT = 16 * MiB;
constexpr size_t WS_BA = 18 * MiB;
constexpr size_t WS_VT8C = 22 * MiB + 512 * 1024;
constexpr size_t WS_ZNA = 24 * MiB, WS_ZDN = 56 * MiB, WS_GNA = 88 * MiB, WS_GDN = 152 * MiB;
constexpr size_t WS_NAK = 216 * MiB, WS_NAV = 249 * MiB, WS_DNQKV = 282 * MiB;
constexpr size_t WS_TB = 282 * MiB, WS_GC = 354 * MiB;
constexpr size_t WS_XN = 381 * MiB;
constexpr size_t WS_DQ = 381 * MiB, WS_DK = 413 * MiB, WS_DKT = 445 * MiB, WS_DV = 477 * MiB;
constexpr size_t WS_DKC = 509 * MiB, WS_DKTC = 510 * MiB, WS_DVC = 511 * MiB;
constexpr size_t WS_T1 = 381 * MiB, WS_Y = 445 * MiB;
constexpr size_t WS_END = 512 * MiB;
constexpr size_t DO_Q = 0, DO_VT8 = 32 * MiB, DO_OF = 64 * MiB, DO_OB = 96 * MiB;

#define LAS __attribute__((address_space(3)))
typedef unsigned short bf16;
typedef unsigned u32x4 __attribute__((ext_vector_type(4)));
typedef unsigned u32x2 __attribute__((ext_vector_type(2)));
typedef float f32x4 __attribute__((ext_vector_type(4)));
typedef short bf16x8 __attribute__((ext_vector_type(8)));
#define LDS_WAIT() asm volatile("s_waitcnt lgkmcnt(0)" ::: "memory")
__device__ __forceinline__ unsigned f2bf(float f) { unsigned u = __builtin_bit_cast(unsigned, f); return (u + 0x7fffu + ((u >> 16) & 1u)) >> 16; }
__device__ __forceinline__ unsigned pk2(float lo, float hi) { return f2bf(lo) | (f2bf(hi) << 16); }
__device__ __forceinline__ float blo(unsigned w) { return __builtin_bit_cast(float, w << 16); }
__device__ __forceinline__ float bhi(unsigned w) { return __builtin_bit_cast(float, w & 0xffff0000u); }
__device__ __forceinline__ float bf1(unsigned short h) { return __builtin_bit_cast(float, ((unsigned)h) << 16); }
__device__ __forceinline__ void unpack8(const u32x4 v, float (&f)[8]) { f[0] = blo(v.x); f[1] = bhi(v.x); f[2] = blo(v.y); f[3] = bhi(v.y); f[4] = blo(v.z); f[5] = bhi(v.z); f[6] = blo(v.w); f[7] = bhi(v.w); }
__device__ __forceinline__ u32x4 pack8(const float (&f)[8]) { u32x4 w; w.x = pk2(f[0], f[1]); w.y = pk2(f[2], f[3]); w.z = pk2(f[4], f[5]); w.w = pk2(f[6], f[7]); return w; }
__device__ __forceinline__ bf16x8 pack_frag(const f32x4 a, const f32x4 b) { u32x4 w; w.x = pk2(a[0], a[1]); w.y = pk2(a[2], a[3]); w.z = pk2(b[0], b[1]); w.w = pk2(b[2], b[3]); return __builtin_bit_cast(bf16x8, w); }
__device__ __forceinline__ float sigm(float v) { return __builtin_amdgcn_rcpf(1.0f + __expf(-v)); }
#define MFMA16(a, b, c) __builtin_amdgcn_mfma_f32_16x16x32_bf16((a), (b), (c), 0, 0, 0)
__device__ __forceinline__ void tr8x8(const u32x4 (&in)[8], u32x4 (&out)[8]) {
#pragma unroll
    for (int e = 0; e < 8; ++e) {
        unsigned w[4];
#pragma unroll
        for (int p = 0; p < 4; ++p) { const unsigned a = in[2 * p][e >> 1], b = in[2 * p + 1][e >> 1];
            w[p] = (e & 1) ? ((a >> 16) | (b & 0xffff0000u)) : ((a & 0xffffu) | (b << 16)); }
        out[e] = (u32x4){w[0], w[1], w[2], w[3]};
    }
}

struct Args { const float* in[18]; float* out; unsigned char* ws; };

struct Ctx {
    LAS unsigned char* lds; int tid, lane, wave, G, gw, NGW;
    unsigned char* ws; unsigned char* dout;
};

__device__ __forceinline__ void p0_transpose_item(const float* W, int K, int N, bf16* WT, int k0, int n0, int dst_row, LAS float* scr, int lane) {
#pragma unroll 8
    for (int i = 0; i < 32; ++i) { const int kk = 2 * i + (lane >> 5); scr[kk * 33 + (lane & 31)] = W[(size_t)(k0 + kk) * N + n0 + (lane & 31)]; }
    LDS_WAIT();
    const int c = lane & 7;
#pragma unroll
    for (int j = 0; j < 4; ++j) { const int n = (lane >> 3) + 8 * j; const LAS float* s = scr + (8 * c) * 33 + n;
        u32x4 o; o.x = pk2(s[0 * 33], s[1 * 33]); o.y = pk2(s[2 * 33], s[3 * 33]); o.z = pk2(s[4 * 33], s[5 * 33]); o.w = pk2(s[6 * 33], s[7 * 33]);
        *(u32x4*)(WT + (size_t)(dst_row + n) * K + k0 + 8 * c) = o; }
    LDS_WAIT();
}
__device__ __forceinline__ void phase0(Ctx& F, const Args& A) {
    if (blockIdx.x < 48) {
        LAS float* sc = (LAS float*)F.lds;
        LAS float* red = (LAS float*)(F.lds + 20480);
        for (int i = F.tid; i < 5 * 1024; i += NTHREADS) { const int v = i >> 10, k = i & 1023; const float cv = (v < 4) ? A.in[1][v * 1024 + k] : A.in[3][k]; sc[i] = cv * sigm(cv); }
        __syncthreads();
        const int n0 = blockIdx.x * 64, kc = F.tid >> 4, c4 = F.tid & 15;
        float acc[5][4];
#pragma unroll
        for (int v = 0; v < 5; ++v)
#pragma unroll
            for (int e = 0; e < 4; ++e) acc[v][e] = 0.f;
#pragma unroll 4
        for (int i = 0; i < 32; ++i) { const int k = kc * 32 + i; const f32x4 w = *(const f32x4*)(A.in[4] + (size_t)k * 3072 + n0 + 4 * c4);
#pragma unroll
            for (int v = 0; v < 5; ++v) { const float s = sc[v * 1024 + k]; acc[v][0] += s * w[0]; acc[v][1] += s * w[1]; acc[v][2] += s * w[2]; acc[v][3] += s * w[3]; } }
#pragma unroll
        for (int v = 0; v < 5; ++v)
#pragma unroll
            for (int e = 0; e < 4; ++e) red[(kc * 5 + v) * 64 + 4 * c4 + e] = acc[v][e];
        __syncthreads();
        if (F.tid < 320) { const int v = F.tid >> 6, col = F.tid & 63; float s = A.in[5][n0 + col];
            for (int k = 0; k < 32; ++k) s += red[(k * 5 + v) * 64 + col];
            ((float*)(F.ws + WS_MODV))[v * 3072 + n0 + col] = s; }
        __syncthreads();
    }
    { u32x4* z = (u32x4*)(F.ws + WS_WIN + (size_t)NPROJ * 1024 * 2); const int n16 = (NPAD - NPROJ) * 1024 * 2 / 16;
      for (int i = blockIdx.x * NTHREADS + F.tid; i < n16; i += F.G * NTHREADS) z[i] = (u32x4){0u, 0u, 0u, 0u}; }
    LAS float* scr = (LAS float*)(F.lds + F.wave * 16384);
    constexpr int I_IN = 16 * 193, I_ONA = 8 * 32, I_ODN = 8 * 32, I_OUT = 16 * 32;
    for (int it = F.gw; it < I_IN + I_ONA + I_ODN + I_OUT; it += F.NGW) {
        int r = it;
        if (r < I_IN) { const int kb = r / 193, nb = r % 193, c0 = 32 * nb; const int dst = (c0 < 4096) ? c0 : ((c0 < 4128) ? 6144 + (c0 - 4096) : c0 - 32);
            p0_transpose_item(A.in[7], 1024, NPROJ, (bf16*)(F.ws + WS_WIN), 64 * kb, c0, dst, scr, F.lane); continue; }
        r -= I_IN;
        if (r < I_ONA) { p0_transpose_item(A.in[15], 512, 1024, (bf16*)(F.ws + WS_WONA), 64 * (r / 32), 32 * (r % 32), 32 * (r % 32), scr, F.lane); continue; }
        r -= I_ONA;
        if (r < I_ODN) { p0_transpose_item(A.in[16], 512, 1024, (bf16*)(F.ws + WS_WODN), 64 * (r / 32), 32 * (r % 32), 32 * (r % 32), scr, F.lane); continue; }
        r -= I_ODN;
        p0_transpose_item(A.in[17], 1024, 1024, (bf16*)(F.ws + WS_WOUT), 64 * (r / 32), 32 * (r % 32), 32 * (r % 32), scr, F.lane);
    }
}
__device__ __forceinline__ float wave_sum(float v) {
#pragma unroll
    for (int o = 1; o < 64; o <<= 1) v += __shfl_xor(v, o);
    return v;
}
__device__ __forceinline__ void phase1(Ctx& F, const Args& A) {
    const float* modv = (const float*)(F.ws + WS_MODV); bf16* XN = (bf16*)(F.ws + WS_XN);
    for (int ch = F.gw; ch < MT / 16; ch += F.NGW) {
        const int row0 = ch * 16; const int b = (row0 < ML) ? row0 / SEQ : 4;
        f32x4 mul[4], add[4];
#pragma unroll
        for (int j = 0; j < 4; ++j) { const int col = 4 * F.lane + 256 * j; const f32x4 nw = *(const f32x4*)(A.in[6] + col), sc = *(const f32x4*)(modv + b * 3072 + 1024 + col);
            mul[j] = nw * (sc + 1.0f); add[j] = *(const f32x4*)(modv + b * 3072 + col); }
        for (int rr = 0; rr < 16; ++rr) {
            const int row = row0 + rr; const float* src = (row < ML) ? A.in[0] + (size_t)row * DM : A.in[2] + (size_t)(row - ML) * DM;
            f32x4 v[4]; float s = 0.f;
#pragma unroll
            for (int j = 0; j < 4; ++j) { v[j] = *(const f32x4*)(src + 4 * F.lane + 256 * j); s += (v[j][0] * v[j][0] + v[j][1] * v[j][1]) + (v[j][2] * v[j][2] + v[j][3] * v[j][3]); }
            const float r = rsqrtf(wave_sum(s) * (1.f / DM) + EPSF);
#pragma unroll
            for (int j = 0; j < 4; ++j) { const f32x4 o = v[j] * r * mul[j] + add[j];
                *(u32x2*)(XN + (size_t)row * DM + 4 * F.lane + 256 * j) = (u32x2){pk2(o[0], o[1]), pk2(o[2], o[3])}; }
        }
    }
}
__device__ __forceinline__ float red8(float v) { v += __shfl_xor(v, 1); v += __shfl_xor(v, 2); v += __shfl_xor(v, 4); return v; }
__device__ __forceinline__ void item_pos(int it, bool& lat, int& m0, int& b, int& t0, int& Tseq) {
    lat = it < ML / 8;
    if (lat) { m0 = it * 8; b = m0 / SEQ; t0 = m0 % SEQ; Tseq = SEQ; } else { const int ci = it - ML / 8; m0 = ML + ci * 8; b = ci / 32; t0 = (ci % 32) * 8; Tseq = CTXL; }
}
__device__ __forceinline__ void phase3(Ctx& F, const Args& A) {
    const int l = F.lane, h = l >> 3, j = l & 7;
    {
        bf16* NAQ = (bf16*)(F.dout + DO_Q); bf16* NAK = (bf16*)(F.ws + WS_NAK); const bf16* NAV = (const bf16*)(F.ws + WS_NAV);
        float wq8[8], wk8[8];
#pragma unroll
        for (int e = 0; e < 8; ++e) { wq8[e] = A.in[9][8 * j + e] * 0.125f; wk8[e] = A.in[10][8 * j + e]; }
        for (int it = F.gw; it < MT / 8; it += F.NGW) {
            bool lat; int m0, b, t0, Tseq; item_pos(it, lat, m0, b, t0, Tseq);
            const int bh = b * 8 + h;
            if (lat) {
#pragma unroll 2
                for (int t = 0; t < 8; ++t) { u32x4* p = (u32x4*)(NAQ + (size_t)(m0 + t) * 512 + 8 * l); float f[8]; unpack8(*p, f); float ss = 0.f;
#pragma unroll
                    for (int e = 0; e < 8; ++e) ss += f[e] * f[e];
                    const float r = rsqrtf(red8(ss) * (1.f / 64.f) + EPSF);
#pragma unroll
                    for (int e = 0; e < 8; ++e) f[e] = f[e] * r * wq8[e];
                    *p = pack8(f); }
            }
#pragma unroll 2
            for (int t = 0; t < 8; ++t) { u32x4* p = (u32x4*)(NAK + (size_t)(m0 + t) * 512 + 8 * l); float f[8]; unpack8(*p, f); float ss = 0.f;
#pragma unroll
                for (int e = 0; e < 8; ++e) ss += f[e] * f[e];
                const float r = rsqrtf(red8(ss) * (1.f / 64.f) + EPSF);
#pragma unroll
                for (int e = 0; e < 8; ++e) f[e] = f[e] * r * wk8[e];
                *p = pack8(f); }
            { u32x4 vin[8], vout[8];
#pragma unroll
              for (int t = 0; t < 8; ++t) vin[t] = *(const u32x4*)(NAV + (size_t)(m0 + t) * 512 + 8 * l);
              tr8x8(vin, vout);
              u32x4* dst = lat ? (u32x4*)(F.dout + DO_VT8) + ((size_t)bh * (SEQ / 8) + t0 / 8) * 64 + 8 * j : (u32x4*)(F.ws + WS_VT8C) + ((size_t)bh * (CTXL / 8) + t0 / 8) * 64 + 8 * j;
#pragma unroll
              for (int e = 0; e < 8; ++e) dst[e] = vout[e]; }
        }
    }
    {
        const bf16* DNQKV = (const bf16*)(F.ws + WS_DNQKV);
        float fr8[8];
#pragma unroll
        for (int e = 0; e < 8; ++e) fr8[e] = exp2f(-(float)(8 * (j & 1) + e) * (13.287712379549449f / 16.0f));
        for (int it2 = F.gw; it2 < 3 * (MT / 8); it2 += F.NGW) {
            const int seg = it2 % 3, it = it2 / 3;
            bool lat; int m0, b, t0, Tseq; item_pos(it, lat, m0, b, t0, Tseq);
            if (seg == 0 && !lat) continue;
            const int bh = b * 8 + h;
            float cw[3][8];
#pragma unroll
            for (int tp = 0; tp < 3; ++tp) { const f32x4 a = *(const f32x4*)(A.in[8] + tp * 1536 + seg * 512 + 8 * l), bq = *(const f32x4*)(A.in[8] + tp * 1536 + seg * 512 + 8 * l + 4);
                cw[tp][0] = a[0]; cw[tp][1] = a[1]; cw[tp][2] = a[2]; cw[tp][3] = a[3]; cw[tp][4] = bq[0]; cw[tp][5] = bq[1]; cw[tp][6] = bq[2]; cw[tp][7] = bq[3]; }
            bf16* dst; if (seg == 0) dst = (bf16*)(F.ws + WS_DQ); else if (seg == 1) dst = lat ? (bf16*)(F.ws + WS_DK) : (bf16*)(F.ws + WS_DKC); else dst = lat ? (bf16*)(F.ws + WS_DV) : (bf16*)(F.ws + WS_DVC);
            const bf16* src = DNQKV + (size_t)m0 * 1536 + seg * 512 + 8 * l;
            u32x4 r0 = (t0 > 0) ? *(const u32x4*)(src - 1536) : (u32x4){0u, 0u, 0u, 0u};
            u32x4 r1 = *(const u32x4*)(src);
#pragma unroll 1
            for (int t = 0; t < 8; ++t) {
                const u32x4 r2 = (t0 + t + 1 < Tseq) ? *(const u32x4*)(src + (size_t)(t + 1) * 1536) : (u32x4){0u, 0u, 0u, 0u};
                float a[8], bq[8], cq[8], y[8]; unpack8(r0, a); unpack8(r1, bq); unpack8(r2, cq);
#pragma unroll
                for (int e = 0; e < 8; ++e) { const float s = cw[0][e] * a[e] + cw[1][e] * bq[e] + cw[2][e] * cq[e]; y[e] = s * sigm(s); }
                if (seg < 2) {
                    float ss = 0.f;
#pragma unroll
                    for (int e = 0; e < 8; ++e) ss += y[e] * y[e];
                    const float r = rsqrtf(red8(ss) + EPSF);
#pragma unroll
                    for (int e = 0; e < 8; ++e) y[e] *= r;
                    if (lat) {
                        const int tok = t0 + t; const float pos = (float)((j < 4) ? (tok >> 6) : (tok & 63));
#pragma unroll
                        for (int e = 0; e < 8; ++e) { const float ang = pos * fr8[e]; const float cs = __cosf(ang), sn = __sinf(ang); const float pr = __shfl_xor(y[e], 2);
                            y[e] = (j & 2) ? (y[e] * cs + pr * sn) : (y[e] * cs - pr * sn); }
                    }
                    if (seg == 0) {
#pragma unroll
                        for (int e = 0; e < 8; ++e) y[e] *= 0.125f;
                    }
                }
                *(u32x4*)(dst + ((size_t)bh * Tseq + t0 + t) * 64 + 8 * j) = pack8(y);
                r0 = r1; r1 = r2;
            }
            if (seg == 1) {
                asm volatile("s_waitcnt vmcnt(0)" ::: "memory");
                u32x4 res[8], kt[8];
#pragma unroll
                for (int t = 0; t < 8; ++t) res[t] = __builtin_nontemporal_load((const u32x4*)(dst + ((size_t)bh * Tseq + t0 + t) * 64 + 8 * j));
                tr8x8(res, kt);
                bf16* kd = lat ? (bf16*)(F.ws + WS_DKT) : (bf16*)(F.ws + WS_DKTC);
#pragma unroll
                for (int e = 0; e < 8; ++e) *(u32x4*)(kd + (((size_t)bh * (Tseq / 64) + t0 / 64) * 64 + 8 * j + e) * 64 + (t0 & 63)) = kt[e];
            }
        }
    }
}
__device__ __forceinline__ void step_chunk(int step, int dir, bool& lat, int& chunk) { if (step < 4) { lat = false; chunk = dir ? 3 - step : step; } else { lat = true; chunk = dir ? 131 - step : step - 4; } }
__host__ __device__ constexpr int tri_off(int i) { return i == 0 ? 0 : (8 * ((i - 1) >> 2) * (((i - 1) >> 2) + 1) + (i - 1 - 4 * ((i - 1) >> 2)) * 4 * (((i - 1) >> 2) + 1)); }
__host__ __device__ constexpr int tri_len(int i) { return i == 0 ? 0 : 4 * (((i - 1) >> 2) + 1); }
constexpr int TRI_FLOATS = 2176;
template <int I> struct SubstRow {
    static __device__ __forceinline__ void run(float (&t)[64], const LAS float* L, float lanef) {
        SubstRow<I - 1>::run(t, L, lanef);
        float s = fmaxf(0.f, 1.f - fabsf(lanef - (float)I));
#pragma unroll
        for (int q = 0; q < tri_len(I) / 4; ++q) { const f32x4 lv = *(const LAS f32x4*)(L + tri_off(I) + 4 * q);
            if (4 * q + 0 < I) s -= lv[0] * t[4 * q + 0];
            if (4 * q + 1 < I) s -= lv[1] * t[4 * q + 1];
            if (4 * q + 2 < I) s -= lv[2] * t[4 * q + 2];
            if (4 * q + 3 < I) s -= lv[3] * t[4 * q + 3]; }
        t[I] = s;
        if ((I & 3) == 3) asm volatile("" ::: "memory");
    }
};
template <> struct SubstRow<-1> { static __device__ __forceinline__ void run(float (&)[64], const LAS float*, float) {} };

__device__ __forceinline__ void phase4(Ctx& F, const Args& A) {
    LAS float* Lt = (LAS float*)(F.lds + F.wave * (TRI_FLOATS * 4));
    const float* BA = (const float*)(F.ws + WS_BA);
    for (int id = F.gw; id < 64 * NSTEP; id += F.NGW) {
        int l = F.lane; asm volatile("" : "+v"(l));
        const int g = l >> 4, i16 = l & 15;
        const int step = id % NSTEP, sd = id / NSTEP, dir = sd & 1, bh = sd >> 1, b = bh >> 3, h = bh & 7;
        bool lat; int chunk; step_chunk(step, dir, lat, chunk);
        const int tl = dir ? 63 - l : l;
        const int m = lat ? b * SEQ + chunk * 64 + tl : ML + b * CTXL + chunk * 64 + tl;
        const float braw = BA[(size_t)m * 32 + dir * 8 + h], araw = BA[(size_t)m * 32 + 16 + dir * 8 + h];
        const float beta = sigm(braw);
        const float xs = araw + A.in[13][dir * 8 + h];
        const float sp = (xs > 15.f) ? xs : log1pf(expf(xs));
        float gc = -expf(A.in[12][dir * 8 + h]) * sp;
#pragma unroll
        for (int o = 1; o < 64; o <<= 1) { const float v = __shfl_up(gc, o); if (l >= o) gc += v; }
        ((float*)(F.ws + WS_GC))[(size_t)id * 64 + tl] = gc;
        const bf16* Kt = lat ? (const bf16*)(F.ws + WS_DK) + ((size_t)bh * SEQ + chunk * 64) * 64 : (const bf16*)(F.ws + WS_DKC) + ((size_t)bh * CTXL + chunk * 64) * 64;
        bf16x8 Kf[4][2];
#pragma unroll
        for (int it = 0; it < 4; ++it)
#pragma unroll
            for (int kk = 0; kk < 2; ++kk) { const int li = 16 * it + i16; const int tk = dir ? 63 - li : li; Kf[it][kk] = *(const bf16x8*)(Kt + tk * 64 + 8 * g + 32 * kk); }
#pragma unroll
        for (int it = 0; it < 4; ++it) {
            float gci[4], bti[4];
#pragma unroll
            for (int r = 0; r < 4; ++r) { gci[r] = __shfl(gc, 16 * it + 4 * g + r); bti[r] = __shfl(beta, 16 * it + 4 * g + r); }
#pragma unroll
            for (int jt = 0; jt <= it; ++jt) {
                f32x4 a = {0.f, 0.f, 0.f, 0.f};
                a = MFMA16(Kf[it][0], Kf[jt][0], a); a = MFMA16(Kf[it][1], Kf[jt][1], a);
                const int jj = 16 * jt + i16; const float gcj = __shfl(gc, jj);
#pragma unroll
                for (int r = 0; r < 4; ++r) { const int ii = 16 * it + 4 * g + r; const int q = (ii - 1) >> 2; const int len = (ii == 0) ? 0 : 4 * (q + 1);
                    const int off = (ii == 0) ? 0 : (8 * q * (q + 1) + (ii - 1 - 4 * q) * 4 * (q + 1));
                    if (jj < len) Lt[off + jj] = (jj < ii) ? bti[r] * a[r] * __expf(gci[r] - gcj) : 0.f; }
            }
        }
        LDS_WAIT();
        float t[64];
        SubstRow<63>::run(t, Lt, (float)l);
        asm volatile("" ::: "memory");
        bf16* TB = (bf16*)(F.ws + WS_TB) + (size_t)id * 4096;
#pragma unroll
        for (int i = 0; i < 64; ++i) { const int ti = dir ? 63 - i : i; TB[ti * 64 + tl] = (bf16)f2bf(t[i] * beta); }
        LDS_WAIT();
    }
}
__device__ __forceinline__ void phase_na(Ctx& F, const Args& A) {
    const int l = F.lane, g = l >> 4, i16 = l & 15;
    LAS float* rp = (LAS float*)F.lds;
    for (int i = F.tid; i < 8 * 465; i += NTHREADS) rp[i] = A.in[11][i];
    float mq = fabsf(A.in[9][l]), mk = fabsf(A.in[10][l]), mr = 0.f;
    for (int i = l; i < 8 * 465; i += 64) mr = fmaxf(mr, fabsf(A.in[11][i]));
#pragma unroll
    for (int o = 1; o < 64; o <<= 1) { mq = fmaxf(mq, __shfl_xor(mq, o)); mk = fmaxf(mk, __shfl_xor(mk, o)); mr = fmaxf(mr, __shfl_xor(mr, o)); }
    const float mb = 8.0f * mq * mk + mr;
    __syncthreads();
    bf16* Q = (bf16*)(F.dout + DO_Q); const bf16* Kn = (const bf16*)(F.ws + WS_NAK); const bf16* ZNA = (const bf16*)(F.ws + WS_ZNA);
    const u32x4* VTL = (const u32x4*)(F.dout + DO_VT8); const u32x4* VTC = (const u32x4*)(F.ws + WS_VT8C);
    const int key0 = 8 * (i16 >> 2) + (i16 & 3);
    for (int task = F.gw; task < NB * NH * 128 * 4; task += F.NGW) {
        const int jq = task & 3, r = (task >> 2) & 127, bh = task >> 9, b = bh >> 3, h = bh & 7;
        const int q0 = 16 * jq, kc0 = (jq == 0) ? 0 : ((jq == 1) ? 8 : ((jq == 2) ? 24 : 32));
        const int r0 = min(max(r - 4, 0), 120);
        const size_t mq_row = (size_t)b * SEQ + r * 64 + q0 + i16;
        bf16x8 Qf[2];
#pragma unroll
        for (int kk = 0; kk < 2; ++kk) Qf[kk] = *(const bf16x8*)(Q + mq_row * 512 + h * 64 + 8 * g + 32 * kk);
        const int cq = q0 + i16, c0 = min(max(cq - 8, 0), 48);
        f32x4 O[4]; float lsum = 0.f;
#pragma unroll
        for (int dt = 0; dt < 4; ++dt) O[dt] = (f32x4){0.f, 0.f, 0.f, 0.f};
        const LAS float* rph = rp + h * 465;
#pragma unroll 2
        for (int y = 0; y < 8; ++y) {
            const int trow = r0 + y; const size_t tk0 = (size_t)b * SEQ + trow * 64 + kc0;
            const bf16* kp = Kn + (tk0 + key0) * 512 + h * 64 + 8 * g;
            const bf16x8 ka0 = *(const bf16x8*)(kp), ka1 = *(const bf16x8*)(kp + 32), kb0 = *(const bf16x8*)(kp + 4 * 512), kb1 = *(const bf16x8*)(kp + 4 * 512 + 32);
            const u32x4* vp = VTL + ((size_t)bh * (SEQ / 8) + (trow * 64 + kc0) / 8 + g) * 64 + i16;
            bf16x8 vf[4];
#pragma unroll
            for (int dt = 0; dt < 4; ++dt) vf[dt] = __builtin_bit_cast(bf16x8, vp[16 * dt]);
            f32x4 s0 = {0.f, 0.f, 0.f, 0.f}, s1 = {0.f, 0.f, 0.f, 0.f};
            s0 = MFMA16(ka0, Qf[0], s0); s0 = MFMA16(ka1, Qf[1], s0); s1 = MFMA16(kb0, Qf[0], s1); s1 = MFMA16(kb1, Qf[1], s1);
            const LAS float* rrow = rph + (trow - r + 7) * 31 + 15;
#pragma unroll
            for (int rr = 0; rr < 4; ++rr) {
                const int ck0 = kc0 + 8 * g + rr, ck1 = ck0 + 4;
                const int dx0 = min(max(ck0 - cq, -15), 15), dx1 = min(max(ck1 - cq, -15), 15);
                const float p0 = (ck0 >= c0 && ck0 < c0 + 16) ? __expf(s0[rr] + rrow[dx0] - mb) : 0.f;
                const float p1 = (ck1 >= c0 && ck1 < c0 + 16) ? __expf(s1[rr] + rrow[dx1] - mb) : 0.f;
                s0[rr] = p0; s1[rr] = p1; lsum += p0 + p1;
            }
            const bf16x8 pf = pack_frag(s0, s1);
#pragma unroll
            for (int dt = 0; dt < 4; ++dt) O[dt] = MFMA16(vf[dt], pf, O[dt]);
        }
#pragma unroll 2
        for (int cb = 0; cb < 8; ++cb) {
            const size_t tk0 = (size_t)ML + b * CTXL + cb * 32;
            const bf16* kp = Kn + (tk0 + key0) * 512 + h * 64 + 8 * g;
            const bf16x8 ka0 = *(const bf16x8*)(kp), ka1 = *(const bf16x8*)(kp + 32), kb0 = *(const bf16x8*)(kp + 4 * 512), kb1 = *(const bf16x8*)(kp + 4 * 512 + 32);
            const u32x4* vp = VTC + ((size_t)bh * (CTXL / 8) + cb * 4 + g) * 64 + i16;
            bf16x8 vf[4];
#pragma unroll
            for (int dt = 0; dt < 4; ++dt) vf[dt] = __builtin_bit_cast(bf16x8, vp[16 * dt]);
            f32x4 s0 = {0.f, 0.f, 0.f, 0.f}, s1 = {0.f, 0.f, 0.f, 0.f};
            s0 = MFMA16(ka0, Qf[0], s0); s0 = MFMA16(ka1, Qf[1], s0); s1 = MFMA16(kb0, Qf[0], s1); s1 = MFMA16(kb1, Qf[1], s1);
#pragma unroll
            for (int rr = 0; rr < 4; ++rr) { const float p0 = __expf(s0[rr] - mb), p1 = __expf(s1[rr] - mb); s0[rr] = p0; s1[rr] = p1; lsum += p0 + p1; }
            const bf16x8 pf = pack_frag(s0, s1);
#pragma unroll
            for (int dt = 0; dt < 4; ++dt) O[dt] = MFMA16(vf[dt], pf, O[dt]);
        }
        lsum += __shfl_xor(lsum, 16); lsum += __shfl_xor(lsum, 32);
        const float inv = 1.0f / lsum;
#pragma unroll
        for (int dt = 0; dt < 4; ++dt) { const size_t off = mq_row * 512 + h * 64 + 16 * dt + 4 * g; const u32x2 z = *(const u32x2*)(ZNA + off);
            *(u32x2*)(Q + off) = (u32x2){pk2(O[dt][0] * inv * blo(z.x), O[dt][1] * inv * bhi(z.x)), pk2(O[dt][2] * inv * blo(z.y), O[dt][3] * inv * bhi(z.y))}; }
    }
}
constexpr int SROW = 144;
constexpr int SM_K = 0, SM_KT = 9216, SM_Q = 18432, SM_V = 27648, SM_TB = 36864, SM_QK = 46080, SM_EG = 55296, SM_ED = 55552, SM_STAGE = 56320;
__device__ __forceinline__ int rowmap(int tau, int g, int r) { return 32 * (tau >> 1) + 8 * g + 4 * (tau & 1) + r; }
__device__ __forceinline__ void phase_scan(Ctx& F, const Args& A) {
    if (blockIdx.x >= 64) return;
    const int l = F.lane, g = l >> 4, i16 = l & 15, w = F.wave, tid = F.tid;
    const int sd = blockIdx.x, dir = sd & 1, bh = sd >> 1, b = bh >> 3, h = bh & 7;
    const float* GC = (const float*)(F.ws + WS_GC) + (size_t)sd * NSTEP * 64;
    const bf16* TBg = (const bf16*)(F.ws + WS_TB) + (size_t)sd * NSTEP * 4096;
    bf16* OD = (bf16*)(F.dout + (dir ? DO_OB : DO_OF));
    const int srow = tid >> 3, spc = tid & 7; const int sdst = srow * SROW + spc * 16;
    u32x4 stg[5]; float sgc = 0.f, sgl = 0.f;
    auto issue = [&](int step) {
        bool lat; int chunk; step_chunk(step, dir, lat, chunk);
        const u32x4* pk = lat ? (const u32x4*)((const bf16*)(F.ws + WS_DK) + ((size_t)bh * SEQ + chunk * 64) * 64) : (const u32x4*)((const bf16*)(F.ws + WS_DKC) + ((size_t)bh * CTXL + chunk * 64) * 64);
        const u32x4* pkt = lat ? (const u32x4*)((const bf16*)(F.ws + WS_DKT) + ((size_t)bh * 128 + chunk) * 4096) : (const u32x4*)((const bf16*)(F.ws + WS_DKTC) + ((size_t)bh * 4 + chunk) * 4096);
        const u32x4* pv = lat ? (const u32x4*)((const bf16*)(F.ws + WS_DV) + ((size_t)bh * SEQ + chunk * 64) * 64) : (const u32x4*)((const bf16*)(F.ws + WS_DVC) + ((size_t)bh * CTXL + chunk * 64) * 64);
        stg[0] = pk[tid]; stg[1] = pkt[tid]; stg[3] = pv[tid]; stg[4] = ((const u32x4*)(TBg + (size_t)step * 4096))[tid];
        stg[2] = lat ? ((const u32x4*)((const bf16*)(F.ws + WS_DQ) + ((size_t)bh * SEQ + chunk * 64) * 64))[tid] : (u32x4){0u, 0u, 0u, 0u};
        if (tid < 64) { sgc = GC[step * 64 + tid]; sgl = GC[step * 64 + (dir ? 0 : 63)]; }
    };
    auto commit = [&](int buf) {
        LAS unsigned char* sb = F.lds + buf * SM_STAGE;
        *(LAS u32x4*)(sb + SM_K + sdst) = stg[0]; *(LAS u32x4*)(sb + SM_KT + sdst) = stg[1]; *(LAS u32x4*)(sb + SM_Q + sdst) = stg[2]; *(LAS u32x4*)(sb + SM_V + sdst) = stg[3]; *(LAS u32x4*)(sb + SM_TB + sdst) = stg[4];
        if (tid < 64) { ((LAS float*)(sb + SM_EG))[tid] = __expf(sgc); ((LAS float*)(sb + SM_ED))[tid] = __expf(sgl - sgc); if (tid == 0) ((LAS float*)(sb + SM_ED))[64] = __expf(sgl); }
    };
    auto helper_qk = [&](int step, int buf) {
        bool lat; int chunk; step_chunk(step, dir, lat, chunk);
        if (!lat) return;
        const int hw = w - 4;
        const bf16* Kt = (const bf16*)(F.ws + WS_DK) + ((size_t)bh * SEQ + chunk * 64) * 64; const bf16* Qt = (const bf16*)(F.ws + WS_DQ) + ((size_t)bh * SEQ + chunk * 64) * 64;
        const int tq = 16 * hw + i16;
        const bf16x8 q0 = *(const bf16x8*)(Qt + tq * 64 + 8 * g), q1 = *(const bf16x8*)(Qt + tq * 64 + 8 * g + 32);
        const float gct = GC[step * 64 + tq];
        LAS unsigned char* sb = F.lds + buf * SM_STAGE;
#pragma unroll
        for (int kk = 0; kk < 2; ++kk) {
            f32x4 a[2];
#pragma unroll
            for (int hf = 0; hf < 2; ++hf) { const int tau = 2 * kk + hf; const int tr = 32 * kk + 8 * (i16 >> 2) + 4 * hf + (i16 & 3);
                const bf16x8 k0 = *(const bf16x8*)(Kt + tr * 64 + 8 * g), k1 = *(const bf16x8*)(Kt + tr * 64 + 8 * g + 32);
                f32x4 s = {0.f, 0.f, 0.f, 0.f}; s = MFMA16(k0, q0, s); s = MFMA16(k1, q1, s);
                const f32x4 gk = *(const f32x4*)(GC + step * 64 + rowmap(tau, g, 0));
#pragma unroll
                for (int r = 0; r < 4; ++r) { const int tp = rowmap(tau, g, r); const bool ok = dir ? (tq <= tp) : (tq >= tp); s[r] = ok ? s[r] * __expf(gct - gk[r]) : 0.f; }
                a[hf] = s; }
            *(LAS bf16x8*)(sb + SM_QK + tq * SROW + (32 * kk + 8 * g) * 2) = pack_frag(a[0], a[1]);
        }
    };
    f32x4 S[4]; bf16x8 Sb[2];
#pragma unroll
    for (int t = 0; t < 4; ++t) S[t] = (f32x4){0.f, 0.f, 0.f, 0.f};
    Sb[0] = (bf16x8){0, 0, 0, 0, 0, 0, 0, 0}; Sb[1] = Sb[0];
    issue(0); commit(0);
    if (w >= 4) helper_qk(0, 0);
    __syncthreads();
    for (int step = 0; step < NSTEP; ++step) {
        const int buf = step & 1; LAS unsigned char* sb = F.lds + buf * SM_STAGE;
        if (step + 1 < NSTEP) issue(step + 1);
        if (w < 4) {
            bool lat; int chunk; step_chunk(step, dir, lat, chunk);
            const int vc = 16 * w + i16;
            const LAS float* EG = (const LAS float*)(sb + SM_EG); const LAS float* ED = (const LAS float*)(sb + SM_ED);
            const float gtot = ED[64];
            f32x4 X[4], VN[4], eg[4], ed[4];
            int arow[4];
#pragma unroll
            for (int tau = 0; tau < 4; ++tau) { arow[tau] = 32 * (tau >> 1) + 8 * (i16 >> 2) + 4 * (tau & 1) + (i16 & 3); eg[tau] = *(const LAS f32x4*)(EG + rowmap(tau, g, 0)); ed[tau] = *(const LAS f32x4*)(ED + rowmap(tau, g, 0)); }
#define LDSA(mat, row, kk) (*(const LAS bf16x8*)(sb + (mat) + (row) * SROW + (8 * g + 32 * (kk)) * 2))
#pragma unroll
            for (int tau = 0; tau < 4; ++tau) { f32x4 a = {0.f, 0.f, 0.f, 0.f}; a = MFMA16(LDSA(SM_K, arow[tau], 0), Sb[0], a); a = MFMA16(LDSA(SM_K, arow[tau], 1), Sb[1], a);
#pragma unroll
                for (int r = 0; r < 4; ++r) { const int t = rowmap(tau, g, r); const float v = bf1(*(const LAS unsigned short*)(sb + SM_V + t * SROW + vc * 2)); a[r] = v - eg[tau][r] * a[r]; }
                X[tau] = a; }
            bf16x8 Rb[2]; Rb[0] = pack_frag(X[0], X[1]); Rb[1] = pack_frag(X[2], X[3]);
#pragma unroll
            for (int tau = 0; tau < 4; ++tau) { f32x4 a = {0.f, 0.f, 0.f, 0.f}; a = MFMA16(LDSA(SM_TB, arow[tau], 0), Rb[0], a); a = MFMA16(LDSA(SM_TB, arow[tau], 1), Rb[1], a); VN[tau] = a; }
            bf16x8 Vb[2], Vs[2]; Vb[0] = pack_frag(VN[0], VN[1]); Vb[1] = pack_frag(VN[2], VN[3]);
            Vs[0] = pack_frag(VN[0] * ed[0], VN[1] * ed[1]); Vs[1] = pack_frag(VN[2] * ed[2], VN[3] * ed[3]);
            if (lat) {
#pragma unroll
                for (int tau = 0; tau < 4; ++tau) { f32x4 a = {0.f, 0.f, 0.f, 0.f}; a = MFMA16(LDSA(SM_Q, arow[tau], 0), Sb[0], a); a = MFMA16(LDSA(SM_Q, arow[tau], 1), Sb[1], a);
                    a = a * eg[tau]; a = MFMA16(LDSA(SM_QK, arow[tau], 0), Vb[0], a); a = MFMA16(LDSA(SM_QK, arow[tau], 1), Vb[1], a);
#pragma unroll
                    for (int r = 0; r < 4; ++r) { const int t = rowmap(tau, g, r); OD[((size_t)b * SEQ + chunk * 64 + t) * 512 + h * 64 + vc] = (bf16)f2bf(a[r]); } }
            }
#pragma unroll
            for (int tau = 0; tau < 4; ++tau) { f32x4 a = S[tau] * gtot; a = MFMA16(LDSA(SM_KT, arow[tau], 0), Vs[0], a); a = MFMA16(LDSA(SM_KT, arow[tau], 1), Vs[1], a); S[tau] = a; }
            Sb[0] = pack_frag(S[0], S[1]); Sb[1] = pack_frag(S[2], S[3]);
#undef LDSA
        } else {
            if (step + 1 < NSTEP) helper_qk(step + 1, buf ^ 1);
        }
        if (step + 1 < NSTEP) commit(buf ^ 1);
        __syncthreads();
    }
}
__device__ __forceinline__ void phase_mp(Ctx& F, const Args& A) {
    const int l = F.lane, j = l & 7;
    bf16* OF = (bf16*)(F.dout + DO_OF); const bf16* OB = (const bf16*)(F.dout + DO_OB); const bf16* ZDN = (const bf16*)(F.ws + WS_ZDN);
    float w8[8];
#pragma unroll
    for (int e = 0; e < 8; ++e) w8[e] = A.in[14][8 * j + e];
    for (int m = F.gw; m < ML; m += F.NGW) {
        const size_t off = (size_t)m * 512 + 8 * l; float a[8], bq[8], z[8]; unpack8(*(const u32x4*)(OF + off), a); unpack8(*(const u32x4*)(OB + off), bq); unpack8(*(const u32x4*)(ZDN + off), z);
        float ss = 0.f;
#pragma unroll
        for (int e = 0; e < 8; ++e) { a[e] += bq[e]; ss += a[e] * a[e]; }
        const float r = rsqrtf(red8(ss) * (1.f / 64.f) + EPSF);
#pragma unroll
        for (int e = 0; e < 8; ++e) a[e] = a[e] * r * w8[e] * z[e];
        *(u32x4*)(OF + off) = pack8(a);
    }
}
constexpr size_t WS_CTL = 65536, CTL_BYTES = 16384;
constexpr int LDS_MISC = 131072;
#define XB_TMO      128
#define XB_XCNT(j)  (256  + 64 * (j))
#define XB_XSUB(j)  (1280 + 64 * (j))
#define XB_XGEN(j)  (2304 + 64 * (j))
#define XB_TOP      3328
#define XB_TOPGEN   3392
#define XCD_BAR_WORDS 3456
#define XB_SPIN_CAP (1u << 18)

__device__ __forceinline__ unsigned xb_ld(unsigned* p)              { return __hip_atomic_load(p, __ATOMIC_RELAXED, __HIP_MEMORY_SCOPE_AGENT); }
__device__ __forceinline__ unsigned xb_add(unsigned* p, unsigned v) { return __hip_atomic_fetch_add(p, v, __ATOMIC_RELAXED, __HIP_MEMORY_SCOPE_AGENT); }
__device__ __forceinline__ unsigned xb_xcc_id() { return (unsigned)__builtin_amdgcn_s_getreg((3 << 11) | 20) & 0xFu; }
#define XB_SPIN(cond, bar) do { unsigned _sp = 0; while (cond) { __builtin_amdgcn_s_sleep(1); \
    if ((++_sp & 255u) == 0u) { if (xb_ld(&(bar)[XB_TMO])) break; if (_sp > XB_SPIN_CAP) { atomicAdd(&(bar)[XB_TMO], 1u); break; } } } } while (0)

struct XcdBarrier {
    unsigned* bar; unsigned x;
    volatile LAS unsigned* st;
};

__device__ __forceinline__ XcdBarrier xcd_barrier_post(unsigned* bar, volatile LAS unsigned* st) {
    XcdBarrier b; b.bar = bar; b.x = xb_xcc_id(); b.st = st;
    if (threadIdx.x == 0) (void)xb_add(&bar[XB_XCNT(b.x)], 1u);
    return b;
}
__device__ __forceinline__ void xcd_barrier_complete(unsigned* bar, unsigned x, unsigned& nloc, unsigned& nx) {
    const unsigned G = gridDim.x * gridDim.y * gridDim.z;
    unsigned sum, cnt, mine, sp = 0u;
    for (;;) {
        sum = 0u; cnt = 0u; mine = 0u;
#pragma unroll
        for (unsigned j = 0; j < 16; ++j) { const unsigned c = xb_ld(&bar[XB_XCNT(j)]); sum += c; cnt += (c > 0u) ? 1u : 0u; mine = (j == x) ? c : mine; }
        if (sum == G) break;
        __builtin_amdgcn_s_sleep(1);
        if ((++sp & 255u) == 0u) { if (xb_ld(&bar[XB_TMO])) break; if (sp > XB_SPIN_CAP) { atomicAdd(&bar[XB_TMO], 1u); break; } }
    }
    nloc = mine > 0u ? mine : 1u; nx = cnt > 0u ? cnt : 1u;
}

__device__ __forceinline__ void xcd_barrier(const XcdBarrier& b) {
    asm volatile("s_waitcnt vmcnt(0)" ::: "memory");
    __syncthreads();
    if (threadIdx.x == 0) {
        unsigned* bar = b.bar;
        __builtin_amdgcn_s_waitcnt(0);
        unsigned nloc = b.st[0], nx = b.st[1];
        if (nloc == 0u) { xcd_barrier_complete(bar, b.x, nloc, nx); b.st[0] = nloc; b.st[1] = nx; }
        const unsigned old = xb_add(&bar[XB_XSUB(b.x)], 1u);
        const unsigned gen = old / nloc;
        if (old + 1u == (gen + 1u) * nloc) {
            __builtin_amdgcn_fence(__ATOMIC_RELEASE, "agent");
            asm volatile("s_waitcnt vmcnt(0)" ::: "memory");
            const unsigned og = xb_add(&bar[XB_TOP], 1u);
            const unsigned tg = og / nx;
            if (og + 1u == (tg + 1u) * nx) xb_add(&bar[XB_TOPGEN], 1u);
            else XB_SPIN(xb_ld(&bar[XB_TOPGEN]) == tg, bar);
            __builtin_amdgcn_fence(__ATOMIC_ACQUIRE, "agent");
            xb_add(&bar[XB_XGEN(b.x)], 1u);
            asm volatile("s_waitcnt vmcnt(0)" ::: "memory");
        } else {
            XB_SPIN(xb_ld(&bar[XB_XGEN(b.x)]) == gen, bar);
            __builtin_amdgcn_fence(__ATOMIC_ACQUIRE, "agent");
            asm volatile("s_waitcnt vmcnt(0)" ::: "memory");
        }
    }
    __syncthreads();
}

#define REFRESH(F) do { int t_ = threadIdx.x; asm volatile("" : "+v"(t_)); (F).tid = t_; (F).lane = t_ & 63; } while (0)
__global__ void __launch_bounds__(NTHREADS, 2) fwd_kernel(Args args) {
    extern __shared__ __attribute__((aligned(16))) unsigned char lds_raw[];
    cg::grid_group grid = cg::this_grid();
    Ctx F;
    F.lds = (LAS unsigned char*)lds_raw; F.tid = threadIdx.x; F.lane = F.tid & 63; F.wave = __builtin_amdgcn_readfirstlane(F.tid >> 6);
    F.G = gridDim.x; F.gw = blockIdx.x * NWAVES + F.wave; F.NGW = F.G * NWAVES;
    F.ws = args.ws; F.dout = (unsigned char*)args.out;
    unsigned char* ws = args.ws;
    if (F.tid < 8) ((volatile LAS unsigned*)(F.lds + LDS_MISC))[F.tid] = 0u;
    __syncthreads();
    const XcdBarrier bar = xcd_barrier_post((unsigned*)(ws + WS_CTL), (volatile LAS unsigned*)(F.lds + LDS_MISC));

#ifndef SK0
    REFRESH(F); phase0(F, args);
#endif
    grid.sync();
#ifndef SK1
    REFRESH(F); phase1(F, args);
#endif
    xcd_barrier(bar);
#ifndef SK2
    {
        pg8::Gemm gm{(const pg8::bf16_t*)(ws + WS_XN), (const pg8::bf16_t*)(ws + WS_WIN), MT, NPAD, DM}; pg8::StaticOrder S; S.init(MT, NPAD, F.G, (int)blockIdx.x);
        static_assert(pg8::EPI_BA == WS_BA && pg8::EPI_ZNA == WS_ZNA && pg8::EPI_ZDN == WS_ZDN && pg8::EPI_GNA == WS_GNA && pg8::EPI_GDN == WS_GDN && pg8::EPI_NAK == WS_NAK && pg8::EPI_NAV == WS_NAV && pg8::EPI_DNQKV == WS_DNQKV && DO_Q == 0, "epilogue map");
        pg8::EpiIn E{ws, F.dout};
        pg8::gemm_phase<pg8::EpiIn, pg8::StaticOrder, true, true>(F.lds, gm, S, E);
    }
#endif
    xcd_barrier(bar);
#ifndef SK3
    REFRESH(F); phase3(F, args);
#endif
    xcd_barrier(bar);
#ifndef SK4
    REFRESH(F); phase4(F, args);
#endif
    __syncthreads();
#ifndef SK5
    REFRESH(F); phase_na(F, args);
#endif
    xcd_barrier(bar);
#ifndef SK6
    REFRESH(F); phase_scan(F, args);
#endif
    xcd_barrier(bar);
#ifndef SK7
    REFRESH(F); phase_mp(F, args);
#endif
    xcd_barrier(bar);
#ifndef SK8
    {
        pg8::StaticOrder S; S.init(ML, DM, F.G, (int)blockIdx.x);
        pg8::Gemm g1{(const pg8::bf16_t*)(F.dout + DO_Q), (const pg8::bf16_t*)(ws + WS_WONA), ML, DM, 512};
        pg8::EpiGate<0> E1{(const pg8::bf16_t*)(ws + WS_GNA), nullptr, (pg8::bf16_t*)(ws + WS_T1)};
        pg8::gemm_phase<pg8::EpiGate<0>, pg8::StaticOrder, true, true>(F.lds, g1, S, E1);
        __syncthreads();
        pg8::Gemm g2{(const pg8::bf16_t*)(F.dout + DO_OF), (const pg8::bf16_t*)(ws + WS_WODN), ML, DM, 512};
        pg8::EpiGate<1> E2{(const pg8::bf16_t*)(ws + WS_GDN), (const pg8::bf16_t*)(ws + WS_T1), (pg8::bf16_t*)(ws + WS_Y)};
        pg8::gemm_phase<pg8::EpiGate<1>, pg8::StaticOrder, true, true>(F.lds, g2, S, E2);
    }
#endif
    xcd_barrier(bar);
#ifndef SK9
    {
        pg8::StaticOrder S; S.init(ML, DM, F.G, (int)blockIdx.x);
        pg8::Gemm g3{(const pg8::bf16_t*)(ws + WS_Y), (const pg8::bf16_t*)(ws + WS_WOUT), ML, DM, DM};
        pg8::EpiOut E3{args.in[0], (const float*)(ws + WS_MODV), args.out};
        pg8::gemm_phase<pg8::EpiOut, pg8::StaticOrder, true, true>(F.lds, g3, S, E3);
    }
#endif
}

extern "C" void kernel_launch(void* const* d_in, const int* in_sizes, int n_in, void* d_out, int out_size, void* d_ws, size_t ws_size, hipStream_t stream) {
    static int grid = 0;
    if (grid == 0) {
        if (n_in != 18 || out_size != ML * DM || ws_size < WS_END) { fprintf(stderr, "kernel_launch: unexpected problem (n_in %d, out %d, ws %zu)\n", n_in, out_size, ws_size); grid = -1; return; }
        int dev = 0, cus = 0, per_cu = 0;
        hipGetDevice(&dev); hipDeviceGetAttribute(&cus, hipDeviceAttributeMultiprocessorCount, dev);
        if (hipFuncSetAttribute((const void*)fwd_kernel, hipFuncAttributeMaxDynamicSharedMemorySize, LDS_BYTES) != hipSuccess) { fprintf(stderr, "kernel_launch: hipFuncSetAttribute failed\n"); grid = -1; return; }
        hipOccupancyMaxActiveBlocksPerMultiprocessor(&per_cu, (const void*)fwd_kernel, NTHREADS, LDS_BYTES);
        if (per_cu < 1) { fprintf(stderr, "kernel_launch: occupancy query says %d blocks per CU\n", per_cu); per_cu = 1; }
        (void)hipGetLastError();
        grid = cus;
        if (grid < 64) { fprintf(stderr, "kernel_launch: needs >= 64 CUs\n"); grid = -1; return; }
    }
    if (grid < 0) return;
    if (hipMemsetAsync((char*)d_ws + WS_CTL, 0, CTL_BYTES, stream) != hipSuccess) { fprintf(stderr, "kernel_launch: memset failed\n"); return; }
    Args a{};
    for (int i = 0; i < 18; ++i) a.in[i] = (const float*)d_in[i];
    a.out = (float*)d_out; a.ws = (unsigned char*)d_ws;
    void* kargs[] = {&a};
    hipError_t e = hipLaunchCooperativeKernel((const void*)fwd_kernel, dim3(grid), dim3(NTHREADS), kargs, LDS_BYTES, stream);
    if (e != hipSuccess) fprintf(stderr, "kernel_launch: cooperative launch failed: %s (grid %d)\n", hipGetErrorString(e), grid);
}
```

```cpp
#include <hip/hip_runtime.h>
#include <hip/hip_cooperative_groups.h>
#include <cstdio>
#include <cstdint>
namespace cg = cooperative_groups;
namespace pg8 {
#define PG8_LAS __attribute__((address_space(3)))
typedef unsigned short bf16_t;
typedef short bf16x8 __attribute__((ext_vector_type(8)));
typedef float f32x4 __attribute__((ext_vector_type(4)));
typedef unsigned u32x4 __attribute__((ext_vector_type(4)));
constexpr int BM = 256, BK = 64, HALF = 128, HTB = HALF * BK * 2  , STAGE_BYTES = 8 * HTB, NXCD = 8, WGM = 8;

__host__ __device__ __forceinline__ int lds_byte(int r, int c) { const int st = (r >> 4) * 2 + (c >> 5), rr = r & 15, cc = c & 31, ob = rr * 64 + cc * 2; return st * 1024 + (ob ^ (((ob >> 9) & 1) << 5)); }
__host__ __device__ __forceinline__ void stage_rc(int b, int& R, int& C) { const int st = b / 1024, sb = b % 1024, swz = sb ^ (((sb >> 9) & 1) << 5); R = (st >> 1) * 16 + swz / 64; C = (st & 1) * 32 + (swz % 64) / 2; }
__host__ __device__ __forceinline__ int perm32(int rho) { const int n = rho >> 4, i = rho & 15; return 8 * (i >> 2) + 4 * n + (i & 3); }

struct Unit { int pm, pn; };
struct Gemm { const bf16_t* A; const bf16_t* Bt; int M, N, K; };

struct StaticOrder {
    int nM, nN, nwg, G, c;
    __host__ __device__ void init(int M, int N, int G_, int c_) { nM = M / BM; nN = N / BM; nwg = nM * nN; G = G_; c = c_; }
    __host__ __device__ bool next(int i, Unit& u) const {
        const long L = (long)i * G + c; if (L >= nwg) return false;
        int wgid = (int)L; { const int q = nwg / NXCD, r = nwg % NXCD, xcd = wgid % NXCD, off = wgid / NXCD; wgid = (xcd < r ? xcd * (q + 1) : r * (q + 1) + (xcd - r) * q) + off; }
        const int nig = WGM * nN, gid = wgid / nig, fm = gid * WGM, gsz = (nM - fm) < WGM ? (nM - fm) : WGM;
        u.pm = fm + ((wgid % nig) % gsz); u.pn = (wgid % nig) / gsz; return true;
    }
    __device__ __forceinline__ void a_ready(const Unit&) const {}
    __device__ __forceinline__ void done(const Unit&) const {}
};

__device__ __forceinline__ unsigned cvt_pk_bf16(float lo, float hi) { unsigned r; asm volatile("v_cvt_pk_bf16_f32 %0, %1, %2" : "=v"(r) : "v"(lo), "v"(hi)); return r; }
__device__ __forceinline__ float bflo(unsigned w) { return __builtin_bit_cast(float, w << 16); }
__device__ __forceinline__ float bfhi(unsigned w) { return __builtin_bit_cast(float, w & 0xffff0000u); }
__device__ __forceinline__ float sigmoidf_(float v) { return __builtin_amdgcn_rcpf(1.0f + __expf(-v)); }
constexpr size_t EPI_MiB = 1u << 20, EPI_BA = 18 * EPI_MiB, EPI_ZNA = 24 * EPI_MiB, EPI_ZDN = 56 * EPI_MiB, EPI_GNA = 88 * EPI_MiB, EPI_GDN = 152 * EPI_MiB, EPI_NAK = 216 * EPI_MiB, EPI_NAV = 249 * EPI_MiB, EPI_DNQKV = 282 * EPI_MiB;
struct EpiIn {
    static constexpr bool PERM = true, AFTER_DRAIN = false;
    unsigned char* ws; unsigned char* dout;
    __device__ __forceinline__ void operator()(const f32x4 (&acc)[2][2][4][2], const Unit& u, int wr, int wc, int fr, int fq) const {
        const int pn = u.pn; size_t boff; int ldc, colt, act = 0; bool latent_only = false; float* ba = (float*)(ws + EPI_BA);
        if (pn < 2) { boff = 0; ldc = 512; colt = pn * 256; latent_only = true; }
        else if (pn < 4) { boff = EPI_NAK; ldc = 512; colt = (pn - 2) * 256; }
        else if (pn < 6) { boff = EPI_NAV; ldc = 512; colt = (pn - 4) * 256; }
        else if (pn < 8) { boff = EPI_ZNA; ldc = 512; colt = (pn - 6) * 256; act = 2; latent_only = true; }
        else if (pn < 14) { boff = EPI_DNQKV; ldc = 1536; colt = (pn - 8) * 256; }
        else if (pn < 16) { boff = EPI_ZDN; ldc = 512; colt = (pn - 14) * 256; act = 2; latent_only = true; }
        else if (pn < 20) { boff = EPI_GNA; ldc = 1024; colt = (pn - 16) * 256; act = 1; latent_only = true; }
        else if (pn < 24) { boff = EPI_GDN; ldc = 1024; colt = (pn - 20) * 256; act = 1; latent_only = true; }
        else {
            if (wc == 0) {
#pragma unroll
                for (int ai = 0; ai < 2; ++ai)
#pragma unroll
                    for (int m = 0; m < 4; ++m) { float* rowp = ba + (size_t)(u.pm * BM + ai * HALF + wr * 64 + m * 16 + fr) * 32 + 8 * fq;
                        *(f32x4*)(rowp) = acc[ai][0][m][0]; *(f32x4*)(rowp + 4) = acc[ai][0][m][1]; }
            }
            return;
        }
        if (latent_only && u.pm >= 128) return;
        bf16_t* base = (pn < 2) ? (bf16_t*)dout : (bf16_t*)(ws + boff);
        const int row0 = u.pm * BM + wr * 64 + fr, col0 = colt + wc * 32 + 8 * fq;
#pragma unroll
        for (int ai = 0; ai < 2; ++ai)
#pragma unroll
            for (int m = 0; m < 4; ++m) { bf16_t* rowp = base + (size_t)(row0 + ai * HALF + m * 16) * ldc + col0;
#pragma unroll
                for (int bj = 0; bj < 2; ++bj) { f32x4 v0 = acc[ai][bj][m][0], v1 = acc[ai][bj][m][1];
                    if (act != 0) {
#pragma unroll
                        for (int e = 0; e < 4; ++e) { const float s0 = sigmoidf_(v0[e]), s1 = sigmoidf_(v1[e]); v0[e] = (act == 1) ? s0 : v0[e] * s0; v1[e] = (act == 1) ? s1 : v1[e] * s1; }
                    }
                    u32x4 w; w.x = cvt_pk_bf16(v0[0], v0[1]); w.y = cvt_pk_bf16(v0[2], v0[3]); w.z = cvt_pk_bf16(v1[0], v1[1]); w.w = cvt_pk_bf16(v1[2], v1[3]);
                    *(u32x4*)(rowp + bj * HALF) = w; } }
    }
};
template <int MODE> struct EpiGate {
    static constexpr bool PERM = true, AFTER_DRAIN = false;
    const bf16_t* G; const bf16_t* T1; bf16_t* O;
    __device__ __forceinline__ void operator()(const f32x4 (&acc)[2][2][4][2], const Unit& u, int wr, int wc, int fr, int fq) const {
        const int row0 = u.pm * BM + wr * 64 + fr, col0 = u.pn * BM + wc * 32 + 8 * fq;
#pragma unroll
        for (int ai = 0; ai < 2; ++ai)
#pragma unroll
            for (int m = 0; m < 4; ++m) { const size_t off = (size_t)(row0 + ai * HALF + m * 16) * 1024 + col0;
#pragma unroll
                for (int bj = 0; bj < 2; ++bj) { const f32x4 v0 = acc[ai][bj][m][0], v1 = acc[ai][bj][m][1];
                    const u32x4 g = *(const u32x4*)(G + off + bj * HALF);
                    float o[8] = { v0[0] * bflo(g.x), v0[1] * bfhi(g.x), v0[2] * bflo(g.y), v0[3] * bfhi(g.y), v1[0] * bflo(g.z), v1[1] * bfhi(g.z), v1[2] * bflo(g.w), v1[3] * bfhi(g.w) };
                    if (MODE == 1) { const u32x4 t = *(const u32x4*)(T1 + off + bj * HALF);
                        o[0] += bflo(t.x); o[1] += bfhi(t.x); o[2] += bflo(t.y); o[3] += bfhi(t.y); o[4] += bflo(t.z); o[5] += bfhi(t.z); o[6] += bflo(t.w); o[7] += bfhi(t.w); }
                    u32x4 w; w.x = cvt_pk_bf16(o[0], o[1]); w.y = cvt_pk_bf16(o[2], o[3]); w.z = cvt_pk_bf16(o[4], o[5]); w.w = cvt_pk_bf16(o[6], o[7]);
                    *(u32x4*)(O + off + bj * HALF) = w; } }
    }
};
struct EpiOut {
    static constexpr bool PERM = true, AFTER_DRAIN = false;
    const float* x; const float* modv; float* out;
    __device__ __forceinline__ void operator()(const f32x4 (&acc)[2][2][4][2], const Unit& u, int wr, int wc, int fr, int fq) const {
        const int row0 = u.pm * BM + wr * 64 + fr, col0 = u.pn * BM + wc * 32 + 8 * fq;
        const float* gp = modv + (size_t)(u.pm / 32) * 3072 + 2048 + col0;
        f32x4 gv[2][2];
#pragma unroll
        for (int bj = 0; bj < 2; ++bj)
#pragma unroll
            for (int n = 0; n < 2; ++n) gv[bj][n] = *(const f32x4*)(gp + bj * HALF + 4 * n);
#pragma unroll
        for (int ai = 0; ai < 2; ++ai)
#pragma unroll
            for (int m = 0; m < 4; ++m) { const size_t off = (size_t)(row0 + ai * HALF + m * 16) * 1024 + col0;
#pragma unroll
                for (int bj = 0; bj < 2; ++bj)
#pragma unroll
                    for (int n = 0; n < 2; ++n) { const f32x4 xv = *(const f32x4*)(x + off + bj * HALF + 4 * n);
                        *(f32x4*)(out + off + bj * HALF + 4 * n) = xv + gv[bj][n] * acc[ai][bj][m][n]; } }
    }
};
template <class Epi, class Sched, bool ALIGN_EPI = false, bool SP2 = false>
__device__ __forceinline__ void gemm_phase(PG8_LAS unsigned char* lds, const Gemm g, const Sched& S, const Epi& E) {
    int tid_ = threadIdx.x; asm volatile("" : "+v"(tid_));
    const int tid = tid_, wid = __builtin_amdgcn_readfirstlane(tid >> 6), lane = tid & 63, wr = wid >> 2, wc = wid & 3, fr = lane & 15, fq = lane >> 4;
    const int K = g.K, nt = K / BK;
    unsigned voffA[2], voffB[2];
#pragma unroll
    for (int i = 0; i < 2; ++i) { int R, C; stage_rc(tid * 16 + i * 8192, R, C); const int Rb = Epi::PERM ? ((R & ~31) + perm32(R & 31)) : R;
        voffA[i] = (unsigned)(R * K + C) * 2u; voffB[i] = (unsigned)(Rb * K + C) * 2u; }
    const size_t kstep = (size_t)(BK * 2);
    const size_t hstep = (size_t)HALF * K * 2;
    const size_t tstep = 2 * hstep;
    const unsigned ldsw = (unsigned)wid * 1024u;
    const int aoff = lds_byte(wr * 64 + fr, fq * 8), boff = lds_byte(wc * 32 + fr, fq * 8);
#define PG8_SA(b, h) (((b) * 2 + (h)) * HTB)
#define PG8_SB(b, h) ((4 + (b) * 2 + (h)) * HTB)
#define PG8_STAGE(bufoff, gbase, voff) do { _Pragma("unroll") for (int _i = 0; _i < 2; ++_i) \
        __builtin_amdgcn_global_load_lds((const unsigned*)((const char*)(gbase) + (voff)[_i]), (PG8_LAS unsigned*)(lds + (bufoff) + ldsw + _i * 8192), 16, 0, 0); } while (0)
#define PG8_LDA(dst, b, h) do { _Pragma("unroll") for (int m = 0; m < 4; ++m) _Pragma("unroll") for (int k = 0; k < 2; ++k) dst[m][k] = *(const PG8_LAS bf16x8*)(lds + PG8_SA(b, h) + aoff + m * 2048 + k * 1024); } while (0)
#define PG8_LDB(dst, b, h) do { _Pragma("unroll") for (int n = 0; n < 2; ++n) _Pragma("unroll") for (int k = 0; k < 2; ++k) dst[n][k] = *(const PG8_LAS bf16x8*)(lds + PG8_SB(b, h) + boff + n * 2048 + k * 1024); } while (0)
#define PG8_MMA(ai, bj, At, Bt) do { __builtin_amdgcn_s_setprio(1); _Pragma("unroll") for (int m = 0; m < 4; ++m) _Pragma("unroll") for (int n = 0; n < 2; ++n) _Pragma("unroll") for (int k = 0; k < 2; ++k) \
        acc[ai][bj][m][n] = __builtin_amdgcn_mfma_f32_16x16x32_bf16(Bt[n][k], At[m][k], acc[ai][bj][m][n], 0, 0, 0); __builtin_amdgcn_s_setprio(0); } while (0)
#define PG8_WAIT_V(n) asm volatile("s_waitcnt vmcnt(" #n ")" ::: "memory")
#define PG8_WAIT_L(n) asm volatile("s_waitcnt lgkmcnt(" #n ")" ::: "memory")
#define PG8_BAR __builtin_amdgcn_s_barrier()
#define PG8_SCHED __builtin_amdgcn_sched_barrier(0)
    Unit cur, nxt; int ui = 0;
    if (!S.next(0, cur)) return;
    f32x4 acc[2][2][4][2];
#pragma unroll
    for (int a = 0; a < 2; ++a)
#pragma unroll
        for (int b = 0; b < 2; ++b)
#pragma unroll
            for (int m = 0; m < 4; ++m)
#pragma unroll
                for (int n = 0; n < 2; ++n) acc[a][b][m][n] = (f32x4){0.f, 0.f, 0.f, 0.f};
    bf16x8 At[4][2], B0[2][2], B1[2][2];
    const char* cA = (const char*)g.A + (size_t)cur.pm * tstep; const char* cB = (const char*)g.Bt + (size_t)cur.pn * tstep;
    S.a_ready(cur);
    if constexpr (SP2) {
        PG8_STAGE(PG8_SB(0, 0), cB, voffB); PG8_STAGE(PG8_SB(0, 1), cB + hstep, voffB); PG8_STAGE(PG8_SA(0, 0), cA, voffA); PG8_STAGE(PG8_SA(0, 1), cA + hstep, voffA);
        if (wr == 1) PG8_BAR;
        PG8_WAIT_V(2); PG8_BAR;
        PG8_STAGE(PG8_SB(1, 0), cB + kstep, voffB); PG8_STAGE(PG8_SA(1, 0), cA + kstep, voffA); PG8_STAGE(PG8_SB(1, 1), cB + hstep + kstep, voffB);
        PG8_WAIT_V(6); PG8_BAR;
    } else {
        PG8_STAGE(PG8_SB(0, 0), cB, voffB); PG8_STAGE(PG8_SA(0, 0), cA, voffA); PG8_STAGE(PG8_SB(0, 1), cB + hstep, voffB); PG8_STAGE(PG8_SA(0, 1), cA + hstep, voffA);
        if (wr == 1) PG8_BAR;
        PG8_WAIT_V(4); PG8_BAR;
        PG8_STAGE(PG8_SB(1, 0), cB + kstep, voffB); PG8_STAGE(PG8_SA(1, 0), cA + kstep, voffA); PG8_STAGE(PG8_SB(1, 1), cB + hstep + kstep, voffB);
        PG8_WAIT_V(6); PG8_BAR;
    }
    for (;;) {
        const bool has_next = S.next(ui + 1, nxt);
        const char* nA = has_next ? (const char*)g.A + (size_t)nxt.pm * tstep : cA; const char* nB = has_next ? (const char*)g.Bt + (size_t)nxt.pn * tstep : cB;
        for (int t = 0; t < nt; t += 2) {
            const bool last = (t == nt - 2);
            const char* a1 = cA + (size_t)(t + 1) * kstep;
            const char* a2 = last ? nA : cA + (size_t)(t + 2) * kstep; const char* b2 = last ? nB : cB + (size_t)(t + 2) * kstep;
            const char* a3 = a2 + kstep; const char* b3 = b2 + kstep;
            if (last && has_next) S.a_ready(nxt);
            if constexpr (SP2) {
            PG8_LDB(B0, 0, 0); PG8_LDB(B1, 0, 1); PG8_SCHED; PG8_LDA(At, 0, 0); PG8_STAGE(PG8_SA(1, 1), a1 + hstep, voffA);
            PG8_WAIT_V(8); PG8_WAIT_L(0); PG8_BAR; PG8_MMA(0, 0, At, B0); PG8_MMA(0, 1, At, B1); PG8_BAR; PG8_SCHED;
            PG8_LDA(At, 0, 1); PG8_STAGE(PG8_SB(0, 0), b2, voffB); PG8_STAGE(PG8_SB(0, 1), b2 + hstep, voffB); PG8_STAGE(PG8_SA(0, 0), a2, voffA);
            PG8_WAIT_V(8); PG8_WAIT_L(0); PG8_BAR; PG8_MMA(1, 0, At, B0); PG8_MMA(1, 1, At, B1); PG8_BAR; PG8_SCHED;
            PG8_LDB(B0, 1, 0); PG8_LDB(B1, 1, 1); PG8_SCHED; PG8_LDA(At, 1, 0); PG8_STAGE(PG8_SA(0, 1), a2 + hstep, voffA);
            PG8_WAIT_V(8); PG8_WAIT_L(0); PG8_BAR; PG8_MMA(0, 0, At, B0); PG8_MMA(0, 1, At, B1); PG8_BAR; PG8_SCHED;
            PG8_LDA(At, 1, 1); PG8_STAGE(PG8_SB(1, 0), b3, voffB); PG8_STAGE(PG8_SB(1, 1), b3 + hstep, voffB); PG8_STAGE(PG8_SA(1, 0), a3, voffA);
            PG8_WAIT_V(8); PG8_WAIT_L(0); PG8_BAR; PG8_MMA(1, 0, At, B0); PG8_MMA(1, 1, At, B1); PG8_BAR; PG8_SCHED;
            } else {
            PG8_LDB(B0, 0, 0); PG8_SCHED; PG8_LDA(At, 0, 0); PG8_STAGE(PG8_SA(1, 1), a1 + hstep, voffA);
            PG8_WAIT_L(8); PG8_BAR; PG8_WAIT_L(0); PG8_MMA(0, 0, At, B0); PG8_BAR; PG8_SCHED;
            PG8_LDB(B1, 0, 1); PG8_STAGE(PG8_SB(0, 0), b2, voffB);
            PG8_BAR; PG8_WAIT_L(0); PG8_MMA(0, 1, At, B1); PG8_BAR;
            PG8_LDA(At, 0, 1); PG8_STAGE(PG8_SA(0, 0), a2, voffA);
            PG8_BAR; PG8_WAIT_L(0); PG8_MMA(1, 0, At, B0); PG8_BAR; PG8_SCHED;
            PG8_STAGE(PG8_SB(0, 1), b2 + hstep, voffB);
            PG8_WAIT_V(6); PG8_BAR; PG8_MMA(1, 1, At, B1); PG8_BAR;
            PG8_LDB(B0, 1, 0); PG8_SCHED; PG8_LDA(At, 1, 0); PG8_STAGE(PG8_SA(0, 1), a2 + hstep, voffA);
            PG8_WAIT_L(8); PG8_BAR; PG8_WAIT_L(0); PG8_MMA(0, 0, At, B0); PG8_BAR; PG8_SCHED;
            PG8_LDB(B1, 1, 1); PG8_STAGE(PG8_SB(1, 0), b3, voffB);
            PG8_BAR; PG8_WAIT_L(0); PG8_MMA(0, 1, At, B1); PG8_BAR;
            PG8_LDA(At, 1, 1); PG8_STAGE(PG8_SA(1, 0), a3, voffA);
            PG8_BAR; PG8_WAIT_L(0); PG8_MMA(1, 0, At, B0); PG8_BAR; PG8_SCHED;
            PG8_STAGE(PG8_SB(1, 1), b3 + hstep, voffB);
            PG8_WAIT_V(6); PG8_BAR; PG8_MMA(1, 1, At, B1); PG8_BAR;
            }
        }
        if constexpr (ALIGN_EPI) { if (wr == 0) PG8_BAR; }
        if constexpr (!Epi::AFTER_DRAIN) { E(acc, cur, wr, wc, fr, fq); S.done(cur); }
        if (!has_next) break;
#pragma unroll
        for (int a = 0; a < 2; ++a)
#pragma unroll
            for (int b = 0; b < 2; ++b)
#pragma unroll
                for (int m = 0; m < 4; ++m)
#pragma unroll
                    for (int n = 0; n < 2; ++n) acc[a][b][m][n] = (f32x4){0.f, 0.f, 0.f, 0.f};
        cur = nxt; cA = nA; cB = nB; ++ui;
        if constexpr (ALIGN_EPI) { if (wr == 1) PG8_BAR; }
    }
    PG8_WAIT_V(0);
    if constexpr (!ALIGN_EPI) { if (wr == 0) PG8_BAR; }
    PG8_BAR;
    if constexpr (Epi::AFTER_DRAIN) { E.fused(acc, cur, wr, wc, fr, fq, lds, wid, lane); S.done(cur); }
#undef PG8_SA
#undef PG8_SB
#undef PG8_STAGE
#undef PG8_LDA
#undef PG8_LDB
#undef PG8_MMA
#undef PG8_WAIT_V
#undef PG8_WAIT_L
#undef PG8_BAR
#undef PG8_SCHED
}
}
constexpr int DM = 1024, NB = 4, SEQ = 8192, CTXL = 256, NH = 8;
constexpr int ML = NB * SEQ, MC = NB * CTXL, MT = ML + MC;
constexpr int NPROJ = 6176, NPAD = 6400;
constexpr int NSTEP = 132;
constexpr float EPSF = 1e-6f;
constexpr int NWAVES = 8, NTHREADS = 512;
constexpr int LDS_BYTES = 135168;
constexpr size_t MiB = 1u << 20;
constexpr size_t WS_MODV = 4096;
constexpr size_t WS_WIN = 1 * MiB;
constexpr size_t WS_WONA = 14 * MiB, WS_WODN = 15 * MiB, WS_WOUT = 16 * MiB;
constexpr size_t WS_BA = 18 * MiB;
constexpr size_t WS_VT8C = 22 * MiB + 512 * 1024;
constexpr size_t WS_ZNA = 24 * MiB, WS_ZDN = 56 * MiB, WS_GNA = 88 * MiB, WS_GDN = 152 * MiB;
constexpr size_t WS_NAK = 216 * MiB, WS_NAV = 249 * MiB, WS_DNQKV = 282 * MiB;
constexpr size_t WS_TB = 282 * MiB, WS_GC = 354 * MiB;
constexpr size_t WS_XN = 381 * MiB;
constexpr size_t WS_DQ = 381 * MiB, WS_DK = 413 * MiB, WS_DKT = 445 * MiB, WS_DV = 477 * MiB;
constexpr size_t WS_DKC = 509 * MiB, WS_DKTC = 510 * MiB, WS_DVC = 511 * MiB;
constexpr size_t WS_T1 = 381 * MiB, WS_Y = 445 * MiB;
constexpr size_t WS_END = 512 * MiB;
constexpr size_t DO_Q = 0, DO_VT8 = 32 * MiB, DO_OF = 64 * MiB, DO_OB = 96 * MiB;

#define LAS __attribute__((address_space(3)))
typedef unsigned short bf16;
typedef unsigned u32x4 __attribute__((ext_vector_type(4)));
typedef unsigned u32x2 __attribute__((ext_vector_type(2)));
typedef float f32x4 __attribute__((ext_vector_type(4)));
typedef short bf16x8 __attribute__((ext_vector_type(8)));
#define LDS_WAIT() asm volatile("s_waitcnt lgkmcnt(0)" ::: "memory")
__device__ __forceinline__ unsigned f2bf(float f) { unsigned u = __builtin_bit_cast(unsigned, f); return (u + 0x7fffu + ((u >> 16) & 1u)) >> 16; }
__device__ __forceinline__ unsigned pk2(float lo, float hi) { return f2bf(lo) | (f2bf(hi) << 16); }
__device__ __forceinline__ float blo(unsigned w) { return __builtin_bit_cast(float, w << 16); }
__device__ __forceinline__ float bhi(unsigned w) { return __builtin_bit_cast(float, w & 0xffff0000u); }
__device__ __forceinline__ float bf1(unsigned short h) { return __builtin_bit_cast(float, ((unsigned)h) << 16); }
__device__ __forceinline__ void unpack8(const u32x4 v, float (&f)[8]) { f[0] = blo(v.x); f[1] = bhi(v.x); f[2] = blo(v.y); f[3] = bhi(v.y); f[4] = blo(v.z); f[5] = bhi(v.z); f[6] = blo(v.w); f[7] = bhi(v.w); }
__device__ __forceinline__ u32x4 pack8(const float (&f)[8]) { u32x4 w; w.x = pk2(f[0], f[1]); w.y = pk2(f[2], f[3]); w.z = pk2(f[4], f[5]); w.w = pk2(f[6], f[7]); return w; }
__device__ __forceinline__ bf16x8 pack_frag(const f32x4 a, const f32x4 b) { u32x4 w; w.x = pk2(a[0], a[1]); w.y = pk2(a[2], a[3]); w.z = pk2(b[0], b[1]); w.w = pk2(b[2], b[3]); return __builtin_bit_cast(bf16x8, w); }
__device__ __forceinline__ float sigm(float v) { return __builtin_amdgcn_rcpf(1.0f + __expf(-v)); }
#define MFMA16(a, b, c) __builtin_amdgcn_mfma_f32_16x16x32_bf16((a), (b), (c), 0, 0, 0)
__device__ __forceinline__ void tr8x8(const u32x4 (&in)[8], u32x4 (&out)[8]) {
#pragma unroll
    for (int e = 0; e < 8; ++e) {
        unsigned w[4];
#pragma unroll
        for (int p = 0; p < 4; ++p) { const unsigned a = in[2 * p][e >> 1], b = in[2 * p + 1][e >> 1];
            w[p] = (e & 1) ? ((a >> 16) | (b & 0xffff0000u)) : ((a & 0xffffu) | (b << 16)); }
        out[e] = (u32x4){w[0], w[1], w[2], w[3]};
    }
}

struct Args { const float* in[18]; float* out; unsigned char* ws; };

struct Ctx {
    LAS unsigned char* lds; int tid, lane, wave, G, gw, NGW;
    unsigned char* ws; unsigned char* dout;
};

__device__ __forceinline__ void p0_transpose_item(const float* W, int K, int N, bf16* WT, int k0, int n0, int dst_row, LAS float* scr, int lane) {
#pragma unroll 8
    for (int i = 0; i < 32; ++i) { const int kk = 2 * i + (lane >> 5); scr[kk * 33 + (lane & 31)] = W[(size_t)(k0 + kk) * N + n0 + (lane & 31)]; }
    LDS_WAIT();
    const int c = lane & 7;
#pragma unroll
    for (int j = 0; j < 4; ++j) { const int n = (lane >> 3) + 8 * j; const LAS float* s = scr + (8 * c) * 33 + n;
        u32x4 o; o.x = pk2(s[0 * 33], s[1 * 33]); o.y = pk2(s[2 * 33], s[3 * 33]); o.z = pk2(s[4 * 33], s[5 * 33]); o.w = pk2(s[6 * 33], s[7 * 33]);
        *(u32x4*)(WT + (size_t)(dst_row + n) * K + k0 + 8 * c) = o; }
    LDS_WAIT();
}
__device__ __forceinline__ void phase0(Ctx& F, const Args& A) {
    if (blockIdx.x < 48) {
        LAS float* sc = (LAS float*)F.lds;
        LAS float* red = (LAS float*)(F.lds + 20480);
        for (int i = F.tid; i < 5 * 1024; i += NTHREADS) { const int v = i >> 10, k = i & 1023; const float cv = (v < 4) ? A.in[1][v * 1024 + k] : A.in[3][k]; sc[i] = cv * sigm(cv); }
        __syncthreads();
        const int n0 = blockIdx.x * 64, kc = F.tid >> 4, c4 = F.tid & 15;
        float acc[5][4];
#pragma unroll
        for (int v = 0; v < 5; ++v)
#pragma unroll
            for (int e = 0; e < 4; ++e) acc[v][e] = 0.f;
#pragma unroll 4
        for (int i = 0; i < 32; ++i) { const int k = kc * 32 + i; const f32x4 w = *(const f32x4*)(A.in[4] + (size_t)k * 3072 + n0 + 4 * c4);
#pragma unroll
            for (int v = 0; v < 5; ++v) { const float s = sc[v * 1024 + k]; acc[v][0] += s * w[0]; acc[v][1] += s * w[1]; acc[v][2] += s * w[2]; acc[v][3] += s * w[3]; } }
#pragma unroll
        for (int v = 0; v < 5; ++v)
#pragma unroll
            for (int e = 0; e < 4; ++e) red[(kc * 5 + v) * 64 + 4 * c4 + e] = acc[v][e];
        __syncthreads();
        if (F.tid < 320) { const int v = F.tid >> 6, col = F.tid & 63; float s = A.in[5][n0 + col];
            for (int k = 0; k < 32; ++k) s += red[(k * 5 + v) * 64 + col];
            ((float*)(F.ws + WS_MODV))[v * 3072 + n0 + col] = s; }
        __syncthreads();
    }
    { u32x4* z = (u32x4*)(F.ws + WS_WIN + (size_t)NPROJ * 1024 * 2); const int n16 = (NPAD - NPROJ) * 1024 * 2 / 16;
      for (int i = blockIdx.x * NTHREADS + F.tid; i < n16; i += F.G * NTHREADS) z[i] = (u32x4){0u, 0u, 0u, 0u}; }
    LAS float* scr = (LAS float*)(F.lds + F.wave * 16384);
    constexpr int I_IN = 16 * 193, I_ONA = 8 * 32, I_ODN = 8 * 32, I_OUT = 16 * 32;
    for (int it = F.gw; it < I_IN + I_ONA + I_ODN + I_OUT; it += F.NGW) {
        int r = it;
        if (r < I_IN) { const int kb = r / 193, nb = r % 193, c0 = 32 * nb; const int dst = (c0 < 4096) ? c0 : ((c0 < 4128) ? 6144 + (c0 - 4096) : c0 - 32);
            p0_transpose_item(A.in[7], 1024, NPROJ, (bf16*)(F.ws + WS_WIN), 64 * kb, c0, dst, scr, F.lane); continue; }
        r -= I_IN;
        if (r < I_ONA) { p0_transpose_item(A.in[15], 512, 1024, (bf16*)(F.ws + WS_WONA), 64 * (r / 32), 32 * (r % 32), 32 * (r % 32), scr, F.lane); continue; }
        r -= I_ONA;
        if (r < I_ODN) { p0_transpose_item(A.in[16], 512, 1024, (bf16*)(F.ws + WS_WODN), 64 * (r / 32), 32 * (r % 32), 32 * (r % 32), scr, F.lane); continue; }
        r -= I_ODN;
        p0_transpose_item(A.in[17], 1024, 1024, (bf16*)(F.ws + WS_WOUT), 64 * (r / 32), 32 * (r % 32), 32 * (r % 32), scr, F.lane);
    }
}
__device__ __forceinline__ float wave_sum(float v) {
#pragma unroll
    for (int o = 1; o < 64; o <<= 1) v += __shfl_xor(v, o);
    return v;
}
__device__ __forceinline__ void phase1(Ctx& F, const Args& A) {
    const float* modv = (const float*)(F.ws + WS_MODV); bf16* XN = (bf16*)(F.ws + WS_XN);
    for (int ch = F.gw; ch < MT / 16; ch += F.NGW) {
        const int row0 = ch * 16; const int b = (row0 < ML) ? row0 / SEQ : 4;
        f32x4 mul[4], add[4];
#pragma unroll
        for (int j = 0; j < 4; ++j) { const int col = 4 * F.lane + 256 * j; const f32x4 nw = *(const f32x4*)(A.in[6] + col), sc = *(const f32x4*)(modv + b * 3072 + 1024 + col);
            mul[j] = nw * (sc + 1.0f); add[j] = *(const f32x4*)(modv + b * 3072 + col); }
        for (int rr = 0; rr < 16; ++rr) {
            const int row = row0 + rr; const float* src = (row < ML) ? A.in[0] + (size_t)row * DM : A.in[2] + (size_t)(row - ML) * DM;
            f32x4 v[4]; float s = 0.f;
#pragma unroll
            for (int j = 0; j < 4; ++j) { v[j] = *(const f32x4*)(src + 4 * F.lane + 256 * j); s += (v[j][0] * v[j][0] + v[j][1] * v[j][1]) + (v[j][2] * v[j][2] + v[j][3] * v[j][3]); }
            const float r = rsqrtf(wave_sum(s) * (1.f / DM) + EPSF);
#pragma unroll
            for (int j = 0; j < 4; ++j) { const f32x4 o = v[j] * r * mul[j] + add[j];
                *(u32x2*)(XN + (size_t)row * DM + 4 * F.lane + 256 * j) = (u32x2){pk2(o[0], o[1]), pk2(o[2], o[3])}; }
        }
    }
}
__device__ __forceinline__ float red8(float v) { v += __shfl_xor(v, 1); v += __shfl_xor(v, 2); v += __shfl_xor(v, 4); return v; }
__device__ __forceinline__ void item_pos(int it, bool& lat, int& m0, int& b, int& t0, int& Tseq) {
    lat = it < ML / 8;
    if (lat) { m0 = it * 8; b = m0 / SEQ; t0 = m0 % SEQ; Tseq = SEQ; } else { const int ci = it - ML / 8; m0 = ML + ci * 8; b = ci / 32; t0 = (ci % 32) * 8; Tseq = CTXL; }
}
__device__ __forceinline__ void phase3(Ctx& F, const Args& A) {
    const int l = F.lane, h = l >> 3, j = l & 7;
    {
        bf16* NAQ = (bf16*)(F.dout + DO_Q); bf16* NAK = (bf16*)(F.ws + WS_NAK); const bf16* NAV = (const bf16*)(F.ws + WS_NAV);
        float wq8[8], wk8[8];
#pragma unroll
        for (int e = 0; e < 8; ++e) { wq8[e] = A.in[9][8 * j + e] * 0.125f; wk8[e] = A.in[10][8 * j + e]; }
        for (int it = F.gw; it < MT / 8; it += F.NGW) {
            bool lat; int m0, b, t0, Tseq; item_pos(it, lat, m0, b, t0, Tseq);
            const int bh = b * 8 + h;
            if (lat) {
#pragma unroll 2
                for (int t = 0; t < 8; ++t) { u32x4* p = (u32x4*)(NAQ + (size_t)(m0 + t) * 512 + 8 * l); float f[8]; unpack8(*p, f); float ss = 0.f;
#pragma unroll
                    for (int e = 0; e < 8; ++e) ss += f[e] * f[e];
                    const float r = rsqrtf(red8(ss) * (1.f / 64.f) + EPSF);
#pragma unroll
                    for (int e = 0; e < 8; ++e) f[e] = f[e] * r * wq8[e];
                    *p = pack8(f); }
            }
#pragma unroll 2
            for (int t = 0; t < 8; ++t) { u32x4* p = (u32x4*)(NAK + (size_t)(m0 + t) * 512 + 8 * l); float f[8]; unpack8(*p, f); float ss = 0.f;
#pragma unroll
                for (int e = 0; e < 8; ++e) ss += f[e] * f[e];
                const float r = rsqrtf(red8(ss) * (1.f / 64.f) + EPSF);
#pragma unroll
                for (int e = 0; e < 8; ++e) f[e] = f[e] * r * wk8[e];
                *p = pack8(f); }
            { u32x4 vin[8], vout[8];
#pragma unroll
              for (int t = 0; t < 8; ++t) vin[t] = *(const u32x4*)(NAV + (size_t)(m0 + t) * 512 + 8 * l);
              tr8x8(vin, vout);
              u32x4* dst = lat ? (u32x4*)(F.dout + DO_VT8) + ((size_t)bh * (SEQ / 8) + t0 / 8) * 64 + 8 * j : (u32x4*)(F.ws + WS_VT8C) + ((size_t)bh * (CTXL / 8) + t0 / 8) * 64 + 8 * j;
#pragma unroll
              for (int e = 0; e < 8; ++e) dst[e] = vout[e]; }
        }
    }
    {
        const bf16* DNQKV = (const bf16*)(F.ws + WS_DNQKV);
        float fr8[8];
#pragma unroll
        for (int e = 0; e < 8; ++e) fr8[e] = exp2f(-(float)(8 * (j & 1) + e) * (13.287712379549449f / 16.0f));
        for (int it2 = F.gw; it2 < 3 * (MT / 8); it2 += F.NGW) {
            const int seg = it2 % 3, it = it2 / 3;
            bool lat; int m0, b, t0, Tseq; item_pos(it, lat, m0, b, t0, Tseq);
            if (seg == 0 && !lat) continue;
            const int bh = b * 8 + h;
            float cw[3][8];
#pragma unroll
            for (int tp = 0; tp < 3; ++tp) { const f32x4 a = *(const f32x4*)(A.in[8] + tp * 1536 + seg * 512 + 8 * l), bq = *(const f32x4*)(A.in[8] + tp * 1536 + seg * 512 + 8 * l + 4);
                cw[tp][0] = a[0]; cw[tp][1] = a[1]; cw[tp][2] = a[2]; cw[tp][3] = a[3]; cw[tp][4] = bq[0]; cw[tp][5] = bq[1]; cw[tp][6] = bq[2]; cw[tp][7] = bq[3]; }
            bf16* dst; if (seg == 0) dst = (bf16*)(F.ws + WS_DQ); else if (seg == 1) dst = lat ? (bf16*)(F.ws + WS_DK) : (bf16*)(F.ws + WS_DKC); else dst = lat ? (bf16*)(F.ws + WS_DV) : (bf16*)(F.ws + WS_DVC);
            const bf16* src = DNQKV + (size_t)m0 * 1536 + seg * 512 + 8 * l;
            u32x4 r0 = (t0 > 0) ? *(const u32x4*)(src - 1536) : (u32x4){0u, 0u, 0u, 0u};
            u32x4 r1 = *(const u32x4*)(src);
#pragma unroll 1
            for (int t = 0; t < 8; ++t) {
                const u32x4 r2 = (t0 + t + 1 < Tseq) ? *(const u32x4*)(src + (size_t)(t + 1) * 1536) : (u32x4){0u, 0u, 0u, 0u};
                float a[8], bq[8], cq[8], y[8]; unpack8(r0, a); unpack8(r1, bq); unpack8(r2, cq);
#pragma unroll
                for (int e = 0; e < 8; ++e) { const float s = cw[0][e] * a[e] + cw[1][e] * bq[e] + cw[2][e] * cq[e]; y[e] = s * sigm(s); }
                if (seg < 2) {
                    float ss = 0.f;
#pragma unroll
                    for (int e = 0; e < 8; ++e) ss += y[e] * y[e];
                    const float r = rsqrtf(red8(ss) + EPSF);
#pragma unroll
                    for (int e = 0; e < 8; ++e) y[e] *= r;
                    if (lat) {
                        const int tok = t0 + t; const float pos = (float)((j < 4) ? (tok >> 6) : (tok & 63));
#pragma unroll
                        for (int e = 0; e < 8; ++e) { const float ang = pos * fr8[e]; const float cs = __cosf(ang), sn = __sinf(ang); const float pr = __shfl_xor(y[e], 2);
                            y[e] = (j & 2) ? (y[e] * cs + pr * sn) : (y[e] * cs - pr * sn); }
                    }
                    if (seg == 0) {
#pragma unroll
                        for (int e = 0; e < 8; ++e) y[e] *= 0.125f;
                    }
                }
                *(u32x4*)(dst + ((size_t)bh * Tseq + t0 + t) * 64 + 8 * j) = pack8(y);
                r0 = r1; r1 = r2;
            }
            if (seg == 1) {
                asm volatile("s_waitcnt vmcnt(0)" ::: "memory");
                u32x4 res[8], kt[8];
#pragma unroll
                for (int t = 0; t < 8; ++t) res[t] = __builtin_nontemporal_load((const u32x4*)(dst + ((size_t)bh * Tseq + t0 + t) * 64 + 8 * j));
                tr8x8(res, kt);
                bf16* kd = lat ? (bf16*)(F.ws + WS_DKT) : (bf16*)(F.ws + WS_DKTC);
#pragma unroll
                for (int e = 0; e < 8; ++e) *(u32x4*)(kd + (((size_t)bh * (Tseq / 64) + t0 / 64) * 64 + 8 * j + e) * 64 + (t0 & 63)) = kt[e];
            }
        }
    }
}
__device__ __forceinline__ void step_chunk(int step, int dir, bool& lat, int& chunk) { if (step < 4) { lat = false; chunk = dir ? 3 - step : step; } else { lat = true; chunk = dir ? 131 - step : step - 4; } }
__host__ __device__ constexpr int tri_off(int i) { return i == 0 ? 0 : (8 * ((i - 1) >> 2) * (((i - 1) >> 2) + 1) + (i - 1 - 4 * ((i - 1) >> 2)) * 4 * (((i - 1) >> 2) + 1)); }
__host__ __device__ constexpr int tri_len(int i) { return i == 0 ? 0 : 4 * (((i - 1) >> 2) + 1); }
constexpr int TRI_FLOATS = 2176;
template <int I> struct SubstRow {
    static __device__ __forceinline__ void run(float (&t)[64], const LAS float* L, float lanef) {
        SubstRow<I - 1>::run(t, L, lanef);
        float s = fmaxf(0.f, 1.f - fabsf(lanef - (float)I));
#pragma unroll
        for (int q = 0; q < tri_len(I) / 4; ++q) { const f32x4 lv = *(const LAS f32x4*)(L + tri_off(I) + 4 * q);
            if (4 * q + 0 < I) s -= lv[0] * t[4 * q + 0];
            if (4 * q + 1 < I) s -= lv[1] * t[4 * q + 1];
            if (4 * q + 2 < I) s -= lv[2] * t[4 * q + 2];
            if (4 * q + 3 < I) s -= lv[3] * t[4 * q + 3]; }
        t[I] = s;
        if ((I & 3) == 3) asm volatile("" ::: "memory");
    }
};
template <> struct SubstRow<-1> { static __device__ __forceinline__ void run(float (&)[64], const LAS float*, float) {} };

__device__ __forceinline__ void phase4(Ctx& F, const Args& A) {
    LAS float* Lt = (LAS float*)(F.lds + F.wave * (TRI_FLOATS * 4));
    const float* BA = (const float*)(F.ws + WS_BA);
    for (int id = F.gw; id < 64 * NSTEP; id += F.NGW) {
        int l = F.lane; asm volatile("" : "+v"(l));
        const int g = l >> 4, i16 = l & 15;
        const int step = id % NSTEP, sd = id / NSTEP, dir = sd & 1, bh = sd >> 1, b = bh >> 3, h = bh & 7;
        bool lat; int chunk; step_chunk(step, dir, lat, chunk);
        const int tl = dir ? 63 - l : l;
        const int m = lat ? b * SEQ + chunk * 64 + tl : ML + b * CTXL + chunk * 64 + tl;
        const float braw = BA[(size_t)m * 32 + dir * 8 + h], araw = BA[(size_t)m * 32 + 16 + dir * 8 + h];
        const float beta = sigm(braw);
        const float xs = araw + A.in[13][dir * 8 + h];
        const float sp = (xs > 15.f) ? xs : log1pf(expf(xs));
        float gc = -expf(A.in[12][dir * 8 + h]) * sp;
#pragma unroll
        for (int o = 1; o < 64; o <<= 1) { const float v = __shfl_up(gc, o); if (l >= o) gc += v; }
        ((float*)(F.ws + WS_GC))[(size_t)id * 64 + tl] = gc;
        const bf16* Kt = lat ? (const bf16*)(F.ws + WS_DK) + ((size_t)bh * SEQ + chunk * 64) * 64 : (const bf16*)(F.ws + WS_DKC) + ((size_t)bh * CTXL + chunk * 64) * 64;
        bf16x8 Kf[4][2];
#pragma unroll
        for (int it = 0; it < 4; ++it)
#pragma unroll
            for (int kk = 0; kk < 2; ++kk) { const int li = 16 * it + i16; const int tk = dir ? 63 - li : li; Kf[it][kk] = *(const bf16x8*)(Kt + tk * 64 + 8 * g + 32 * kk); }
#pragma unroll
        for (int it = 0; it < 4; ++it) {
            float gci[4], bti[4];
#pragma unroll
            for (int r = 0; r < 4; ++r) { gci[r] = __shfl(gc, 16 * it + 4 * g + r); bti[r] = __shfl(beta, 16 * it + 4 * g + r); }
#pragma unroll
            for (int jt = 0; jt <= it; ++jt) {
                f32x4 a = {0.f, 0.f, 0.f, 0.f};
                a = MFMA16(Kf[it][0], Kf[jt][0], a); a = MFMA16(Kf[it][1], Kf[jt][1], a);
                const int jj = 16 * jt + i16; const float gcj = __shfl(gc, jj);
#pragma unroll
                for (int r = 0; r < 4; ++r) { const int ii = 16 * it + 4 * g + r; const int q = (ii - 1) >> 2; const int len = (ii == 0) ? 0 : 4 * (q + 1);
                    const int off = (ii == 0) ? 0 : (8 * q * (q + 1) + (ii - 1 - 4 * q) * 4 * (q + 1));
                    if (jj < len) Lt[off + jj] = (jj < ii) ? bti[r] * a[r] * __expf(gci[r] - gcj) : 0.f; }
            }
        }
        LDS_WAIT();
        float t[64];
        SubstRow<63>::run(t, Lt, (float)l);
        asm volatile("" ::: "memory");
        bf16* TB = (bf16*)(F.ws + WS_TB) + (size_t)id * 4096;
#pragma unroll
        for (int i = 0; i < 64; ++i) { const int ti = dir ? 63 - i : i; TB[ti * 64 + tl] = (bf16)f2bf(t[i] * beta); }
        LDS_WAIT();
    }
}
__device__ __forceinline__ void phase_na(Ctx& F, const Args& A, int gw0, int ngw) {
    const int l = F.lane, g = l >> 4, i16 = l & 15;
    LAS float* rp = (LAS float*)F.lds;
    for (int i = F.tid; i < 8 * 465; i += NTHREADS) rp[i] = A.in[11][i];
    float mq = fabsf(A.in[9][l]), mk = fabsf(A.in[10][l]), mr = 0.f;
    for (int i = l; i < 8 * 465; i += 64) mr = fmaxf(mr, fabsf(A.in[11][i]));
#pragma unroll
    for (int o = 1; o < 64; o <<= 1) { mq = fmaxf(mq, __shfl_xor(mq, o)); mk = fmaxf(mk, __shfl_xor(mk, o)); mr = fmaxf(mr, __shfl_xor(mr, o)); }
    const float mb = 8.0f * mq * mk + mr;
    __syncthreads();
    bf16* Q = (bf16*)(F.dout + DO_Q); const bf16* Kn = (const bf16*)(F.ws + WS_NAK); const bf16* ZNA = (const bf16*)(F.ws + WS_ZNA);
    const u32x4* VTL = (const u32x4*)(F.dout + DO_VT8); const u32x4* VTC = (const u32x4*)(F.ws + WS_VT8C);
    const int key0 = 8 * (i16 >> 2) + (i16 & 3);
    for (int task = gw0; task < NB * NH * 128 * 4; task += ngw) {
        const int jq = task & 3, r = (task >> 2) & 127, bh = task >> 9, b = bh >> 3, h = bh & 7;
        const int q0 = 16 * jq, kc0 = (jq == 0) ? 0 : ((jq == 1) ? 8 : ((jq == 2) ? 24 : 32));
        const int r0 = min(max(r - 4, 0), 120);
        const size_t mq_row = (size_t)b * SEQ + r * 64 + q0 + i16;
        bf16x8 Qf[2];
#pragma unroll
        for (int kk = 0; kk < 2; ++kk) Qf[kk] = *(const bf16x8*)(Q + mq_row * 512 + h * 64 + 8 * g + 32 * kk);
        const int cq = q0 + i16, c0 = min(max(cq - 8, 0), 48);
        f32x4 O[4]; float lsum = 0.f;
#pragma unroll
        for (int dt = 0; dt < 4; ++dt) O[dt] = (f32x4){0.f, 0.f, 0.f, 0.f};
        const LAS float* rph = rp + h * 465;
#pragma unroll 2
        for (int y = 0; y < 8; ++y) {
            const int trow = r0 + y; const size_t tk0 = (size_t)b * SEQ + trow * 64 + kc0;
            const bf16* kp = Kn + (tk0 + key0) * 512 + h * 64 + 8 * g;
            const bf16x8 ka0 = *(const bf16x8*)(kp), ka1 = *(const bf16x8*)(kp + 32), kb0 = *(const bf16x8*)(kp + 4 * 512), kb1 = *(const bf16x8*)(kp + 4 * 512 + 32);
            const u32x4* vp = VTL + ((size_t)bh * (SEQ / 8) + (trow * 64 + kc0) / 8 + g) * 64 + i16;
            bf16x8 vf[4];
#pragma unroll
            for (int dt = 0; dt < 4; ++dt) vf[dt] = __builtin_bit_cast(bf16x8, vp[16 * dt]);
            f32x4 s0 = {0.f, 0.f, 0.f, 0.f}, s1 = {0.f, 0.f, 0.f, 0.f};
            s0 = MFMA16(ka0, Qf[0], s0); s0 = MFMA16(ka1, Qf[1], s0); s1 = MFMA16(kb0, Qf[0], s1); s1 = MFMA16(kb1, Qf[1], s1);
            const LAS float* rrow = rph + (trow - r + 7) * 31 + 15;
#pragma unroll
            for (int rr = 0; rr < 4; ++rr) {
                const int ck0 = kc0 + 8 * g + rr, ck1 = ck0 + 4;
                const int dx0 = min(max(ck0 - cq, -15), 15), dx1 = min(max(ck1 - cq, -15), 15);
                const float p0 = (ck0 >= c0 && ck0 < c0 + 16) ? __expf(s0[rr] + rrow[dx0] - mb) : 0.f;
                const float p1 = (ck1 >= c0 && ck1 < c0 + 16) ? __expf(s1[rr] + rrow[dx1] - mb) : 0.f;
                s0[rr] = p0; s1[rr] = p1; lsum += p0 + p1;
            }
            const bf16x8 pf = pack_frag(s0, s1);
#pragma unroll
            for (int dt = 0; dt < 4; ++dt) O[dt] = MFMA16(vf[dt], pf, O[dt]);
        }
#pragma unroll 2
        for (int cb = 0; cb < 8; ++cb) {
            const size_t tk0 = (size_t)ML + b * CTXL + cb * 32;
            const bf16* kp = Kn + (tk0 + key0) * 512 + h * 64 + 8 * g;
            const bf16x8 ka0 = *(const bf16x8*)(kp), ka1 = *(const bf16x8*)(kp + 32), kb0 = *(const bf16x8*)(kp + 4 * 512), kb1 = *(const bf16x8*)(kp + 4 * 512 + 32);
            const u32x4* vp = VTC + ((size_t)bh * (CTXL / 8) + cb * 4 + g) * 64 + i16;
            bf16x8 vf[4];
#pragma unroll
            for (int dt = 0; dt < 4; ++dt) vf[dt] = __builtin_bit_cast(bf16x8, vp[16 * dt]);
            f32x4 s0 = {0.f, 0.f, 0.f, 0.f}, s1 = {0.f, 0.f, 0.f, 0.f};
            s0 = MFMA16(ka0, Qf[0], s0); s0 = MFMA16(ka1, Qf[1], s0); s1 = MFMA16(kb0, Qf[0], s1); s1 = MFMA16(kb1, Qf[1], s1);
#pragma unroll
            for (int rr = 0; rr < 4; ++rr) { const float p0 = __expf(s0[rr] - mb), p1 = __expf(s1[rr] - mb); s0[rr] = p0; s1[rr] = p1; lsum += p0 + p1; }
            const bf16x8 pf = pack_frag(s0, s1);
#pragma unroll
            for (int dt = 0; dt < 4; ++dt) O[dt] = MFMA16(vf[dt], pf, O[dt]);
        }
        lsum += __shfl_xor(lsum, 16); lsum += __shfl_xor(lsum, 32);
        const float inv = 1.0f / lsum;
#pragma unroll
        for (int dt = 0; dt < 4; ++dt) { const size_t off = mq_row * 512 + h * 64 + 16 * dt + 4 * g; const u32x2 z = *(const u32x2*)(ZNA + off);
            *(u32x2*)(Q + off) = (u32x2){pk2(O[dt][0] * inv * blo(z.x), O[dt][1] * inv * bhi(z.x)), pk2(O[dt][2] * inv * blo(z.y), O[dt][3] * inv * bhi(z.y))}; }
    }
}
constexpr int SROW = 144;
constexpr int SM_K = 0, SM_KT = 9216, SM_Q = 18432, SM_V = 27648, SM_TB = 36864, SM_QK = 46080, SM_EG = 55296, SM_ED = 55552, SM_STAGE = 56320;
__device__ __forceinline__ int rowmap(int tau, int g, int r) { return 32 * (tau >> 1) + 8 * g + 4 * (tau & 1) + r; }
struct HelpSet { bf16x8 k[4][2]; bf16x8 q0, q1; f32x4 gk[4]; float gct; };
__device__ __forceinline__ void phase_scan(Ctx& F, const Args& A) {
    const int l = F.lane, g = l >> 4, i16 = l & 15, w = F.wave, tid = F.tid;
    const int sd = blockIdx.x, dir = sd & 1, bh = sd >> 1, b = bh >> 3, h = bh & 7;
    const float* GC = (const float*)(F.ws + WS_GC) + (size_t)sd * NSTEP * 64;
    const bf16* TBg = (const bf16*)(F.ws + WS_TB) + (size_t)sd * NSTEP * 4096;
    bf16* OD = (bf16*)(F.dout + (dir ? DO_OB : DO_OF));
    const int sdst = (tid >> 3) * SROW + (tid & 7) * 16;
    u32x4 stA[5], stB[5]; float gcA = 0.f, glA = 0.f, gcB = 0.f, glB = 0.f;
    HelpSet hA, hB;
    auto issue = [&](int step, u32x4 (&stg)[5], float& sgc, float& sgl) {
        if (step >= NSTEP) return;
        bool lat; int chunk; step_chunk(step, dir, lat, chunk);
        const u32x4* pk = lat ? (const u32x4*)((const bf16*)(F.ws + WS_DK) + ((size_t)bh * SEQ + chunk * 64) * 64) : (const u32x4*)((const bf16*)(F.ws + WS_DKC) + ((size_t)bh * CTXL + chunk * 64) * 64);
        const u32x4* pkt = lat ? (const u32x4*)((const bf16*)(F.ws + WS_DKT) + ((size_t)bh * 128 + chunk) * 4096) : (const u32x4*)((const bf16*)(F.ws + WS_DKTC) + ((size_t)bh * 4 + chunk) * 4096);
        const u32x4* pv = lat ? (const u32x4*)((const bf16*)(F.ws + WS_DV) + ((size_t)bh * SEQ + chunk * 64) * 64) : (const u32x4*)((const bf16*)(F.ws + WS_DVC) + ((size_t)bh * CTXL + chunk * 64) * 64);
        stg[0] = pk[tid]; stg[1] = pkt[tid]; stg[3] = pv[tid]; stg[4] = ((const u32x4*)(TBg + (size_t)step * 4096))[tid];
        stg[2] = lat ? ((const u32x4*)((const bf16*)(F.ws + WS_DQ) + ((size_t)bh * SEQ + chunk * 64) * 64))[tid] : (u32x4){0u, 0u, 0u, 0u};
        if (tid < 64) { sgc = GC[step * 64 + tid]; sgl = GC[step * 64 + (dir ? 0 : 63)]; }
    };
    auto commit = [&](int step, const u32x4 (&stg)[5], float sgc, float sgl) {
        if (step >= NSTEP) return;
        LAS unsigned char* sb = F.lds + (step & 1) * SM_STAGE;
        *(LAS u32x4*)(sb + SM_K + sdst) = stg[0]; *(LAS u32x4*)(sb + SM_KT + sdst) = stg[1]; *(LAS u32x4*)(sb + SM_Q + sdst) = stg[2]; *(LAS u32x4*)(sb + SM_V + sdst) = stg[3]; *(LAS u32x4*)(sb + SM_TB + sdst) = stg[4];
        if (tid < 64) { ((LAS float*)(sb + SM_EG))[tid] = __expf(sgc); ((LAS float*)(sb + SM_ED))[tid] = __expf(sgl - sgc); if (tid == 0) ((LAS float*)(sb + SM_ED))[64] = __expf(sgl); }
    };
    const int tq = 16 * (w & 3) + i16;
    auto hload = [&](int step, HelpSet& H) {
        if (step >= NSTEP || step < 4) return;
        const int chunk = dir ? 131 - step : step - 4;
        const bf16* Kt = (const bf16*)(F.ws + WS_DK) + ((size_t)bh * SEQ + chunk * 64) * 64; const bf16* Qt = (const bf16*)(F.ws + WS_DQ) + ((size_t)bh * SEQ + chunk * 64) * 64;
        H.q0 = *(const bf16x8*)(Qt + tq * 64 + 8 * g); H.q1 = *(const bf16x8*)(Qt + tq * 64 + 8 * g + 32);
        H.gct = GC[step * 64 + tq];
#pragma unroll
        for (int tau = 0; tau < 4; ++tau) { const int tr = 32 * (tau >> 1) + 8 * (i16 >> 2) + 4 * (tau & 1) + (i16 & 3);
            H.k[tau][0] = *(const bf16x8*)(Kt + tr * 64 + 8 * g); H.k[tau][1] = *(const bf16x8*)(Kt + tr * 64 + 8 * g + 32);
            H.gk[tau] = *(const f32x4*)(GC + step * 64 + rowmap(tau, g, 0)); }
    };
    auto hcompute = [&](int step, const HelpSet& H) {
        if (step >= NSTEP || step < 4) return;
        LAS unsigned char* sb = F.lds + (step & 1) * SM_STAGE;
#pragma unroll
        for (int kk = 0; kk < 2; ++kk) {
            f32x4 a[2];
#pragma unroll
            for (int hf = 0; hf < 2; ++hf) { const int tau = 2 * kk + hf;
                f32x4 s = {0.f, 0.f, 0.f, 0.f}; s = MFMA16(H.k[tau][0], H.q0, s); s = MFMA16(H.k[tau][1], H.q1, s);
#pragma unroll
                for (int r = 0; r < 4; ++r) { const int tp = rowmap(tau, g, r); const bool ok = dir ? (tq <= tp) : (tq >= tp); s[r] = ok ? s[r] * __expf(H.gct - H.gk[tau][r]) : 0.f; }
                a[hf] = s; }
            *(LAS bf16x8*)(sb + SM_QK + tq * SROW + (32 * kk + 8 * g) * 2) = pack_frag(a[0], a[1]);
        }
    };
    f32x4 S[4]; bf16x8 Sb[2];
#pragma unroll
    for (int t = 0; t < 4; ++t) S[t] = (f32x4){0.f, 0.f, 0.f, 0.f};
    Sb[0] = (bf16x8){0, 0, 0, 0, 0, 0, 0, 0}; Sb[1] = Sb[0];
    auto chain = [&](int step) {
        LAS unsigned char* sb = F.lds + (step & 1) * SM_STAGE;
        bool lat; int chunk; step_chunk(step, dir, lat, chunk);
        const int vc = 16 * w + i16;
        const LAS float* EG = (const LAS float*)(sb + SM_EG); const LAS float* ED = (const LAS float*)(sb + SM_ED);
        const float gtot = ED[64];
        f32x4 X[4], VN[4], eg[4], ed[4];
        int arow[4];
#pragma unroll
        for (int tau = 0; tau < 4; ++tau) { arow[tau] = 32 * (tau >> 1) + 8 * (i16 >> 2) + 4 * (tau & 1) + (i16 & 3); eg[tau] = *(const LAS f32x4*)(EG + rowmap(tau, g, 0)); ed[tau] = *(const LAS f32x4*)(ED + rowmap(tau, g, 0)); }
#define LDSA(mat, row, kk) (*(const LAS bf16x8*)(sb + (mat) + (row) * SROW + (8 * g + 32 * (kk)) * 2))
#pragma unroll
        for (int tau = 0; tau < 4; ++tau) { f32x4 a = {0.f, 0.f, 0.f, 0.f}; a = MFMA16(LDSA(SM_K, arow[tau], 0), Sb[0], a); a = MFMA16(LDSA(SM_K, arow[tau], 1), Sb[1], a);
#pragma unroll
            for (int r = 0; r < 4; ++r) { const int t = rowmap(tau, g, r); const float v = bf1(*(const LAS unsigned short*)(sb + SM_V + t * SROW + vc * 2)); a[r] = v - eg[tau][r] * a[r]; }
            X[tau] = a; }
        bf16x8 Rb[2]; Rb[0] = pack_frag(X[0], X[1]); Rb[1] = pack_frag(X[2], X[3]);
        asm volatile("" ::: "memory");
#pragma unroll
        for (int tau = 0; tau < 4; ++tau) { f32x4 a = {0.f, 0.f, 0.f, 0.f}; a = MFMA16(LDSA(SM_TB, arow[tau], 0), Rb[0], a); a = MFMA16(LDSA(SM_TB, arow[tau], 1), Rb[1], a); VN[tau] = a; }
        bf16x8 Vb[2], Vs[2]; Vb[0] = pack_frag(VN[0], VN[1]); Vb[1] = pack_frag(VN[2], VN[3]);
        Vs[0] = pack_frag(VN[0] * ed[0], VN[1] * ed[1]); Vs[1] = pack_frag(VN[2] * ed[2], VN[3] * ed[3]);
#pragma unroll
        for (int tau = 0; tau < 4; ++tau) { f32x4 a = S[tau] * gtot; a = MFMA16(LDSA(SM_KT, arow[tau], 0), Vs[0], a); a = MFMA16(LDSA(SM_KT, arow[tau], 1), Vs[1], a); S[tau] = a; }
        asm volatile("" ::: "memory");
        if (lat) {
#pragma unroll
            for (int tau = 0; tau < 4; ++tau) { f32x4 a = {0.f, 0.f, 0.f, 0.f}; a = MFMA16(LDSA(SM_Q, arow[tau], 0), Sb[0], a); a = MFMA16(LDSA(SM_Q, arow[tau], 1), Sb[1], a);
                a = a * eg[tau]; a = MFMA16(LDSA(SM_QK, arow[tau], 0), Vb[0], a); a = MFMA16(LDSA(SM_QK, arow[tau], 1), Vb[1], a);
#pragma unroll
                for (int r = 0; r < 4; ++r) { const int t = rowmap(tau, g, r); OD[((size_t)b * SEQ + chunk * 64 + t) * 512 + h * 64 + vc] = (bf16)f2bf(a[r]); } }
        }
        Sb[0] = pack_frag(S[0], S[1]); Sb[1] = pack_frag(S[2], S[3]);
#undef LDSA
    };
    issue(0, stA, gcA, glA); commit(0, stA, gcA, glA); issue(1, stB, gcB, glB);
    if (w < 4) {
        __syncthreads();
        for (int step = 0; step < NSTEP; step += 2) {
            issue(step + 2, stA, gcA, glA); chain(step); commit(step + 1, stB, gcB, glB);
            __syncthreads();
            issue(step + 3, stB, gcB, glB); chain(step + 1); commit(step + 2, stA, gcA, glA);
            __syncthreads();
        }
    } else {
        hload(0, hA); hcompute(0, hA); hload(1, hB);
        __syncthreads();
        for (int step = 0; step < NSTEP; step += 2) {
            issue(step + 2, stA, gcA, glA); hload(step + 2, hA); hcompute(step + 1, hB); commit(step + 1, stB, gcB, glB);
            __syncthreads();
            issue(step + 3, stB, gcB, glB); hload(step + 3, hB); hcompute(step + 2, hA); commit(step + 2, stA, gcA, glA);
            __syncthreads();
        }
    }
}
__device__ __forceinline__ void phase_mp(Ctx& F, const Args& A) {
    const int l = F.lane, j = l & 7;
    bf16* OF = (bf16*)(F.dout + DO_OF); const bf16* OB = (const bf16*)(F.dout + DO_OB); const bf16* ZDN = (const bf16*)(F.ws + WS_ZDN);
    float w8[8];
#pragma unroll
    for (int e = 0; e < 8; ++e) w8[e] = A.in[14][8 * j + e];
    for (int m = F.gw; m < ML; m += F.NGW) {
        const size_t off = (size_t)m * 512 + 8 * l; float a[8], bq[8], z[8]; unpack8(*(const u32x4*)(OF + off), a); unpack8(*(const u32x4*)(OB + off), bq); unpack8(*(const u32x4*)(ZDN + off), z);
        float ss = 0.f;
#pragma unroll
        for (int e = 0; e < 8; ++e) { a[e] += bq[e]; ss += a[e] * a[e]; }
        const float r = rsqrtf(red8(ss) * (1.f / 64.f) + EPSF);
#pragma unroll
        for (int e = 0; e < 8; ++e) a[e] = a[e] * r * w8[e] * z[e];
        *(u32x4*)(OF + off) = pack8(a);
    }
}
constexpr size_t WS_CTL = 65536, CTL_BYTES = 16384;
constexpr int LDS_MISC = 131072;
#define XB_TMO      128
#define XB_XCNT(j)  (256  + 64 * (j))
#define XB_XSUB(j)  (1280 + 64 * (j))
#define XB_XGEN(j)  (2304 + 64 * (j))
#define XB_TOP      3328
#define XB_TOPGEN   3392
#define XCD_BAR_WORDS 3456
#define XB_SPIN_CAP (1u << 18)

__device__ __forceinline__ unsigned xb_ld(unsigned* p)              { return __hip_atomic_load(p, __ATOMIC_RELAXED, __HIP_MEMORY_SCOPE_AGENT); }
__device__ __forceinline__ unsigned xb_add(unsigned* p, unsigned v) { return __hip_atomic_fetch_add(p, v, __ATOMIC_RELAXED, __HIP_MEMORY_SCOPE_AGENT); }
__device__ __forceinline__ unsigned xb_xcc_id() { return (unsigned)__builtin_amdgcn_s_getreg((3 << 11) | 20) & 0xFu; }
#define XB_SPIN(cond, bar) do { unsigned _sp = 0; while (cond) { __builtin_amdgcn_s_sleep(1); \
    if ((++_sp & 255u) == 0u) { if (xb_ld(&(bar)[XB_TMO])) break; if (_sp > XB_SPIN_CAP) { atomicAdd(&(bar)[XB_TMO], 1u); break; } } } } while (0)

struct XcdBarrier {
    unsigned* bar; unsigned x;
    volatile LAS unsigned* st;
};

__device__ __forceinline__ XcdBarrier xcd_barrier_post(unsigned* bar, volatile LAS unsigned* st) {
    XcdBarrier b; b.bar = bar; b.x = xb_xcc_id(); b.st = st;
    if (threadIdx.x == 0) (void)xb_add(&bar[XB_XCNT(b.x)], 1u);
    return b;
}
__device__ __forceinline__ void xcd_barrier_complete(unsigned* bar, unsigned x, unsigned& nloc, unsigned& nx) {
    const unsigned G = gridDim.x * gridDim.y * gridDim.z;
    unsigned sum, cnt, mine, sp = 0u;
    for (;;) {
        sum = 0u; cnt = 0u; mine = 0u;
#pragma unroll
        for (unsigned j = 0; j < 16; ++j) { const unsigned c = xb_ld(&bar[XB_XCNT(j)]); sum += c; cnt += (c > 0u) ? 1u : 0u; mine = (j == x) ? c : mine; }
        if (sum == G) break;
        __builtin_amdgcn_s_sleep(1);
        if ((++sp & 255u) == 0u) { if (xb_ld(&bar[XB_TMO])) break; if (sp > XB_SPIN_CAP) { atomicAdd(&bar[XB_TMO], 1u); break; } }
    }
    nloc = mine > 0u ? mine : 1u; nx = cnt > 0u ? cnt : 1u;
}

__device__ __forceinline__ void xcd_barrier(const XcdBarrier& b) {
    asm volatile("s_waitcnt vmcnt(0)" ::: "memory");
    __syncthreads();
    if (threadIdx.x == 0) {
        unsigned* bar = b.bar;
        __builtin_amdgcn_s_waitcnt(0);
        unsigned nloc = b.st[0], nx = b.st[1];
        if (nloc == 0u) { xcd_barrier_complete(bar, b.x, nloc, nx); b.st[0] = nloc; b.st[1] = nx; }
        const unsigned old = xb_add(&bar[XB_XSUB(b.x)], 1u);
        const unsigned gen = old / nloc;
        if (old + 1u == (gen + 1u) * nloc) {
            __builtin_amdgcn_fence(__ATOMIC_RELEASE, "agent");
            asm volatile("s_waitcnt vmcnt(0)" ::: "memory");
            const unsigned og = xb_add(&bar[XB_TOP], 1u);
            const unsigned tg = og / nx;
            if (og + 1u == (tg + 1u) * nx) xb_add(&bar[XB_TOPGEN], 1u);
            else XB_SPIN(xb_ld(&bar[XB_TOPGEN]) == tg, bar);
            __builtin_amdgcn_fence(__ATOMIC_ACQUIRE, "agent");
            xb_add(&bar[XB_XGEN(b.x)], 1u);
            asm volatile("s_waitcnt vmcnt(0)" ::: "memory");
        } else {
            XB_SPIN(xb_ld(&bar[XB_XGEN(b.x)]) == gen, bar);
            __builtin_amdgcn_fence(__ATOMIC_ACQUIRE, "agent");
            asm volatile("s_waitcnt vmcnt(0)" ::: "memory");
        }
    }
    __syncthreads();
}

#define REFRESH(F) do { int t_ = threadIdx.x; asm volatile("" : "+v"(t_)); (F).tid = t_; (F).lane = t_ & 63; } while (0)
__global__ void __launch_bounds__(NTHREADS, 2) fwd_kernel(Args args) {
    extern __shared__ __attribute__((aligned(16))) unsigned char lds_raw[];
    cg::grid_group grid = cg::this_grid();
    Ctx F;
    F.lds = (LAS unsigned char*)lds_raw; F.tid = threadIdx.x; F.lane = F.tid & 63; F.wave = __builtin_amdgcn_readfirstlane(F.tid >> 6);
    F.G = gridDim.x; F.gw = blockIdx.x * NWAVES + F.wave; F.NGW = F.G * NWAVES;
    F.ws = args.ws; F.dout = (unsigned char*)args.out;
    unsigned char* ws = args.ws;
    if (F.tid < 8) ((volatile LAS unsigned*)(F.lds + LDS_MISC))[F.tid] = 0u;
    __syncthreads();
    const XcdBarrier bar = xcd_barrier_post((unsigned*)(ws + WS_CTL), (volatile LAS unsigned*)(F.lds + LDS_MISC));

#ifndef SK0
    REFRESH(F); phase0(F, args);
#endif
    grid.sync();
#ifndef SK1
    REFRESH(F); phase1(F, args);
#endif
    xcd_barrier(bar);
#ifndef SK2
    {
        pg8::Gemm gm{(const pg8::bf16_t*)(ws + WS_XN), (const pg8::bf16_t*)(ws + WS_WIN), MT, NPAD, DM}; pg8::StaticOrder S; S.init(MT, NPAD, F.G, (int)blockIdx.x);
        static_assert(pg8::EPI_BA == WS_BA && pg8::EPI_ZNA == WS_ZNA && pg8::EPI_ZDN == WS_ZDN && pg8::EPI_GNA == WS_GNA && pg8::EPI_GDN == WS_GDN && pg8::EPI_NAK == WS_NAK && pg8::EPI_NAV == WS_NAV && pg8::EPI_DNQKV == WS_DNQKV && DO_Q == 0, "epilogue map");
        pg8::EpiIn E{ws, F.dout};
        pg8::gemm_phase<pg8::EpiIn, pg8::StaticOrder, true, true>(F.lds, gm, S, E);
    }
#endif
    xcd_barrier(bar);
#ifndef SK3
    REFRESH(F); phase3(F, args);
#endif
    xcd_barrier(bar);
#ifndef SK4
    REFRESH(F); phase4(F, args);
#endif
    xcd_barrier(bar);
    if (blockIdx.x < 64) {
#ifndef SK6
        REFRESH(F); phase_scan(F, args);
#endif
    } else {
#ifndef SK5
        REFRESH(F); phase_na(F, args, ((int)blockIdx.x - 64) * NWAVES + F.wave, (F.G - 64) * NWAVES);
#endif
    }
    xcd_barrier(bar);
#ifndef SK7
    REFRESH(F); phase_mp(F, args);
#endif
    xcd_barrier(bar);
#ifndef SK8
    {
        pg8::StaticOrder S; S.init(ML, DM, F.G, (int)blockIdx.x);
        pg8::Gemm g1{(const pg8::bf16_t*)(F.dout + DO_Q), (const pg8::bf16_t*)(ws + WS_WONA), ML, DM, 512};
        pg8::EpiGate<0> E1{(const pg8::bf16_t*)(ws + WS_GNA), nullptr, (pg8::bf16_t*)(ws + WS_T1)};
        pg8::gemm_phase<pg8::EpiGate<0>, pg8::StaticOrder, true, true>(F.lds, g1, S, E1);
        __syncthreads();
        pg8::Gemm g2{(const pg8::bf16_t*)(F.dout + DO_OF), (const pg8::bf16_t*)(ws + WS_WODN), ML, DM, 512};
        pg8::EpiGate<1> E2{(const pg8::bf16_t*)(ws + WS_GDN), (const pg8::bf16_t*)(ws + WS_T1), (pg8::bf16_t*)(ws + WS_Y)};
        pg8::gemm_phase<pg8::EpiGate<1>, pg8::StaticOrder, true, true>(F.lds, g2, S, E2);
    }
#endif
    xcd_barrier(bar);
#ifndef SK9
    {
        pg8::StaticOrder S; S.init(ML, DM, F.G, (int)blockIdx.x);
        pg8::Gemm g3{(const pg8::bf16_t*)(ws + WS_Y), (const pg8::bf16_t*)(ws + WS_WOUT), ML, DM, DM};
        pg8::EpiOut E3{args.in[0], (const float*)(ws + WS_MODV), args.out};
        pg8::gemm_phase<pg8::EpiOut, pg8::StaticOrder, true, true>(F.lds, g3, S, E3);
    }
#endif
}

extern "C" void kernel_launch(void* const* d_in, const int* in_sizes, int n_in, void* d_out, int out_size, void* d_ws, size_t ws_size, hipStream_t stream) {
    static int grid = 0;
    if (grid == 0) {
        if (n_in != 18 || out_size != ML * DM || ws_size < WS_END) { fprintf(stderr, "kernel_launch: unexpected problem (n_in %d, out %d, ws %zu)\n", n_in, out_size, ws_size); grid = -1; return; }
        int dev = 0, cus = 0, per_cu = 0;
        hipGetDevice(&dev); hipDeviceGetAttribute(&cus, hipDeviceAttributeMultiprocessorCount, dev);
        if (hipFuncSetAttribute((const void*)fwd_kernel, hipFuncAttributeMaxDynamicSharedMemorySize, LDS_BYTES) != hipSuccess) { fprintf(stderr, "kernel_launch: hipFuncSetAttribute failed\n"); grid = -1; return; }
        hipOccupancyMaxActiveBlocksPerMultiprocessor(&per_cu, (const void*)fwd_kernel, NTHREADS, LDS_BYTES);
        if (per_cu < 1) { fprintf(stderr, "kernel_launch: occupancy query says %d blocks per CU\n", per_cu); per_cu = 1; }
        (void)hipGetLastError();
        grid = cus;
        if (grid < 64) { fprintf(stderr, "kernel_launch: needs >= 64 CUs\n"); grid = -1; return; }
    }
    if (grid < 0) return;
    if (hipMemsetAsync((char*)d_ws + WS_CTL, 0, CTL_BYTES, stream) != hipSuccess) { fprintf(stderr, "kernel_launch: memset failed\n"); return; }
    Args a{};
    for (int i = 0; i < 18; ++i) a.in[i] = (const float*)d_in[i];
    a.out = (float*)d_out; a.ws = (unsigned char*)d_ws;
    void* kargs[] = {&a};
    hipError_t e = hipLaunchCooperativeKernel((const void*)fwd_kernel, dim3(grid), dim3(NTHREADS), kargs, LDS_BYTES, stream);
    if (e != hipSuccess) fprintf(stderr, "kernel_launch: cooperative launch failed: %s (grid %d)\n", hipGetErrorString(e), grid);
}
```

```cpp
#include <hip/hip_runtime.h>
#include <hip/hip_cooperative_groups.h>
#include <cstdio>
#include <cstdint>
namespace cg = cooperative_groups;
namespace pg8 {
#define PG8_LAS __attribute__((address_space(3)))
typedef unsigned short bf16_t;
typedef short bf16x8 __attribute__((ext_vector_type(8)));
typedef float f32x4 __attribute__((ext_vector_type(4)));
typedef unsigned u32x4 __attribute__((ext_vector_type(4)));
constexpr int BM = 256, BK = 64, HALF = 128, HTB = HALF * BK * 2  , STAGE_BYTES = 8 * HTB, NXCD = 8, WGM = 8;

__host__ __device__ __forceinline__ int lds_byte(int r, int c) { const int st = (r >> 4) * 2 + (c >> 5), rr = r & 15, cc = c & 31, ob = rr * 64 + cc * 2; return st * 1024 + (ob ^ (((ob >> 9) & 1) << 5)); }
__host__ __device__ __forceinline__ void stage_rc(int b, int& R, int& C) { const int st = b / 1024, sb = b % 1024, swz = sb ^ (((sb >> 9) & 1) << 5); R = (st >> 1) * 16 + swz / 64; C = (st & 1) * 32 + (swz % 64) / 2; }
__host__ __device__ __forceinline__ int perm32(int rho) { const int n = rho >> 4, i = rho & 15; return 8 * (i >> 2) + 4 * n + (i & 3); }

struct Unit { int pm, pn; };
struct Gemm { const bf16_t* A; const bf16_t* Bt; int M, N, K; };

struct StaticOrder {
    int nM, nN, nwg, G, c;
    __host__ __device__ void init(int M, int N, int G_, int c_) { nM = M / BM; nN = N / BM; nwg = nM * nN; G = G_; c = c_; }
    __host__ __device__ bool next(int i, Unit& u) const {
        const long L = (long)i * G + c; if (L >= nwg) return false;
        int wgid = (int)L; { const int q = nwg / NXCD, r = nwg % NXCD, xcd = wgid % NXCD, off = wgid / NXCD; wgid = (xcd < r ? xcd * (q + 1) : r * (q + 1) + (xcd - r) * q) + off; }
        const int nig = WGM * nN, gid = wgid / nig, fm = gid * WGM, gsz = (nM - fm) < WGM ? (nM - fm) : WGM;
        u.pm = fm + ((wgid % nig) % gsz); u.pn = (wgid % nig) / gsz; return true;
    }
    __device__ __forceinline__ void a_ready(const Unit&) const {}
    __device__ __forceinline__ void done(const Unit&) const {}
};

__device__ __forceinline__ unsigned cvt_pk_bf16(float lo, float hi) { unsigned r; asm volatile("v_cvt_pk_bf16_f32 %0, %1, %2" : "=v"(r) : "v"(lo), "v"(hi)); return r; }
__device__ __forceinline__ float bflo(unsigned w) { return __builtin_bit_cast(float, w << 16); }
__device__ __forceinline__ float bfhi(unsigned w) { return __builtin_bit_cast(float, w & 0xffff0000u); }
__device__ __forceinline__ float sigmoidf_(float v) { return __builtin_amdgcn_rcpf(1.0f + __expf(-v)); }
constexpr size_t EPI_MiB = 1u << 20, EPI_BA = 18 * EPI_MiB, EPI_ZNA = 24 * EPI_MiB, EPI_ZDN = 56 * EPI_MiB, EPI_GNA = 88 * EPI_MiB, EPI_GDN = 152 * EPI_MiB, EPI_NAK = 216 * EPI_MiB, EPI_NAV = 249 * EPI_MiB, EPI_DNQKV = 282 * EPI_MiB;
struct EpiIn {
    static constexpr bool PERM = true, AFTER_DRAIN = false;
    unsigned char* ws; unsigned char* dout;
    const float* wq; const float* wk;
    __device__ __forceinline__ void operator()(const f32x4 (&acc)[2][2][4][2], const Unit& u, int wr, int wc, int fr, int fq) const {
        const int pn = u.pn; size_t boff; int ldc, colt, act = 0; bool latent_only = false; float* ba = (float*)(ws + EPI_BA);
        if (pn < 2) { boff = 0; ldc = 512; colt = pn * 256; latent_only = true; }
        else if (pn < 4) { boff = EPI_NAK; ldc = 512; colt = (pn - 2) * 256; }
        else if (pn < 6) { boff = EPI_NAV; ldc = 512; colt = (pn - 4) * 256; }
        else if (pn < 8) { boff = EPI_ZNA; ldc = 512; colt = (pn - 6) * 256; act = 2; latent_only = true; }
        else if (pn < 14) { boff = EPI_DNQKV; ldc = 1536; colt = (pn - 8) * 256; }
        else if (pn < 16) { boff = EPI_ZDN; ldc = 512; colt = (pn - 14) * 256; act = 2; latent_only = true; }
        else if (pn < 20) { boff = EPI_GNA; ldc = 1024; colt = (pn - 16) * 256; act = 1; latent_only = true; }
        else if (pn < 24) { boff = EPI_GDN; ldc = 1024; colt = (pn - 20) * 256; act = 1; latent_only = true; }
        else {
            if (wc == 0) {
#pragma unroll
                for (int ai = 0; ai < 2; ++ai)
#pragma unroll
                    for (int m = 0; m < 4; ++m) { float* rowp = ba + (size_t)(u.pm * BM + ai * HALF + wr * 64 + m * 16 + fr) * 32 + 8 * fq;
                        *(f32x4*)(rowp) = acc[ai][0][m][0]; *(f32x4*)(rowp + 4) = acc[ai][0][m][1]; }
            }
            return;
        }
        if (latent_only && u.pm >= 128) return;
        if (pn < 4) {
            const float* w = (pn < 2) ? wq : wk; const float qs = (pn < 2) ? 0.125f : 1.0f;
            f32x4 wv[2][2];
#pragma unroll
            for (int bj = 0; bj < 2; ++bj)
#pragma unroll
                for (int n = 0; n < 2; ++n) wv[bj][n] = *(const f32x4*)(w + 32 * bj + 8 * fq + 4 * n) * qs;
            bf16_t* hb = ((pn < 2) ? (bf16_t*)dout : (bf16_t*)(ws + EPI_NAK)) + (size_t)(u.pm * BM + wr * 64 + fr) * 512 + (4 * (pn & 1) + wc) * 64 + 8 * fq;
#pragma unroll
            for (int ai = 0; ai < 2; ++ai)
#pragma unroll
                for (int m = 0; m < 4; ++m) {
                    float ss = 0.f;
#pragma unroll
                    for (int bj = 0; bj < 2; ++bj)
#pragma unroll
                        for (int n = 0; n < 2; ++n) { const f32x4 v = acc[ai][bj][m][n]; ss += (v[0] * v[0] + v[1] * v[1]) + (v[2] * v[2] + v[3] * v[3]); }
                    ss += __shfl_xor(ss, 16); ss += __shfl_xor(ss, 32);
                    const float r = __builtin_amdgcn_rsqf(ss * (1.0f / 64.0f) + 1e-6f);
                    bf16_t* rowp = hb + (size_t)(ai * HALF + m * 16) * 512;
#pragma unroll
                    for (int bj = 0; bj < 2; ++bj) { const f32x4 v0 = acc[ai][bj][m][0] * r * wv[bj][0], v1 = acc[ai][bj][m][1] * r * wv[bj][1];
                        u32x4 o; o.x = cvt_pk_bf16(v0[0], v0[1]); o.y = cvt_pk_bf16(v0[2], v0[3]); o.z = cvt_pk_bf16(v1[0], v1[1]); o.w = cvt_pk_bf16(v1[2], v1[3]);
                        *(u32x4*)(rowp + 32 * bj) = o; }
                }
            return;
        }
        bf16_t* base = (pn < 2) ? (bf16_t*)dout : (bf16_t*)(ws + boff);
        const int row0 = u.pm * BM + wr * 64 + fr, col0 = colt + wc * 32 + 8 * fq;
#pragma unroll
        for (int ai = 0; ai < 2; ++ai)
#pragma unroll
            for (int m = 0; m < 4; ++m) { bf16_t* rowp = base + (size_t)(row0 + ai * HALF + m * 16) * ldc + col0;
#pragma unroll
                for (int bj = 0; bj < 2; ++bj) { f32x4 v0 = acc[ai][bj][m][0], v1 = acc[ai][bj][m][1];
                    if (act != 0) {
#pragma unroll
                        for (int e = 0; e < 4; ++e) { const float s0 = sigmoidf_(v0[e]), s1 = sigmoidf_(v1[e]); v0[e] = (act == 1) ? s0 : v0[e] * s0; v1[e] = (act == 1) ? s1 : v1[e] * s1; }
                    }
                    u32x4 w; w.x = cvt_pk_bf16(v0[0], v0[1]); w.y = cvt_pk_bf16(v0[2], v0[3]); w.z = cvt_pk_bf16(v1[0], v1[1]); w.w = cvt_pk_bf16(v1[2], v1[3]);
                    *(u32x4*)(rowp + bj * HALF) = w; } }
    }
};
template <int MODE> struct EpiGate {
    static constexpr bool PERM = true, AFTER_DRAIN = false;
    const bf16_t* G; const bf16_t* T1; bf16_t* O;
    __device__ __forceinline__ void operator()(const f32x4 (&acc)[2][2][4][2], const Unit& u, int wr, int wc, int fr, int fq) const {
        const int row0 = u.pm * BM + wr * 64 + fr, col0 = u.pn * BM + wc * 32 + 8 * fq;
#pragma unroll
        for (int ai = 0; ai < 2; ++ai)
#pragma unroll
            for (int m = 0; m < 4; ++m) { const size_t off = (size_t)(row0 + ai * HALF + m * 16) * 1024 + col0;
#pragma unroll
                for (int bj = 0; bj < 2; ++bj) { const f32x4 v0 = acc[ai][bj][m][0], v1 = acc[ai][bj][m][1];
                    const u32x4 g = *(const u32x4*)(G + off + bj * HALF);
                    float o[8] = { v0[0] * bflo(g.x), v0[1] * bfhi(g.x), v0[2] * bflo(g.y), v0[3] * bfhi(g.y), v1[0] * bflo(g.z), v1[1] * bfhi(g.z), v1[2] * bflo(g.w), v1[3] * bfhi(g.w) };
                    if (MODE == 1) { const u32x4 t = *(const u32x4*)(T1 + off + bj * HALF);
                        o[0] += bflo(t.x); o[1] += bfhi(t.x); o[2] += bflo(t.y); o[3] += bfhi(t.y); o[4] += bflo(t.z); o[5] += bfhi(t.z); o[6] += bflo(t.w); o[7] += bfhi(t.w); }
                    u32x4 w; w.x = cvt_pk_bf16(o[0], o[1]); w.y = cvt_pk_bf16(o[2], o[3]); w.z = cvt_pk_bf16(o[4], o[5]); w.w = cvt_pk_bf16(o[6], o[7]);
                    *(u32x4*)(O + off + bj * HALF) = w; } }
    }
};
struct EpiOut {
    static constexpr bool PERM = true, AFTER_DRAIN = false;
    const float* x; const float* modv; float* out;
    __device__ __forceinline__ void operator()(const f32x4 (&acc)[2][2][4][2], const Unit& u, int wr, int wc, int fr, int fq) const {
        const int row0 = u.pm * BM + wr * 64 + fr, col0 = u.pn * BM + wc * 32 + 8 * fq;
        const float* gp = modv + (size_t)(u.pm / 32) * 3072 + 2048 + col0;
        f32x4 gv[2][2];
#pragma unroll
        for (int bj = 0; bj < 2; ++bj)
#pragma unroll
            for (int n = 0; n < 2; ++n) gv[bj][n] = *(const f32x4*)(gp + bj * HALF + 4 * n);
#pragma unroll
        for (int ai = 0; ai < 2; ++ai)
#pragma unroll
            for (int m = 0; m < 4; ++m) { const size_t off = (size_t)(row0 + ai * HALF + m * 16) * 1024 + col0;
#pragma unroll
                for (int bj = 0; bj < 2; ++bj)
#pragma unroll
                    for (int n = 0; n < 2; ++n) { const f32x4 xv = *(const f32x4*)(x + off + bj * HALF + 4 * n);
                        *(f32x4*)(out + off + bj * HALF + 4 * n) = xv + gv[bj][n] * acc[ai][bj][m][n]; } }
    }
};
template <class Epi, class Sched, bool ALIGN_EPI = false, bool SP2 = false>
__device__ __forceinline__ void gemm_phase(PG8_LAS unsigned char* lds, const Gemm g, const Sched& S, const Epi& E) {
    int tid_ = threadIdx.x; asm volatile("" : "+v"(tid_));
    const int tid = tid_, wid = __builtin_amdgcn_readfirstlane(tid >> 6), lane = tid & 63, wr = wid >> 2, wc = wid & 3, fr = lane & 15, fq = lane >> 4;
    const int K = g.K, nt = K / BK;
    unsigned voffA[2], voffB[2];
#pragma unroll
    for (int i = 0; i < 2; ++i) { int R, C; stage_rc(tid * 16 + i * 8192, R, C); const int Rb = Epi::PERM ? ((R & ~31) + perm32(R & 31)) : R;
        voffA[i] = (unsigned)(R * K + C) * 2u; voffB[i] = (unsigned)(Rb * K + C) * 2u; }
    const size_t kstep = (size_t)(BK * 2);
    const size_t hstep = (size_t)HALF * K * 2;
    const size_t tstep = 2 * hstep;
    const unsigned ldsw = (unsigned)wid * 1024u;
    const int aoff = lds_byte(wr * 64 + fr, fq * 8), boff = lds_byte(wc * 32 + fr, fq * 8);
#define PG8_SA(b, h) (((b) * 2 + (h)) * HTB)
#define PG8_SB(b, h) ((4 + (b) * 2 + (h)) * HTB)
#define PG8_STAGE(bufoff, gbase, voff) do { _Pragma("unroll") for (int _i = 0; _i < 2; ++_i) \
        __builtin_amdgcn_global_load_lds((const unsigned*)((const char*)(gbase) + (voff)[_i]), (PG8_LAS unsigned*)(lds + (bufoff) + ldsw + _i * 8192), 16, 0, 0); } while (0)
#define PG8_LDA(dst, b, h) do { _Pragma("unroll") for (int m = 0; m < 4; ++m) _Pragma("unroll") for (int k = 0; k < 2; ++k) dst[m][k] = *(const PG8_LAS bf16x8*)(lds + PG8_SA(b, h) + aoff + m * 2048 + k * 1024); } while (0)
#define PG8_LDB(dst, b, h) do { _Pragma("unroll") for (int n = 0; n < 2; ++n) _Pragma("unroll") for (int k = 0; k < 2; ++k) dst[n][k] = *(const PG8_LAS bf16x8*)(lds + PG8_SB(b, h) + boff + n * 2048 + k * 1024); } while (0)
#define PG8_MMA(ai, bj, At, Bt) do { __builtin_amdgcn_s_setprio(1); _Pragma("unroll") for (int m = 0; m < 4; ++m) _Pragma("unroll") for (int n = 0; n < 2; ++n) _Pragma("unroll") for (int k = 0; k < 2; ++k) \
        acc[ai][bj][m][n] = __builtin_amdgcn_mfma_f32_16x16x32_bf16(Bt[n][k], At[m][k], acc[ai][bj][m][n], 0, 0, 0); __builtin_amdgcn_s_setprio(0); } while (0)
#define PG8_WAIT_V(n) asm volatile("s_waitcnt vmcnt(" #n ")" ::: "memory")
#define PG8_WAIT_L(n) asm volatile("s_waitcnt lgkmcnt(" #n ")" ::: "memory")
#define PG8_BAR __builtin_amdgcn_s_barrier()
#define PG8_SCHED __builtin_amdgcn_sched_barrier(0)
    Unit cur, nxt; int ui = 0;
    if (!S.next(0, cur)) return;
    f32x4 acc[2][2][4][2];
#pragma unroll
    for (int a = 0; a < 2; ++a)
#pragma unroll
        for (int b = 0; b < 2; ++b)
#pragma unroll
            for (int m = 0; m < 4; ++m)
#pragma unroll
                for (int n = 0; n < 2; ++n) acc[a][b][m][n] = (f32x4){0.f, 0.f, 0.f, 0.f};
    bf16x8 At[4][2], B0[2][2], B1[2][2];
    const char* cA = (const char*)g.A + (size_t)cur.pm * tstep; const char* cB = (const char*)g.Bt + (size_t)cur.pn * tstep;
    S.a_ready(cur);
    if constexpr (SP2) {
        PG8_STAGE(PG8_SB(0, 0), cB, voffB); PG8_STAGE(PG8_SB(0, 1), cB + hstep, voffB); PG8_STAGE(PG8_SA(0, 0), cA, voffA); PG8_STAGE(PG8_SA(0, 1), cA + hstep, voffA);
        if (wr == 1) PG8_BAR;
        PG8_WAIT_V(2); PG8_BAR;
        PG8_STAGE(PG8_SB(1, 0), cB + kstep, voffB); PG8_STAGE(PG8_SA(1, 0), cA + kstep, voffA); PG8_STAGE(PG8_SB(1, 1), cB + hstep + kstep, voffB);
        PG8_WAIT_V(6); PG8_BAR;
    } else {
        PG8_STAGE(PG8_SB(0, 0), cB, voffB); PG8_STAGE(PG8_SA(0, 0), cA, voffA); PG8_STAGE(PG8_SB(0, 1), cB + hstep, voffB); PG8_STAGE(PG8_SA(0, 1), cA + hstep, voffA);
        if (wr == 1) PG8_BAR;
        PG8_WAIT_V(4); PG8_BAR;
        PG8_STAGE(PG8_SB(1, 0), cB + kstep, voffB); PG8_STAGE(PG8_SA(1, 0), cA + kstep, voffA); PG8_STAGE(PG8_SB(1, 1), cB + hstep + kstep, voffB);
        PG8_WAIT_V(6); PG8_BAR;
    }
    for (;;) {
        const bool has_next = S.next(ui + 1, nxt);
        const char* nA = has_next ? (const char*)g.A + (size_t)nxt.pm * tstep : cA; const char* nB = has_next ? (const char*)g.Bt + (size_t)nxt.pn * tstep : cB;
        for (int t = 0; t < nt; t += 2) {
            const bool last = (t == nt - 2);
            const char* a1 = cA + (size_t)(t + 1) * kstep;
            const char* a2 = last ? nA : cA + (size_t)(t + 2) * kstep; const char* b2 = last ? nB : cB + (size_t)(t + 2) * kstep;
            const char* a3 = a2 + kstep; const char* b3 = b2 + kstep;
            if (last && has_next) S.a_ready(nxt);
            if constexpr (SP2) {
            PG8_LDB(B0, 0, 0); PG8_LDB(B1, 0, 1); PG8_SCHED; PG8_LDA(At, 0, 0); PG8_STAGE(PG8_SA(1, 1), a1 + hstep, voffA);
            PG8_WAIT_V(8); PG8_WAIT_L(0); PG8_BAR; PG8_MMA(0, 0, At, B0); PG8_MMA(0, 1, At, B1); PG8_BAR; PG8_SCHED;
            PG8_LDA(At, 0, 1); PG8_STAGE(PG8_SB(0, 0), b2, voffB); PG8_STAGE(PG8_SB(0, 1), b2 + hstep, voffB); PG8_STAGE(PG8_SA(0, 0), a2, voffA);
            PG8_WAIT_V(8); PG8_WAIT_L(0); PG8_BAR; PG8_MMA(1, 0, At, B0); PG8_MMA(1, 1, At, B1); PG8_BAR; PG8_SCHED;
            PG8_LDB(B0, 1, 0); PG8_LDB(B1, 1, 1); PG8_SCHED; PG8_LDA(At, 1, 0); PG8_STAGE(PG8_SA(0, 1), a2 + hstep, voffA);
            PG8_WAIT_V(8); PG8_WAIT_L(0); PG8_BAR; PG8_MMA(0, 0, At, B0); PG8_MMA(0, 1, At, B1); PG8_BAR; PG8_SCHED;
            PG8_LDA(At, 1, 1); PG8_STAGE(PG8_SB(1, 0), b3, voffB); PG8_STAGE(PG8_SB(1, 1), b3 + hstep, voffB); PG8_STAGE(PG8_SA(1, 0), a3, voffA);
            PG8_WAIT_V(8); PG8_WAIT_L(0); PG8_BAR; PG8_MMA(1, 0, At, B0); PG8_MMA(1, 1, At, B1); PG8_BAR; PG8_SCHED;
            } else {
            PG8_LDB(B0, 0, 0); PG8_SCHED; PG8_LDA(At, 0, 0); PG8_STAGE(PG8_SA(1, 1), a1 + hstep, voffA);
            PG8_WAIT_L(8); PG8_BAR; PG8_WAIT_L(0); PG8_MMA(0, 0, At, B0); PG8_BAR; PG8_SCHED;
            PG8_LDB(B1, 0, 1); PG8_STAGE(PG8_SB(0, 0), b2, voffB);
            PG8_BAR; PG8_WAIT_L(0); PG8_MMA(0, 1, At, B1); PG8_BAR;
            PG8_LDA(At, 0, 1); PG8_STAGE(PG8_SA(0, 0), a2, voffA);
            PG8_BAR; PG8_WAIT_L(0); PG8_MMA(1, 0, At, B0); PG8_BAR; PG8_SCHED;
            PG8_STAGE(PG8_SB(0, 1), b2 + hstep, voffB);
            PG8_WAIT_V(6); PG8_BAR; PG8_MMA(1, 1, At, B1); PG8_BAR;
            PG8_LDB(B0, 1, 0); PG8_SCHED; PG8_LDA(At, 1, 0); PG8_STAGE(PG8_SA(0, 1), a2 + hstep, voffA);
            PG8_WAIT_L(8); PG8_BAR; PG8_WAIT_L(0); PG8_MMA(0, 0, At, B0); PG8_BAR; PG8_SCHED;
            PG8_LDB(B1, 1, 1); PG8_STAGE(PG8_SB(1, 0), b3, voffB);
            PG8_BAR; PG8_WAIT_L(0); PG8_MMA(0, 1, At, B1); PG8_BAR;
            PG8_LDA(At, 1, 1); PG8_STAGE(PG8_SA(1, 0), a3, voffA);
            PG8_BAR; PG8_WAIT_L(0); PG8_MMA(1, 0, At, B0); PG8_BAR; PG8_SCHED;
            PG8_STAGE(PG8_SB(1, 1), b3 + hstep, voffB);
            PG8_WAIT_V(6); PG8_BAR; PG8_MMA(1, 1, At, B1); PG8_BAR;
            }
        }
        if constexpr (ALIGN_EPI) { if (wr == 0) PG8_BAR; }
        if constexpr (!Epi::AFTER_DRAIN) { E(acc, cur, wr, wc, fr, fq); S.done(cur); }
        if (!has_next) break;
#pragma unroll
        for (int a = 0; a < 2; ++a)
#pragma unroll
            for (int b = 0; b < 2; ++b)
#pragma unroll
                for (int m = 0; m < 4; ++m)
#pragma unroll
                    for (int n = 0; n < 2; ++n) acc[a][b][m][n] = (f32x4){0.f, 0.f, 0.f, 0.f};
        cur = nxt; cA = nA; cB = nB; ++ui;
        if constexpr (ALIGN_EPI) { if (wr == 1) PG8_BAR; }
    }
    PG8_WAIT_V(0);
    if constexpr (!ALIGN_EPI) { if (wr == 0) PG8_BAR; }
    PG8_BAR;
    if constexpr (Epi::AFTER_DRAIN) { E.fused(acc, cur, wr, wc, fr, fq, lds, wid, lane); S.done(cur); }
#undef PG8_SA
#undef PG8_SB
#undef PG8_STAGE
#undef PG8_LDA
#undef PG8_LDB
#undef PG8_MMA
#undef PG8_WAIT_V
#undef PG8_WAIT_L
#undef PG8_BAR
#undef PG8_SCHED
}
}
constexpr int DM = 1024, NB = 4, SEQ = 8192, CTXL = 256, NH = 8;
constexpr int ML = NB * SEQ, MC = NB * CTXL, MT = ML + MC;
constexpr int NPROJ = 6176, NPAD = 6400;
constexpr int NSTEP = 132;
constexpr float EPSF = 1e-6f;
constexpr int NWAVES = 8, NTHREADS = 512;
constexpr int LDS_BYTES = 135168;
constexpr size_t MiB = 1u << 20;
constexpr size_t WS_MODCNT = 65536 + 15360;
constexpr size_t WS_MODV = 4096;
constexpr size_t WS_WIN = 1 * MiB;
constexpr size_t WS_WONA = 14 * MiB, WS_WODN = 15 * MiB, WS_WOUT = 16 * MiB;
constexpr size_t WS_BA = 18 * MiB;
constexpr size_t WS_VT8C = 22 * MiB + 512 * 1024;
constexpr size_t WS_ZNA = 24 * MiB, WS_ZDN = 56 * MiB, WS_GNA = 88 * MiB, WS_GDN = 152 * MiB;
constexpr size_t WS_NAK = 216 * MiB, WS_NAV = 249 * MiB, WS_DNQKV = 282 * MiB;
constexpr size_t WS_TB = 282 * MiB, WS_GC = 354 * MiB;
constexpr size_t WS_XN = 381 * MiB;
constexpr size_t WS_DQ = 381 * MiB, WS_DK = 413 * MiB, WS_DKT = 445 * MiB, WS_DV = 477 * MiB;
constexpr size_t WS_DKC = 509 * MiB, WS_DKTC = 510 * MiB, WS_DVC = 511 * MiB;
constexpr size_t WS_T1 = 216 * MiB + 1 * MiB + 69632;
constexpr size_t WS_Y = 445 * MiB;
constexpr size_t WS_END = 512 * MiB;
constexpr size_t DO_Q = 0, DO_VT8 = 32 * MiB, DO_OF = 64 * MiB, DO_OB = 96 * MiB;

#define LAS __attribute__((address_space(3)))
typedef unsigned short bf16;
typedef unsigned u32x4 __attribute__((ext_vector_type(4)));
typedef unsigned u32x2 __attribute__((ext_vector_type(2)));
typedef float f32x4 __attribute__((ext_vector_type(4)));
typedef short bf16x8 __attribute__((ext_vector_type(8)));
#define LDS_WAIT() asm volatile("s_waitcnt lgkmcnt(0)" ::: "memory")
__device__ __forceinline__ unsigned f2bf(float f) { unsigned u = __builtin_bit_cast(unsigned, f); return (u + 0x7fffu + ((u >> 16) & 1u)) >> 16; }
typedef float f32x2_t __attribute__((ext_vector_type(2))); typedef __bf16 bf16x2_t __attribute__((ext_vector_type(2)));
__device__ __forceinline__ unsigned pk2(float lo, float hi) { f32x2_t v = {lo, hi}; bf16x2_t b = __builtin_convertvector(v, bf16x2_t); return __builtin_bit_cast(unsigned, b); }
__device__ __forceinline__ unsigned short f2bf1(float f) { return (unsigned short)(pk2(f, f) & 0xffffu); }
__device__ __forceinline__ float blo(unsigned w) { return __builtin_bit_cast(float, w << 16); }
__device__ __forceinline__ float bhi(unsigned w) { return __builtin_bit_cast(float, w & 0xffff0000u); }
__device__ __forceinline__ float bf1(unsigned short h) { return __builtin_bit_cast(float, ((unsigned)h) << 16); }
__device__ __forceinline__ void unpack8(const u32x4 v, float (&f)[8]) { f[0] = blo(v.x); f[1] = bhi(v.x); f[2] = blo(v.y); f[3] = bhi(v.y); f[4] = blo(v.z); f[5] = bhi(v.z); f[6] = blo(v.w); f[7] = bhi(v.w); }
__device__ __forceinline__ u32x4 pack8(const float (&f)[8]) { u32x4 w; w.x = pk2(f[0], f[1]); w.y = pk2(f[2], f[3]); w.z = pk2(f[4], f[5]); w.w = pk2(f[6], f[7]); return w; }
__device__ __forceinline__ bf16x8 pack_frag(const f32x4 a, const f32x4 b) { u32x4 w; w.x = pk2(a[0], a[1]); w.y = pk2(a[2], a[3]); w.z = pk2(b[0], b[1]); w.w = pk2(b[2], b[3]); return __builtin_bit_cast(bf16x8, w); }
__device__ __forceinline__ float sigm(float v) { return __builtin_amdgcn_rcpf(1.0f + __expf(-v)); }
#define MFMA16(a, b, c) __builtin_amdgcn_mfma_f32_16x16x32_bf16((a), (b), (c), 0, 0, 0)
__device__ __forceinline__ void tr8x8(const u32x4 (&in)[8], u32x4 (&out)[8]) {
#pragma unroll
    for (int e = 0; e < 8; ++e) {
        unsigned w[4];
#pragma unroll
        for (int p = 0; p < 4; ++p) { const unsigned a = in[2 * p][e >> 1], b = in[2 * p + 1][e >> 1];
            w[p] = (e & 1) ? ((a >> 16) | (b & 0xffff0000u)) : ((a & 0xffffu) | (b << 16)); }
        out[e] = (u32x4){w[0], w[1], w[2], w[3]};
    }
}

struct Args { const float* in[18]; float* out; unsigned char* ws; };

struct Ctx {
    LAS unsigned char* lds; int tid, lane, wave, G, gw, NGW;
    unsigned char* ws; unsigned char* dout;
};

__device__ __forceinline__ void p0_transpose_item(const float* W, int K, int N, bf16* WT, int k0, int n0, int dst_row, LAS float* scr, int lane) {
#pragma unroll 8
    for (int i = 0; i < 32; ++i) { const int kk = 2 * i + (lane >> 5); scr[kk * 33 + (lane & 31)] = W[(size_t)(k0 + kk) * N + n0 + (lane & 31)]; }
    LDS_WAIT();
    const int c = lane & 7;
#pragma unroll
    for (int j = 0; j < 4; ++j) { const int n = (lane >> 3) + 8 * j; const LAS float* s = scr + (8 * c) * 33 + n;
        u32x4 o; o.x = pk2(s[0 * 33], s[1 * 33]); o.y = pk2(s[2 * 33], s[3 * 33]); o.z = pk2(s[4 * 33], s[5 * 33]); o.w = pk2(s[6 * 33], s[7 * 33]);
        *(u32x4*)(WT + (size_t)(dst_row + n) * K + k0 + 8 * c) = o; }
    LDS_WAIT();
}
__device__ __forceinline__ void phase0(Ctx& F, const Args& A) {
    if (blockIdx.x < 48) {
        LAS float* sc = (LAS float*)F.lds;
        LAS float* red = (LAS float*)(F.lds + 20480);
        for (int i = F.tid; i < 5 * 1024; i += NTHREADS) { const int v = i >> 10, k = i & 1023; const float cv = (v < 4) ? A.in[1][v * 1024 + k] : A.in[3][k]; sc[i] = cv * sigm(cv); }
        __syncthreads();
        const int n0 = blockIdx.x * 64, kc = F.tid >> 4, c4 = F.tid & 15;
        float acc[5][4];
#pragma unroll
        for (int v = 0; v < 5; ++v)
#pragma unroll
            for (int e = 0; e < 4; ++e) acc[v][e] = 0.f;
#pragma unroll 16
        for (int i = 0; i < 32; ++i) { const int k = kc * 32 + i; const f32x4 w = *(const f32x4*)(A.in[4] + (size_t)k * 3072 + n0 + 4 * c4);
#pragma unroll
            for (int v = 0; v < 5; ++v) { const float s = sc[v * 1024 + k]; acc[v][0] += s * w[0]; acc[v][1] += s * w[1]; acc[v][2] += s * w[2]; acc[v][3] += s * w[3]; } }
#pragma unroll
        for (int v = 0; v < 5; ++v)
#pragma unroll
            for (int e = 0; e < 4; ++e) red[(kc * 5 + v) * 64 + 4 * c4 + e] = acc[v][e];
        __syncthreads();
        if (F.tid < 320) { const int v = F.tid >> 6, col = F.tid & 63; float s = A.in[5][n0 + col];
            for (int k = 0; k < 32; ++k) s += red[(k * 5 + v) * 64 + col];
            ((float*)(F.ws + WS_MODV))[v * 3072 + n0 + col] = s; __threadfence(); }
        __syncthreads();
        if (F.tid == 0) __hip_atomic_fetch_add((unsigned*)(F.ws + WS_MODCNT), 1u, __ATOMIC_RELAXED, __HIP_MEMORY_SCOPE_AGENT);
    }
    { u32x4* z = (u32x4*)(F.ws + WS_WIN + (size_t)NPROJ * 1024 * 2); const int n16 = (NPAD - NPROJ) * 1024 * 2 / 16;
      for (int i = blockIdx.x * NTHREADS + F.tid; i < n16; i += F.G * NTHREADS) z[i] = (u32x4){0u, 0u, 0u, 0u}; }
    LAS float* scr = (LAS float*)(F.lds + F.wave * 16384);
    constexpr int I_IN = 16 * 193, I_ONA = 8 * 32, I_ODN = 8 * 32, I_OUT = 16 * 32;
    if (blockIdx.x >= 48 || F.G <= 48)
    for (int it = (F.G > 48 ? F.gw - 48 * NWAVES : F.gw); it < I_IN + I_ONA + I_ODN + I_OUT; it += (F.G > 48 ? F.NGW - 48 * NWAVES : F.NGW)) {
        int r = it;
        if (r < I_IN) { const int kb = r / 193, nb = r % 193, c0 = 32 * nb; const int dst = (c0 < 1024) ? ((c0 & ~255) + 128 * ((c0 >> 5) & 1) + 32 * ((c0 >> 6) & 3))
                              : ((c0 < 4096) ? c0 : ((c0 < 4128) ? 6144 + (c0 - 4096) : c0 - 32));
            p0_transpose_item(A.in[7], 1024, NPROJ, (bf16*)(F.ws + WS_WIN), 64 * kb, c0, dst, scr, F.lane); continue; }
        r -= I_IN;
        if (r < I_ONA) { p0_transpose_item(A.in[15], 512, 1024, (bf16*)(F.ws + WS_WONA), 64 * (r / 32), 32 * (r % 32), 32 * (r % 32), scr, F.lane); continue; }
        r -= I_ONA;
        if (r < I_ODN) { p0_transpose_item(A.in[16], 512, 1024, (bf16*)(F.ws + WS_WODN), 64 * (r / 32), 32 * (r % 32), 32 * (r % 32), scr, F.lane); continue; }
        r -= I_ODN;
        p0_transpose_item(A.in[17], 1024, 1024, (bf16*)(F.ws + WS_WOUT), 64 * (r / 32), 32 * (r % 32), 32 * (r % 32), scr, F.lane);
    }
}
__device__ __forceinline__ float wave_sum(float v) {
#pragma unroll
    for (int o = 1; o < 64; o <<= 1) v += __shfl_xor(v, o);
    return v;
}
__device__ __forceinline__ void phase1(Ctx& F, const Args& A) {
    const float* modv = (const float*)(F.ws + WS_MODV); bf16* XN = (bf16*)(F.ws + WS_XN);
    for (int ch = F.gw; ch < ML / 16 + MC; ch += F.NGW) {
        const bool isctx = ch >= ML / 16;
        const int row0 = isctx ? ML + (ch - ML / 16) : ch * 16; const int nrow = isctx ? 1 : 16; const int b = isctx ? 4 : row0 / SEQ;
        f32x4 mul[4], add[4];
#pragma unroll
        for (int j = 0; j < 4; ++j) { const int col = 4 * F.lane + 256 * j; const f32x4 nw = *(const f32x4*)(A.in[6] + col), sc = *(const f32x4*)(modv + b * 3072 + 1024 + col);
            mul[j] = nw * (sc + 1.0f); add[j] = *(const f32x4*)(modv + b * 3072 + col); }
#pragma unroll 4
        for (int rr = 0; rr < nrow; ++rr) {
            const int row = row0 + rr; const float* src = (row < ML) ? A.in[0] + (size_t)row * DM : A.in[2] + (size_t)(row - ML) * DM;
            f32x4 v[4]; float s = 0.f;
#pragma unroll
            for (int j = 0; j < 4; ++j) { v[j] = *(const f32x4*)(src + 4 * F.lane + 256 * j); s += (v[j][0] * v[j][0] + v[j][1] * v[j][1]) + (v[j][2] * v[j][2] + v[j][3] * v[j][3]); }
            const float r = rsqrtf(wave_sum(s) * (1.f / DM) + EPSF);
#pragma unroll
            for (int j = 0; j < 4; ++j) { const f32x4 o = v[j] * r * mul[j] + add[j];
                *(u32x2*)(XN + (size_t)row * DM + 4 * F.lane + 256 * j) = (u32x2){pk2(o[0], o[1]), pk2(o[2], o[3])}; }
        }
    }
}
__device__ __forceinline__ float red8(float v) { v += __shfl_xor(v, 1); v += __shfl_xor(v, 2); v += __shfl_xor(v, 4); return v; }
__device__ __forceinline__ void item_pos(int it, bool& lat, int& m0, int& b, int& t0, int& Tseq) {
    lat = it < ML / 8;
    if (lat) { m0 = it * 8; b = m0 / SEQ; t0 = m0 % SEQ; Tseq = SEQ; } else { const int ci = it - ML / 8; m0 = ML + ci * 8; b = ci / 32; t0 = (ci % 32) * 8; Tseq = CTXL; }
}
template <int PASS> __device__ __forceinline__ void phase3(Ctx& F, const Args& A) {
    const int l = F.lane, h = l >> 3, j = l & 7;
    if (PASS == 1) {
        const bf16* NAV = (const bf16*)(F.ws + WS_NAV);
        for (int it = F.gw; it < MT / 8; it += F.NGW) {
            bool lat; int m0, b, t0, Tseq; item_pos(it, lat, m0, b, t0, Tseq);
            const int bh = b * 8 + h;
            { u32x4 vin[8], vout[8];
#pragma unroll
              for (int t = 0; t < 8; ++t) vin[t] = *(const u32x4*)(NAV + (size_t)(m0 + t) * 512 + 8 * l);
              tr8x8(vin, vout);
              u32x4* dst = lat ? (u32x4*)(F.dout + DO_VT8) + ((size_t)bh * (SEQ / 8) + t0 / 8) * 64 + 8 * j : (u32x4*)(F.ws + WS_VT8C) + ((size_t)bh * (CTXL / 8) + t0 / 8) * 64 + 8 * j;
#pragma unroll
              for (int e = 0; e < 8; ++e) dst[e] = vout[e]; }
        }
    }
    if (PASS == 2) {
        const bf16* DNQKV = (const bf16*)(F.ws + WS_DNQKV);
        float fr8[8];
#pragma unroll
        for (int e = 0; e < 8; ++e) fr8[e] = exp2f(-(float)(8 * (j & 1) + e) * (13.287712379549449f / 16.0f));
        for (int s_ = F.gw; s_ < 3 * (ML / 8) + 128 + 3 * (MC / 8); s_ += F.NGW) {
            if (s_ >= 3 * (ML / 8) && s_ < 3 * (ML / 8) + 128) continue;
            const int it2 = (s_ < 3 * (ML / 8)) ? s_ : s_ - 128;
            const int seg = it2 % 3, it = it2 / 3;
            bool lat; int m0, b, t0, Tseq; item_pos(it, lat, m0, b, t0, Tseq);
            if (seg == 0 && !lat) continue;
            const int bh = b * 8 + h;
            float cw[3][8];
#pragma unroll
            for (int tp = 0; tp < 3; ++tp) { const f32x4 a = *(const f32x4*)(A.in[8] + tp * 1536 + seg * 512 + 8 * l), bq = *(const f32x4*)(A.in[8] + tp * 1536 + seg * 512 + 8 * l + 4);
                cw[tp][0] = a[0]; cw[tp][1] = a[1]; cw[tp][2] = a[2]; cw[tp][3] = a[3]; cw[tp][4] = bq[0]; cw[tp][5] = bq[1]; cw[tp][6] = bq[2]; cw[tp][7] = bq[3]; }
            bf16* dst; if (seg == 0) dst = (bf16*)(F.ws + WS_DQ); else if (seg == 1) dst = lat ? (bf16*)(F.ws + WS_DK) : (bf16*)(F.ws + WS_DKC); else dst = lat ? (bf16*)(F.ws + WS_DV) : (bf16*)(F.ws + WS_DVC);
            const bf16* src = DNQKV + (size_t)m0 * 1536 + seg * 512 + 8 * l;
            u32x4 raw[10], res[8];
#pragma unroll
            for (int t = 0; t < 10; ++t) { const int tt = t0 - 1 + t; raw[t] = (tt >= 0 && tt < Tseq) ? *(const u32x4*)(src + (ptrdiff_t)(t - 1) * 1536) : (u32x4){0u, 0u, 0u, 0u}; }
#pragma unroll
            for (int t = 0; t < 8; ++t) {
                const u32x4 r0 = raw[t], r1 = raw[t + 1], r2 = raw[t + 2];
                float a[8], bq[8], cq[8], y[8]; unpack8(r0, a); unpack8(r1, bq); unpack8(r2, cq);
#pragma unroll
                for (int e = 0; e < 8; ++e) { const float s = cw[0][e] * a[e] + cw[1][e] * bq[e] + cw[2][e] * cq[e]; y[e] = s * sigm(s); }
                if (seg < 2) {
                    float ss = 0.f;
#pragma unroll
                    for (int e = 0; e < 8; ++e) ss += y[e] * y[e];
                    const float r = rsqrtf(red8(ss) + EPSF);
#pragma unroll
                    for (int e = 0; e < 8; ++e) y[e] *= r;
                    if (lat) {
                        const int tok = t0 + t; const float pos = (float)((j < 4) ? (tok >> 6) : (tok & 63));
#pragma unroll
                        for (int e = 0; e < 8; ++e) { const float ang = pos * fr8[e]; const float cs = __cosf(ang), sn = __sinf(ang); const float pr = __shfl_xor(y[e], 2);
                            y[e] = (j & 2) ? (y[e] * cs + pr * sn) : (y[e] * cs - pr * sn); }
                    }
                    if (seg == 0) {
#pragma unroll
                        for (int e = 0; e < 8; ++e) y[e] *= 0.125f;
                    }
                }
                res[t] = pack8(y);
                *(u32x4*)(dst + ((size_t)bh * Tseq + t0 + t) * 64 + 8 * j) = res[t];
            }
            if (seg == 1) {
                u32x4 kt[8];
                tr8x8(res, kt);
                bf16* kd = lat ? (bf16*)(F.ws + WS_DKT) : (bf16*)(F.ws + WS_DKTC);
#pragma unroll
                for (int e = 0; e < 8; ++e) *(u32x4*)(kd + (((size_t)bh * (Tseq / 64) + t0 / 64) * 64 + 8 * j + e) * 64 + (t0 & 63)) = kt[e];
            }
        }
    }
}
__device__ __forceinline__ void step_chunk(int step, int dir, bool& lat, int& chunk) { if (step < 4) { lat = false; chunk = dir ? 3 - step : step; } else { lat = true; chunk = dir ? 131 - step : step - 4; } }
__host__ __device__ constexpr int tri_off(int i) { return i == 0 ? 0 : (8 * ((i - 1) >> 2) * (((i - 1) >> 2) + 1) + (i - 1 - 4 * ((i - 1) >> 2)) * 4 * (((i - 1) >> 2) + 1)); }
__host__ __device__ constexpr int tri_len(int i) { return i == 0 ? 0 : 4 * (((i - 1) >> 2) + 1); }
constexpr int TRI_FLOATS = 2176;
typedef float f32x2 __attribute__((ext_vector_type(2)));
template <int I> struct SubstRow {
    static __device__ __forceinline__ void run(f32x2 (&t2)[32], const LAS float* L, float lanef) {
        SubstRow<I - 1>::run(t2, L, lanef);
        f32x2 a0 = {0.f, 0.f}, a1 = {0.f, 0.f};
#pragma unroll
        for (int q = 0; q < tri_len(I) / 4; ++q) { const f32x4 lv = *(const LAS f32x4*)(L + tri_off(I) + 4 * q);
            a0 += (f32x2){lv[0], lv[1]} * t2[2 * q]; a1 += (f32x2){lv[2], lv[3]} * t2[2 * q + 1]; }
        const float s = fmaxf(0.f, 1.f - fabsf(lanef - (float)I)) - ((a0[0] + a0[1]) + (a1[0] + a1[1]));
        if (I & 1) t2[I >> 1][1] = s; else t2[I >> 1][0] = s;
        if ((I & 3) == 3) asm volatile("" ::: "memory");
    }
};
template <> struct SubstRow<-1> { static __device__ __forceinline__ void run(f32x2 (&)[32], const LAS float*, float) {} };
template <int I> struct SubstHalf {
    static __device__ __forceinline__ void run(f32x2 (&t2)[16], const LAS float* L, int hb, float ccf) {
        SubstHalf<I - 1>::run(t2, L, hb, ccf);
        f32x2 a0 = {0.f, 0.f}, a1 = {0.f, 0.f};
        const LAS float* row = L + (hb ? (tri_off(32 + I) + 32) : tri_off(I));
#pragma unroll
        for (int q = 0; q < tri_len(I) / 4; ++q) { const f32x4 lv = *(const LAS f32x4*)(row + 4 * q);
            a0 += (f32x2){lv[0], lv[1]} * t2[2 * q]; a1 += (f32x2){lv[2], lv[3]} * t2[2 * q + 1]; }
        const float s = fmaxf(0.f, 1.f - fabsf(ccf - (float)I)) - ((a0[0] + a0[1]) + (a1[0] + a1[1]));
        if (I & 1) t2[I >> 1][1] = s; else t2[I >> 1][0] = s;
        if ((I & 15) == 15) asm volatile("" ::: "memory");
    }
};
template <> struct SubstHalf<-1> { static __device__ __forceinline__ void run(f32x2 (&)[16], const LAS float*, int, float) {} };
constexpr int P4_WAVE_LDS = 16384, P4_T11 = 8704, P4_T22 = 8704 + 2048;

template <bool CTX> __device__ __forceinline__ void phase4(Ctx& F, const Args& A) {
    LAS float* Lt = (LAS float*)(F.lds + F.wave * P4_WAVE_LDS);
    LAS unsigned char* Wb = F.lds + F.wave * P4_WAVE_LDS;
    const float* BA = (const float*)(F.ws + WS_BA);
    for (int jt_ = CTX ? F.wave : F.gw; jt_ < (CTX ? 4 : 64 * 128); jt_ += (CTX ? 4 : F.NGW)) {
        const int id = CTX ? (int)blockIdx.x * NSTEP + jt_ : (jt_ >> 7) * NSTEP + 4 + (jt_ & 127);
        int l = F.lane; asm volatile("" : "+v"(l));
        const int g = l >> 4, i16 = l & 15;
        const int step = id % NSTEP, sd = id / NSTEP, dir = sd & 1, bh = sd >> 1, b = bh >> 3, h = bh & 7;
        bool lat; int chunk; step_chunk(step, dir, lat, chunk);
        const int tl = dir ? 63 - l : l;
        const int m = lat ? b * SEQ + chunk * 64 + tl : ML + b * CTXL + chunk * 64 + tl;
        const float braw = BA[(size_t)m * 32 + dir * 8 + h], araw = BA[(size_t)m * 32 + 16 + dir * 8 + h];
        const float beta = sigm(braw);
        const float xs = araw + A.in[13][dir * 8 + h];
        const float sp = (xs > 15.f) ? xs : log1pf(expf(xs));
        float gc = -expf(A.in[12][dir * 8 + h]) * sp;
#pragma unroll
        for (int o = 1; o < 64; o <<= 1) { const float v = __shfl_up(gc, o); if (l >= o) gc += v; }
        ((float*)(F.ws + WS_GC))[(size_t)id * 64 + tl] = gc;
        const bf16* Kt = lat ? (const bf16*)(F.ws + WS_DK) + ((size_t)bh * SEQ + chunk * 64) * 64 : (const bf16*)(F.ws + WS_DKC) + ((size_t)bh * CTXL + chunk * 64) * 64;
        bf16x8 Kf[4][2];
#pragma unroll
        for (int it = 0; it < 4; ++it)
#pragma unroll
            for (int kk = 0; kk < 2; ++kk) { const int li = 16 * it + i16; const int tk = dir ? 63 - li : li; Kf[it][kk] = *(const bf16x8*)(Kt + tk * 64 + 8 * g + 32 * kk); }
#pragma unroll
        for (int it = 0; it < 4; ++it) {
            float gci[4], bti[4];
#pragma unroll
            for (int r = 0; r < 4; ++r) { gci[r] = __shfl(gc, 16 * it + 4 * g + r); bti[r] = __shfl(beta, 16 * it + 4 * g + r); }
#pragma unroll
            for (int jt = 0; jt <= it; ++jt) {
                f32x4 a = {0.f, 0.f, 0.f, 0.f};
                a = MFMA16(Kf[it][0], Kf[jt][0], a); a = MFMA16(Kf[it][1], Kf[jt][1], a);
                const int jj = 16 * jt + i16; const float gcj = __shfl(gc, jj);
#pragma unroll
                for (int r = 0; r < 4; ++r) { const int ii = 16 * it + 4 * g + r; const int q = (ii - 1) >> 2; const int len = (ii == 0) ? 0 : 4 * (q + 1);
                    const int off = (ii == 0) ? 0 : (8 * q * (q + 1) + (ii - 1 - 4 * q) * 4 * (q + 1));
                    if (jj < len) Lt[off + jj] = (jj < ii) ? bti[r] * a[r] * __expf(gci[r] - gcj) : 0.f; }
            }
        }
        LDS_WAIT();
        const int hb = l >> 5, cc = l & 31;
        f32x2 t2[16];
#pragma unroll
        for (int q = 0; q < 16; ++q) t2[q] = (f32x2){0.f, 0.f};
        SubstHalf<31>::run(t2, Lt, hb, (float)cc);
        asm volatile("" ::: "memory");
        if (hb == 0) {
#pragma unroll
            for (int q = 0; q < 4; ++q) *(LAS u32x4*)(Wb + P4_T11 + cc * 64 + 16 * q) = (u32x4){pk2(t2[4 * q][0], t2[4 * q][1]), pk2(t2[4 * q + 1][0], t2[4 * q + 1][1]), pk2(t2[4 * q + 2][0], t2[4 * q + 2][1]), pk2(t2[4 * q + 3][0], t2[4 * q + 3][1])};
        } else {
#pragma unroll
            for (int i = 0; i < 32; ++i) *(LAS unsigned short*)(Wb + P4_T22 + (i * 32 + cc) * 2) = f2bf1(t2[i >> 1][i & 1]);
        }
        LDS_WAIT();
        f32x4 T21[2][2];
        {
            bf16x8 Af[2], Bf[2], A2[2];
#pragma unroll
            for (int mt = 0; mt < 2; ++mt) { const int ii = 32 + 16 * mt + i16; const int q = (ii - 1) >> 2; const int off = 8 * q * (q + 1) + (ii - 1 - 4 * q) * 4 * (q + 1);
                Af[mt] = pack_frag(*(const LAS f32x4*)(Lt + off + 8 * g), *(const LAS f32x4*)(Lt + off + 8 * g + 4));
                const u32x2 lo = *(const LAS u32x2*)(Wb + P4_T22 + ((16 * mt + i16) * 32 + 4 * g) * 2), hi = *(const LAS u32x2*)(Wb + P4_T22 + ((16 * mt + i16) * 32 + 16 + 4 * g) * 2);
                A2[mt] = __builtin_bit_cast(bf16x8, (u32x4){lo.x, lo.y, hi.x, hi.y}); }
#pragma unroll
            for (int nt = 0; nt < 2; ++nt) Bf[nt] = *(const LAS bf16x8*)(Wb + P4_T11 + (16 * nt + i16) * 64 + g * 16);
#pragma unroll
            for (int nt = 0; nt < 2; ++nt) {
                f32x4 x0 = {0.f, 0.f, 0.f, 0.f}, x1 = {0.f, 0.f, 0.f, 0.f};
                x0 = MFMA16(Af[0], Bf[nt], x0); x1 = MFMA16(Af[1], Bf[nt], x1);
                const bf16x8 xb = pack_frag(x0, x1);
                f32x4 z0 = {0.f, 0.f, 0.f, 0.f}, z1 = {0.f, 0.f, 0.f, 0.f};
                T21[0][nt] = MFMA16(A2[0], xb, z0); T21[1][nt] = MFMA16(A2[1], xb, z1);
            }
        }
        LDS_WAIT();
        LAS unsigned short* Tt = (LAS unsigned short*)Wb;
#pragma unroll
        for (int i = 0; i < 32; ++i) { const int ii = 32 * hb + i; const int ti = dir ? 63 - ii : ii; Tt[ti * 64 + tl] = f2bf1(t2[i >> 1][i & 1] * beta); }
        if (hb) {
#pragma unroll
            for (int i = 0; i < 32; ++i) { const int ti = dir ? 63 - i : i; Tt[ti * 64 + tl] = (unsigned short)0; }
        }
#pragma unroll
        for (int nt = 0; nt < 2; ++nt) { const int jj = 16 * nt + i16; const float bj = __shfl(beta, jj); const int tj = dir ? 63 - jj : jj;
#pragma unroll
            for (int mt = 0; mt < 2; ++mt)
#pragma unroll
                for (int r = 0; r < 4; ++r) { const int ii = 32 + 16 * mt + 4 * g + r; const int ti = dir ? 63 - ii : ii; Tt[ti * 64 + tj] = f2bf1(-T21[mt][nt][r] * bj); } }
        LDS_WAIT();
        u32x4* TBg = (u32x4*)((bf16*)(F.ws + WS_TB) + (size_t)id * 4096);
#pragma unroll
        for (int k = 0; k < 8; ++k) TBg[l + 64 * k] = *(const LAS u32x4*)(Wb + (l + 64 * k) * 16);
        LDS_WAIT();
    }
    if (CTX) asm volatile("s_waitcnt vmcnt(0)" ::: "memory");
}
constexpr int NA_KC = 16384, NA_VC = 53248;
__device__ __forceinline__ void phase_na(Ctx& F, const Args& A, int nb, int nblk) {
    const int l = F.lane, g = l >> 4, i16 = l & 15;
    LAS float* rp = (LAS float*)F.lds;
    for (int i = F.tid; i < 8 * 465; i += NTHREADS) rp[i] = A.in[11][i];
    float mq = fabsf(A.in[9][l]), mk = fabsf(A.in[10][l]), mr = 0.f;
    for (int i = l; i < 8 * 465; i += 64) mr = fmaxf(mr, fabsf(A.in[11][i]));
#pragma unroll
    for (int o = 1; o < 64; o <<= 1) { mq = fmaxf(mq, __shfl_xor(mq, o)); mk = fmaxf(mk, __shfl_xor(mk, o)); mr = fmaxf(mr, __shfl_xor(mr, o)); }
    const float mb = 8.0f * mq * mk + mr;
    __syncthreads();
    bf16* Q = (bf16*)(F.dout + DO_Q); const bf16* Kn = (const bf16*)(F.ws + WS_NAK); const bf16* ZNA = (const bf16*)(F.ws + WS_ZNA);
    const u32x4* VTL = (const u32x4*)(F.dout + DO_VT8); const u32x4* VTC = (const u32x4*)(F.ws + WS_VT8C);
    const int key0 = 8 * (i16 >> 2) + (i16 & 3);
    const int swc = 4 * (i16 >> 3);
    int cur_bh = -1;
    for (int grp = nb * 1024 / nblk; grp < (nb + 1) * 1024 / nblk; ++grp) {
        const int task = grp * 8 + F.wave;
        const int jq = task & 3, rp2 = (task >> 2) & 63, bh = task >> 8, b = bh >> 3, h = bh & 7;
        if (bh != cur_bh) {
            __syncthreads();
#pragma unroll
            for (int k = 0; k < 4; ++k) { const int ci = F.tid + 512 * k; const int key = ci >> 3, p = ci & 7;
                *(LAS u32x4*)(F.lds + NA_KC + key * 144 + ((p ^ (4 * ((key >> 4) & 1))) * 16)) = *(const u32x4*)(Kn + ((size_t)ML + b * CTXL + key) * 512 + h * 64 + 8 * p);
                *(LAS u32x4*)(F.lds + NA_VC + ci * 16) = VTC[(size_t)bh * (CTXL / 8) * 64 + ci]; }
            __syncthreads();
            cur_bh = bh;
        }
        const int q0 = 16 * jq, kc0 = (jq == 0) ? 0 : ((jq == 1) ? 8 : ((jq == 2) ? 24 : 32));
        const int ra = 2 * rp2, rb = ra + 1;
        const int r0a = min(max(ra - 4, 0), 120), r0b = min(max(rb - 4, 0), 120);
        const size_t mrow_a = (size_t)b * SEQ + ra * 64 + q0 + i16, mrow_b = mrow_a + 64;
        bf16x8 Qa[2], Qb[2];
#pragma unroll
        for (int kk = 0; kk < 2; ++kk) { Qa[kk] = *(const bf16x8*)(Q + mrow_a * 512 + h * 64 + 8 * g + 32 * kk); Qb[kk] = *(const bf16x8*)(Q + mrow_b * 512 + h * 64 + 8 * g + 32 * kk); }
        const int cq = q0 + i16, c0 = min(max(cq - 8, 0), 48);
        f32x4 Oa[4], Ob[4]; float lsa = 0.f, lsb = 0.f;
#pragma unroll
        for (int dt = 0; dt < 4; ++dt) { Oa[dt] = (f32x4){0.f, 0.f, 0.f, 0.f}; Ob[dt] = (f32x4){0.f, 0.f, 0.f, 0.f}; }
        const LAS float* rph = rp + h * 465;
        bool ok0[4], ok1[4]; int dx0[4], dx1[4];
#pragma unroll
        for (int rr = 0; rr < 4; ++rr) { const int ck0 = kc0 + 8 * g + rr, ck1 = ck0 + 4; ok0[rr] = (ck0 >= c0 && ck0 < c0 + 16); ok1[rr] = (ck1 >= c0 && ck1 < c0 + 16);
            dx0[rr] = min(max(ck0 - cq, -15), 15) + 15; dx1[rr] = min(max(ck1 - cq, -15), 15) + 15; }
#pragma unroll 3
        for (int y = 0; y < 9; ++y) {
            const int trow = r0a + y;
            if (trow >= r0b + 8) break;
            const size_t tk0 = (size_t)b * SEQ + trow * 64 + kc0;
            const bf16* kp = Kn + (tk0 + key0) * 512 + h * 64 + 8 * g;
            const bf16x8 ka0 = *(const bf16x8*)(kp), ka1 = *(const bf16x8*)(kp + 32), kb0 = *(const bf16x8*)(kp + 4 * 512), kb1 = *(const bf16x8*)(kp + 4 * 512 + 32);
            const u32x4* vp = VTL + ((size_t)bh * (SEQ / 8) + (trow * 64 + kc0) / 8 + g) * 64 + i16;
            bf16x8 vf[4];
#pragma unroll
            for (int dt = 0; dt < 4; ++dt) vf[dt] = __builtin_bit_cast(bf16x8, vp[16 * dt]);
            if (trow < r0a + 8) {
                f32x4 s0 = {0.f, 0.f, 0.f, 0.f}, s1 = {0.f, 0.f, 0.f, 0.f};
                s0 = MFMA16(ka0, Qa[0], s0); s0 = MFMA16(ka1, Qa[1], s0); s1 = MFMA16(kb0, Qa[0], s1); s1 = MFMA16(kb1, Qa[1], s1);
                const LAS float* rrow = rph + (trow - ra + 7) * 31;
#pragma unroll
                for (int rr = 0; rr < 4; ++rr) { const float p0 = ok0[rr] ? __expf(s0[rr] + rrow[dx0[rr]] - mb) : 0.f, p1 = ok1[rr] ? __expf(s1[rr] + rrow[dx1[rr]] - mb) : 0.f; s0[rr] = p0; s1[rr] = p1; lsa += p0 + p1; }
                const bf16x8 pf = pack_frag(s0, s1);
#pragma unroll
                for (int dt = 0; dt < 4; ++dt) Oa[dt] = MFMA16(vf[dt], pf, Oa[dt]);
            }
            if (trow >= r0b) {
                f32x4 s0 = {0.f, 0.f, 0.f, 0.f}, s1 = {0.f, 0.f, 0.f, 0.f};
                s0 = MFMA16(ka0, Qb[0], s0); s0 = MFMA16(ka1, Qb[1], s0); s1 = MFMA16(kb0, Qb[0], s1); s1 = MFMA16(kb1, Qb[1], s1);
                const LAS float* rrow = rph + (trow - rb + 7) * 31;
#pragma unroll
                for (int rr = 0; rr < 4; ++rr) { const float p0 = ok0[rr] ? __expf(s0[rr] + rrow[dx0[rr]] - mb) : 0.f, p1 = ok1[rr] ? __expf(s1[rr] + rrow[dx1[rr]] - mb) : 0.f; s0[rr] = p0; s1[rr] = p1; lsb += p0 + p1; }
                const bf16x8 pf = pack_frag(s0, s1);
#pragma unroll
                for (int dt = 0; dt < 4; ++dt) Ob[dt] = MFMA16(vf[dt], pf, Ob[dt]);
            }
        }
#pragma unroll 2
        for (int cb = 0; cb < 8; ++cb) {
            const LAS unsigned char* kp = F.lds + NA_KC + (cb * 32 + key0) * 144;
            const bf16x8 ka0 = *(const LAS bf16x8*)(kp + ((g ^ swc) * 16)), ka1 = *(const LAS bf16x8*)(kp + (((g + 4) ^ swc) * 16)), kb0 = *(const LAS bf16x8*)(kp + 4 * 144 + ((g ^ swc) * 16)), kb1 = *(const LAS bf16x8*)(kp + 4 * 144 + (((g + 4) ^ swc) * 16));
            bf16x8 vf[4];
#pragma unroll
            for (int dt = 0; dt < 4; ++dt) vf[dt] = *(const LAS bf16x8*)(F.lds + NA_VC + ((cb * 4 + g) * 64 + 16 * dt + i16) * 16);
            {   f32x4 s0 = {0.f, 0.f, 0.f, 0.f}, s1 = {0.f, 0.f, 0.f, 0.f};
                s0 = MFMA16(ka0, Qa[0], s0); s0 = MFMA16(ka1, Qa[1], s0); s1 = MFMA16(kb0, Qa[0], s1); s1 = MFMA16(kb1, Qa[1], s1);
#pragma unroll
                for (int rr = 0; rr < 4; ++rr) { const float p0 = __expf(s0[rr] - mb), p1 = __expf(s1[rr] - mb); s0[rr] = p0; s1[rr] = p1; lsa += p0 + p1; }
                const bf16x8 pf = pack_frag(s0, s1);
#pragma unroll
                for (int dt = 0; dt < 4; ++dt) Oa[dt] = MFMA16(vf[dt], pf, Oa[dt]); }
            {   f32x4 s0 = {0.f, 0.f, 0.f, 0.f}, s1 = {0.f, 0.f, 0.f, 0.f};
                s0 = MFMA16(ka0, Qb[0], s0); s0 = MFMA16(ka1, Qb[1], s0); s1 = MFMA16(kb0, Qb[0], s1); s1 = MFMA16(kb1, Qb[1], s1);
#pragma unroll
                for (int rr = 0; rr < 4; ++rr) { const float p0 = __expf(s0[rr] - mb), p1 = __expf(s1[rr] - mb); s0[rr] = p0; s1[rr] = p1; lsb += p0 + p1; }
                const bf16x8 pf = pack_frag(s0, s1);
#pragma unroll
                for (int dt = 0; dt < 4; ++dt) Ob[dt] = MFMA16(vf[dt], pf, Ob[dt]); }
        }
        lsa += __shfl_xor(lsa, 16); lsa += __shfl_xor(lsa, 32); lsb += __shfl_xor(lsb, 16); lsb += __shfl_xor(lsb, 32);
        const float inva = 1.0f / lsa, invb = 1.0f / lsb;
#pragma unroll
        for (int dt = 0; dt < 4; ++dt) {
            const size_t offa = mrow_a * 512 + h * 64 + 16 * dt + 4 * g, offb = mrow_b * 512 + h * 64 + 16 * dt + 4 * g; const u32x2 za = *(const u32x2*)(ZNA + offa), zb = *(const u32x2*)(ZNA + offb);
            *(u32x2*)(Q + offa) = (u32x2){pk2(Oa[dt][0] * inva * blo(za.x), Oa[dt][1] * inva * bhi(za.x)), pk2(Oa[dt][2] * inva * blo(za.y), Oa[dt][3] * inva * bhi(za.y))};
            *(u32x2*)(Q + offb) = (u32x2){pk2(Ob[dt][0] * invb * blo(zb.x), Ob[dt][1] * invb * bhi(zb.x)), pk2(Ob[dt][2] * invb * blo(zb.y), Ob[dt][3] * invb * bhi(zb.y))}; }
    }
}
constexpr int TOUCH_AHEAD = 1000;
constexpr int SROW = 144;
constexpr int SM_K = 0, SM_KT = 9216, SM_Q = 18432, SM_V = 27648, SM_TB = 36864, SM_QK = 46080, SM_EG = 55296, SM_ED = 55552, SM_GR = 55872, SM_O = 56320, SM_STAGE = 65536;
__device__ __forceinline__ int rowmap(int tau, int g, int r) { return 32 * (tau >> 1) + 8 * g + 4 * (tau & 1) + r; }
#ifdef BAR2X
#define SCAN_BAR() do { asm volatile("s_waitcnt lgkmcnt(0)" ::: "memory"); __builtin_amdgcn_s_barrier(); asm volatile("" ::: "memory"); __builtin_amdgcn_s_barrier(); asm volatile("" ::: "memory"); __builtin_amdgcn_s_barrier(); asm volatile("" ::: "memory"); } while (0)
#else
#define SCAN_BAR() do { asm volatile("s_waitcnt lgkmcnt(0)" ::: "memory"); __builtin_amdgcn_s_barrier(); asm volatile("" ::: "memory"); } while (0)
#endif
__device__ __forceinline__ void phase_scan(Ctx& F, const Args& A) {
    const int l = F.lane, g = l >> 4, i16 = l & 15, w = F.wave, tid = F.tid;
    const int sd = blockIdx.x, dir = sd & 1, bh = sd >> 1, b = bh >> 3, h = bh & 7;
    const float* GC = (const float*)(F.ws + WS_GC) + (size_t)sd * NSTEP * 64;
    const bf16* TBg = (const bf16*)(F.ws + WS_TB) + (size_t)sd * NSTEP * 4096;
    if (w < 4) {
        bf16* OD = (bf16*)(F.dout + (dir ? DO_OB : DO_OF));
        f32x4 S[4]; bf16x8 Sb[2];
#pragma unroll
        for (int t = 0; t < 4; ++t) S[t] = (f32x4){0.f, 0.f, 0.f, 0.f};
        Sb[0] = (bf16x8){0, 0, 0, 0, 0, 0, 0, 0}; Sb[1] = Sb[0];
        const int vc = 16 * w + i16;
        const int sw = 4 * (i16 >> 3), swv = 4 * (g >> 1);
        int arow[4];
#pragma unroll
        for (int tau = 0; tau < 4; ++tau) arow[tau] = 32 * (tau >> 1) + 8 * (i16 >> 2) + 4 * (tau & 1) + (i16 & 3);
        SCAN_BAR();
        for (int step = 0; step < NSTEP; ++step) {
            LAS unsigned char* sb = F.lds + (step & 1) * SM_STAGE;
            bool lat; int chunk; step_chunk(step, dir, lat, chunk);
            {
                const int ts = step + TOUCH_AHEAD;
                if (ts < NSTEP) {
                    bool tlat; int tch; step_chunk(ts, dir, tlat, tch);
                    const char* p0; const char* p1;
                    if (w == 0) { p0 = tlat ? (const char*)((const bf16*)(F.ws + WS_DK) + ((size_t)bh * SEQ + tch * 64) * 64) : (const char*)((const bf16*)(F.ws + WS_DKC) + ((size_t)bh * CTXL + tch * 64) * 64);
                                  p1 = tlat ? (const char*)((const bf16*)(F.ws + WS_DKT) + ((size_t)bh * 128 + tch) * 4096) : (const char*)((const bf16*)(F.ws + WS_DKTC) + ((size_t)bh * 4 + tch) * 4096); }
                    else if (w == 1) { p0 = tlat ? (const char*)((const bf16*)(F.ws + WS_DV) + ((size_t)bh * SEQ + tch * 64) * 64) : (const char*)((const bf16*)(F.ws + WS_DVC) + ((size_t)bh * CTXL + tch * 64) * 64);
                                       p1 = (const char*)((const bf16*)(F.ws + WS_DQ) + ((size_t)bh * SEQ + (tlat ? tch : 0) * 64) * 64); }
                    else { p0 = (const char*)(TBg + (size_t)ts * 4096); p1 = (const char*)(GC + ts * 64) - (size_t)(l >= 2 ? (l - 1) * 128 : 0); }
                    if (w < 3) { const char* q0 = p0 + l * 128; const char* q1 = p1 + l * 128;
                        asm volatile("global_load_dword v250, %0, off\n\tglobal_load_dword v251, %1, off" :: "v"(q0), "v"(q1) : "v250", "v251", "memory"); }
                }
            }
            const LAS float* EG = (const LAS float*)(sb + SM_EG); const LAS float* ED = (const LAS float*)(sb + SM_ED);
            const float gtot = ED[64];
            f32x4 X[4], VN[4], eg[4], ed[4];
#pragma unroll
            for (int tau = 0; tau < 4; ++tau) { eg[tau] = *(const LAS f32x4*)(EG + rowmap(tau, g, 0)); ed[tau] = *(const LAS f32x4*)(ED + rowmap(tau, g, 0)); }
#define LDSA(mat, row, kk) (*(const LAS bf16x8*)(sb + (mat) + (row) * SROW + (((g + 4 * (kk)) ^ sw) * 16)))
#pragma unroll
            for (int tau = 0; tau < 4; ++tau) { f32x4 a = {0.f, 0.f, 0.f, 0.f}; a = MFMA16(LDSA(SM_K, arow[tau], 0), Sb[0], a); a = MFMA16(LDSA(SM_K, arow[tau], 1), Sb[1], a);
#pragma unroll
                for (int r = 0; r < 4; ++r) { const int t = rowmap(tau, g, r); const float v = bf1(*(const LAS unsigned short*)(sb + SM_V + t * SROW + (((vc >> 3) ^ swv) * 16) + (vc & 7) * 2)); a[r] = v - eg[tau][r] * a[r]; }
                X[tau] = a; }
            bf16x8 Rb[2]; Rb[0] = pack_frag(X[0], X[1]); Rb[1] = pack_frag(X[2], X[3]);
#ifdef CHAIN2X
            { f32x4 D[4];
#pragma unroll
              for (int rep = 0; rep < 3; ++rep) {
#pragma unroll
                for (int tau = 0; tau < 4; ++tau) { f32x4 a = {0.f, 0.f, 0.f, 0.f}; a = MFMA16(LDSA(SM_K, arow[tau], 0), rep ? pack_frag(D[0], D[1]) : Sb[0], a); a = MFMA16(LDSA(SM_K, arow[tau], 1), Sb[1], a); D[tau] = a; }
              }
              asm volatile("" :: "v"(D[0]), "v"(D[1]), "v"(D[2]), "v"(D[3])); }
#endif
#pragma unroll
            for (int tau = 0; tau < 4; ++tau) { f32x4 a = {0.f, 0.f, 0.f, 0.f}; a = MFMA16(LDSA(SM_TB, arow[tau], 0), Rb[0], a); a = MFMA16(LDSA(SM_TB, arow[tau], 1), Rb[1], a); VN[tau] = a; }
            bf16x8 Vb[2], Vs[2]; Vb[0] = pack_frag(VN[0], VN[1]); Vb[1] = pack_frag(VN[2], VN[3]);
            Vs[0] = pack_frag(VN[0] * ed[0], VN[1] * ed[1]); Vs[1] = pack_frag(VN[2] * ed[2], VN[3] * ed[3]);
#pragma unroll
            for (int tau = 0; tau < 4; ++tau) { f32x4 a = S[tau] * gtot; a = MFMA16(LDSA(SM_KT, arow[tau], 0), Vs[0], a); a = MFMA16(LDSA(SM_KT, arow[tau], 1), Vs[1], a); S[tau] = a; }
            SCAN_BAR();
            if (lat) {
#pragma unroll
                for (int tau = 0; tau < 4; ++tau) { f32x4 a = {0.f, 0.f, 0.f, 0.f}; a = MFMA16(LDSA(SM_Q, arow[tau], 0), Sb[0], a); a = MFMA16(LDSA(SM_Q, arow[tau], 1), Sb[1], a);
                    a = a * eg[tau]; a = MFMA16(LDSA(SM_QK, arow[tau], 0), Vb[0], a); a = MFMA16(LDSA(SM_QK, arow[tau], 1), Vb[1], a);
#pragma unroll
                    for (int r = 0; r < 4; ++r) { const int t = rowmap(tau, g, r); *(LAS unsigned short*)(sb + SM_O + t * SROW + vc * 2) = f2bf1(a[r]); } }
            }
            Sb[0] = pack_frag(S[0], S[1]); Sb[1] = pack_frag(S[2], S[3]);
#undef LDSA
            SCAN_BAR();
        }
    } else {
        const int sw_ = w - 4, stid = tid - 256;
        const int tq = 16 * sw_ + i16;
        u32x4 st[5][2]; float sgc = 0.f, sgl = 0.f;
        bf16* OD = (bf16*)(F.dout + (dir ? DO_OB : DO_OF));
        auto issue = [&](int step) {
            if (step >= NSTEP) return;
            bool lat; int chunk; step_chunk(step, dir, lat, chunk);
            const u32x4* pk = lat ? (const u32x4*)((const bf16*)(F.ws + WS_DK) + ((size_t)bh * SEQ + chunk * 64) * 64) : (const u32x4*)((const bf16*)(F.ws + WS_DKC) + ((size_t)bh * CTXL + chunk * 64) * 64);
            const u32x4* pkt = lat ? (const u32x4*)((const bf16*)(F.ws + WS_DKT) + ((size_t)bh * 128 + chunk) * 4096) : (const u32x4*)((const bf16*)(F.ws + WS_DKTC) + ((size_t)bh * 4 + chunk) * 4096);
            const u32x4* pv = lat ? (const u32x4*)((const bf16*)(F.ws + WS_DV) + ((size_t)bh * SEQ + chunk * 64) * 64) : (const u32x4*)((const bf16*)(F.ws + WS_DVC) + ((size_t)bh * CTXL + chunk * 64) * 64);
            const u32x4* pq = (const u32x4*)((const bf16*)(F.ws + WS_DQ) + ((size_t)bh * SEQ + (lat ? chunk : 0) * 64) * 64);
            const u32x4* pt = (const u32x4*)(TBg + (size_t)step * 4096);
#pragma unroll
            for (int k = 0; k < 2; ++k) { const int ci = stid + 256 * k; st[0][k] = pk[ci]; st[1][k] = pkt[ci]; st[3][k] = pv[ci]; st[4][k] = pt[ci]; st[2][k] = lat ? pq[ci] : (u32x4){0u, 0u, 0u, 0u}; }
            if (stid < 64) { sgc = GC[step * 64 + stid]; sgl = GC[step * 64 + (dir ? 0 : 63)]; }
        };
        auto commit = [&](int step) {
            if (step >= NSTEP) return;
            LAS unsigned char* sb = F.lds + (step & 1) * SM_STAGE;
#pragma unroll
            for (int k = 0; k < 2; ++k) { const int ci = stid + 256 * k; const int sdst = (ci >> 3) * SROW + (((ci & 7) ^ (4 * ((ci >> 7) & 1))) * 16);
                *(LAS u32x4*)(sb + SM_K + sdst) = st[0][k]; *(LAS u32x4*)(sb + SM_KT + sdst) = st[1][k]; *(LAS u32x4*)(sb + SM_Q + sdst) = st[2][k]; *(LAS u32x4*)(sb + SM_V + sdst) = st[3][k]; *(LAS u32x4*)(sb + SM_TB + sdst) = st[4][k]; }
            if (stid < 64) { ((LAS float*)(sb + SM_EG))[stid] = __expf(sgc); ((LAS float*)(sb + SM_ED))[stid] = __expf(sgl - sgc); ((LAS float*)(sb + SM_GR))[stid] = sgc; if (stid == 0) ((LAS float*)(sb + SM_ED))[64] = __expf(sgl); }
        };
        auto qkm = [&](int step) {
            if (step < 4) return;
            LAS unsigned char* sb = F.lds + (step & 1) * SM_STAGE;
            const LAS float* GR = (const LAS float*)(sb + SM_GR);
            const int swk = 4 * (i16 >> 3), swq = 4 * ((tq >> 4) & 1);
            const bf16x8 q0 = *(const LAS bf16x8*)(sb + SM_Q + tq * SROW + ((g ^ swq) * 16)), q1 = *(const LAS bf16x8*)(sb + SM_Q + tq * SROW + (((g + 4) ^ swq) * 16));
            const float gct = GR[tq];
#pragma unroll
            for (int kk = 0; kk < 2; ++kk) {
                f32x4 a[2];
#pragma unroll
                for (int hf = 0; hf < 2; ++hf) { const int tau = 2 * kk + hf; const int tr = 32 * (tau >> 1) + 8 * (i16 >> 2) + 4 * (tau & 1) + (i16 & 3);
                    const bf16x8 k0 = *(const LAS bf16x8*)(sb + SM_K + tr * SROW + ((g ^ swk) * 16)), k1 = *(const LAS bf16x8*)(sb + SM_K + tr * SROW + (((g + 4) ^ swk) * 16));
                    const f32x4 gk = *(const LAS f32x4*)(GR + rowmap(tau, g, 0));
                    f32x4 s = {0.f, 0.f, 0.f, 0.f}; s = MFMA16(k0, q0, s); s = MFMA16(k1, q1, s);
#pragma unroll
                    for (int r = 0; r < 4; ++r) { const int tp = rowmap(tau, g, r); const bool ok = dir ? (tq <= tp) : (tq >= tp); s[r] = ok ? s[r] * __expf(gct - gk[r]) : 0.f; }
                    a[hf] = s; }
                *(LAS bf16x8*)(sb + SM_QK + tq * SROW + (((4 * kk + g) ^ swq) * 16)) = pack_frag(a[0], a[1]);
            }
        };
        auto flush_o = [&](int step) {
            if (step < 4 || step >= NSTEP) return;
            const int chunk = dir ? 131 - step : step - 4;
            LAS unsigned char* sb = F.lds + (step & 1) * SM_STAGE;
#pragma unroll
            for (int k = 0; k < 2; ++k) { const int ci = stid + 256 * k; const int t = ci >> 3, p = ci & 7;
                *(u32x4*)(OD + ((size_t)b * SEQ + chunk * 64 + t) * 512 + h * 64 + 8 * p) = *(const LAS u32x4*)(sb + SM_O + t * SROW + p * 16); }
        };
        issue(0); commit(0); issue(1);
        SCAN_BAR();
        for (int n = 0; n < NSTEP; ++n) {
            qkm(n);
            SCAN_BAR();
            flush_o(n - 1); commit(n + 1); issue(n + 2);
            SCAN_BAR();
        }
        flush_o(NSTEP - 1);
    }
}
__device__ __forceinline__ void phase_mp(Ctx& F, const Args& A) {
    const int l = F.lane, j = l & 7;
    bf16* OF = (bf16*)(F.dout + DO_OF); const bf16* OB = (const bf16*)(F.dout + DO_OB); const bf16* ZDN = (const bf16*)(F.ws + WS_ZDN);
    float w8[8];
#pragma unroll
    for (int e = 0; e < 8; ++e) w8[e] = A.in[14][8 * j + e];
#pragma unroll 4
    for (int m = F.gw; m < ML; m += F.NGW) {
        const size_t off = (size_t)m * 512 + 8 * l; float a[8], bq[8], z[8]; unpack8(*(const u32x4*)(OF + off), a); unpack8(*(const u32x4*)(OB + off), bq); unpack8(*(const u32x4*)(ZDN + off), z);
        float ss = 0.f;
#pragma unroll
        for (int e = 0; e < 8; ++e) { a[e] += bq[e]; ss += a[e] * a[e]; }
        const float r = rsqrtf(red8(ss) * (1.f / 64.f) + EPSF);
#pragma unroll
        for (int e = 0; e < 8; ++e) a[e] = a[e] * r * w8[e] * z[e];
        *(u32x4*)(OF + off) = pack8(a);
    }
}
constexpr size_t WS_CTL = 65536, CTL_BYTES = 32768;
constexpr int LDS_MISC = 131072;
#define XB_TMO      128
#define XB_XCNT(j)  (256  + 64 * (j))
#define XB_XSUB(j)  (1280 + 64 * (j))
#define XB_XGEN(j)  (2304 + 64 * (j))
#define XB_TOP      3328
#define XB_TOPGEN   3392
#define XCD_BAR_WORDS 3456
#define XB_SPIN_CAP (1u << 18)

__device__ __forceinline__ unsigned xb_ld(unsigned* p)              { return __hip_atomic_load(p, __ATOMIC_RELAXED, __HIP_MEMORY_SCOPE_AGENT); }
__device__ __forceinline__ unsigned xb_add(unsigned* p, unsigned v) { return __hip_atomic_fetch_add(p, v, __ATOMIC_RELAXED, __HIP_MEMORY_SCOPE_AGENT); }
__device__ __forceinline__ unsigned xb_xcc_id() { return (unsigned)__builtin_amdgcn_s_getreg((3 << 11) | 20) & 0xFu; }
#define XB_SPIN(cond, bar) do { unsigned _sp = 0; while (cond) { __builtin_amdgcn_s_sleep(1); \
    if ((++_sp & 255u) == 0u) { if (xb_ld(&(bar)[XB_TMO])) break; if (_sp > XB_SPIN_CAP) { atomicAdd(&(bar)[XB_TMO], 1u); break; } } } } while (0)

struct XcdBarrier {
    unsigned G;
    unsigned* bar; unsigned x;
    volatile LAS unsigned* st;
};

__device__ __forceinline__ XcdBarrier xcd_barrier_post(unsigned* bar, volatile LAS unsigned* st, unsigned G) {
    XcdBarrier b; b.G = G; b.bar = bar; b.x = xb_xcc_id(); b.st = st;
    if (threadIdx.x == 0) (void)xb_add(&bar[XB_XCNT(b.x)], 1u);
    return b;
}
__device__ __forceinline__ void xcd_barrier_complete(unsigned* bar, unsigned x, unsigned G, unsigned& nloc, unsigned& nx) {
    unsigned sum, cnt, mine, sp = 0u;
    for (;;) {
        sum = 0u; cnt = 0u; mine = 0u;
#pragma unroll
        for (unsigned j = 0; j < 16; ++j) { const unsigned c = xb_ld(&bar[XB_XCNT(j)]); sum += c; cnt += (c > 0u) ? 1u : 0u; mine = (j == x) ? c : mine; }
        if (sum == G) break;
        __builtin_amdgcn_s_sleep(1);
        if ((++sp & 255u) == 0u) { if (xb_ld(&bar[XB_TMO])) break; if (sp > XB_SPIN_CAP) { atomicAdd(&bar[XB_TMO], 1u); break; } }
    }
    nloc = mine > 0u ? mine : 1u; nx = cnt > 0u ? cnt : 1u;
}

__device__ __forceinline__ void xcd_barrier(const XcdBarrier& b) {
    asm volatile("s_waitcnt vmcnt(0)" ::: "memory");
    __syncthreads();
    if (threadIdx.x == 0) {
        unsigned* bar = b.bar;
        __builtin_amdgcn_s_waitcnt(0);
        unsigned nloc = b.st[0], nx = b.st[1];
        if (nloc == 0u) { xcd_barrier_complete(bar, b.x, b.G, nloc, nx); b.st[0] = nloc; b.st[1] = nx; }
        const unsigned old = xb_add(&bar[XB_XSUB(b.x)], 1u);
        const unsigned gen = old / nloc;
        if (old + 1u == (gen + 1u) * nloc) {
            __builtin_amdgcn_fence(__ATOMIC_RELEASE, "agent");
            asm volatile("s_waitcnt vmcnt(0)" ::: "memory");
            const unsigned og = xb_add(&bar[XB_TOP], 1u);
            const unsigned tg = og / nx;
            if (og + 1u == (tg + 1u) * nx) xb_add(&bar[XB_TOPGEN], 1u);
            else XB_SPIN(xb_ld(&bar[XB_TOPGEN]) == tg, bar);
            __builtin_amdgcn_fence(__ATOMIC_ACQUIRE, "agent");
            xb_add(&bar[XB_XGEN(b.x)], 1u);
            asm volatile("s_waitcnt vmcnt(0)" ::: "memory");
        } else {
            XB_SPIN(xb_ld(&bar[XB_XGEN(b.x)]) == gen, bar);
            __builtin_amdgcn_fence(__ATOMIC_ACQUIRE, "agent");
            asm volatile("s_waitcnt vmcnt(0)" ::: "memory");
        }
    }
    __syncthreads();
}

struct ShadowOrder {
    int c, G;
    __device__ void init(int G_, int c_) { G = G_; c = c_; }
    __device__ bool next(int i, pg8::Unit& u) const {
        if ((G & 7) != 0) { const long L = (long)i * G + c; if (L >= 512) return false; u.pm = (int)(L >> 2); u.pn = (int)(L & 3); return true; }
        const int per = G >> 3, xcd = c & 7, j = c >> 3, w = i * per + j;
        if (w >= 64) return false;
        u.pm = 16 * xcd + (w >> 2); u.pn = w & 3; return true;
    }
    __device__ __forceinline__ void a_ready(const pg8::Unit&) const {}
    __device__ __forceinline__ void done(const pg8::Unit&) const {}
};
constexpr size_t WS_CNT_PB = 65536 + 15616, WS_CNT_PA = 65536 + 15872, WS_CNT_P4 = 65536 + 16128;
__device__ __forceinline__ void seam_arrive(unsigned char* ws, size_t word) {
    asm volatile("s_waitcnt vmcnt(0)" ::: "memory");
    __syncthreads();
    if (threadIdx.x == 0) { __builtin_amdgcn_fence(__ATOMIC_RELEASE, "agent"); asm volatile("s_waitcnt vmcnt(0)" ::: "memory");
        __hip_atomic_fetch_add((unsigned*)(ws + word), 1u, __ATOMIC_RELAXED, __HIP_MEMORY_SCOPE_AGENT); }
}
__device__ __forceinline__ void seam_wait(unsigned char* ws, size_t word, unsigned want) {
    if (threadIdx.x == 0) { unsigned sp = 0u;
        while (__hip_atomic_load((unsigned*)(ws + word), __ATOMIC_RELAXED, __HIP_MEMORY_SCOPE_AGENT) < want) { __builtin_amdgcn_s_sleep(2); if (++sp > (1u << 20)) break; }
        __builtin_amdgcn_fence(__ATOMIC_ACQUIRE, "agent"); asm volatile("s_waitcnt vmcnt(0)" ::: "memory"); }
    __syncthreads();
}
#ifdef TPROBE
#define STAMP(k) do { if (blockIdx.x == 0 && threadIdx.x == 0) ((volatile LAS unsigned long long*)(F.lds + LDS_MISC + 64))[k] = __builtin_amdgcn_s_memrealtime(); } while (0)
#else
#define STAMP(k) do {} while (0)
#endif
#define REFRESH(F) do { int t_ = threadIdx.x; asm volatile("" : "+v"(t_)); (F).tid = t_; (F).lane = t_ & 63; } while (0)
__global__ void __launch_bounds__(NTHREADS, 2) fwd_kernel(Args args) {
    extern __shared__ __attribute__((aligned(16))) unsigned char lds_raw[];
    cg::grid_group grid = cg::this_grid();
    Ctx F;
    F.lds = (LAS unsigned char*)lds_raw; F.tid = threadIdx.x; F.lane = F.tid & 63; F.wave = __builtin_amdgcn_readfirstlane(F.tid >> 6);
    F.G = gridDim.x; F.gw = blockIdx.x * NWAVES + F.wave; F.NGW = F.G * NWAVES;
    F.ws = args.ws; F.dout = (unsigned char*)args.out;
    unsigned char* ws = args.ws;
    if (F.tid < 8) ((volatile LAS unsigned*)(F.lds + LDS_MISC))[F.tid] = 0u;
    __syncthreads();
    const XcdBarrier bar = xcd_barrier_post((unsigned*)(ws + WS_CTL), (volatile LAS unsigned*)(F.lds + LDS_MISC), gridDim.x);
    XcdBarrier bar2 = bar;
    if (blockIdx.x >= 64) bar2 = xcd_barrier_post((unsigned*)(ws + WS_CTL + 16384), (volatile LAS unsigned*)(F.lds + LDS_MISC + 16), gridDim.x - 64);
    STAMP(0);

#ifndef SK0
    REFRESH(F); phase0(F, args);
#endif
    if (args.ws == nullptr) grid.sync();
    if (threadIdx.x == 0) {
        unsigned* cnt = (unsigned*)(ws + WS_MODCNT); const unsigned want = (gridDim.x < 48u) ? gridDim.x : 48u; unsigned sp = 0u;
        while (__hip_atomic_load(cnt, __ATOMIC_RELAXED, __HIP_MEMORY_SCOPE_AGENT) < want) { __builtin_amdgcn_s_sleep(2); if (++sp > (1u << 20)) break; }
        __builtin_amdgcn_fence(__ATOMIC_ACQUIRE, "agent");
        asm volatile("s_waitcnt vmcnt(0)" ::: "memory");
    }
    __syncthreads(); STAMP(1);
#ifndef SK1
    REFRESH(F); phase1(F, args);
#endif
    xcd_barrier(bar); STAMP(2);
#ifndef SK2
    {
        pg8::Gemm gm{(const pg8::bf16_t*)(ws + WS_XN), (const pg8::bf16_t*)(ws + WS_WIN), MT, NPAD, DM}; pg8::StaticOrder S; S.init(MT, NPAD, F.G, (int)blockIdx.x);
        static_assert(pg8::EPI_BA == WS_BA && pg8::EPI_ZNA == WS_ZNA && pg8::EPI_ZDN == WS_ZDN && pg8::EPI_GNA == WS_GNA && pg8::EPI_GDN == WS_GDN && pg8::EPI_NAK == WS_NAK && pg8::EPI_NAV == WS_NAV && pg8::EPI_DNQKV == WS_DNQKV && DO_Q == 0, "epilogue map");
        pg8::EpiIn E{ws, F.dout, args.in[9], args.in[10]};
        pg8::gemm_phase<pg8::EpiIn, pg8::StaticOrder, true, true>(F.lds, gm, S, E);
    }
#endif
    xcd_barrier(bar); STAMP(3);
#ifndef SK3
    REFRESH(F); phase3<2>(F, args);
    REFRESH(F); phase3<1>(F, args);
#endif
    xcd_barrier(bar); STAMP(4);
#ifndef SK4
    REFRESH(F); phase4<false>(F, args);
#endif
    seam_arrive(ws, WS_CNT_P4); STAMP(5);
    if (blockIdx.x < 64) {
        REFRESH(F); phase4<true>(F, args);
        seam_wait(ws, WS_CNT_P4, gridDim.x);
    }
    if (blockIdx.x < 64) {
#ifndef SK6
        REFRESH(F); phase_scan(F, args); STAMP(12);
#endif
    } else {
#ifndef SK5
        REFRESH(F); phase_na(F, args, (int)blockIdx.x - 64, F.G - 64);
#endif
#ifdef TPROBE
        __syncthreads(); if (blockIdx.x == 64 && threadIdx.x == 0) *(volatile unsigned long long*)(ws + WS_CTL + 14336) = __builtin_amdgcn_s_memrealtime();
#endif
        xcd_barrier(bar2);
#ifndef SK8
        {   ShadowOrder S; S.init(F.G - 64, (int)blockIdx.x - 64);
            pg8::Gemm g1{(const pg8::bf16_t*)(F.dout + DO_Q), (const pg8::bf16_t*)(ws + WS_WONA), ML, DM, 512};
            pg8::EpiGate<0> E1{(const pg8::bf16_t*)(ws + WS_GNA), nullptr, (pg8::bf16_t*)(ws + WS_T1)};
            pg8::gemm_phase<pg8::EpiGate<0>, ShadowOrder, true, false>(F.lds, g1, S, E1); }
#endif
    }
    xcd_barrier(bar); STAMP(6);
#ifndef SK7
    REFRESH(F); phase_mp(F, args);
#endif
    xcd_barrier(bar); STAMP(7);
#ifndef SK8
    {
        pg8::StaticOrder S; S.init(ML, DM, F.G, (int)blockIdx.x);
        pg8::Gemm g2{(const pg8::bf16_t*)(F.dout + DO_OF), (const pg8::bf16_t*)(ws + WS_WODN), ML, DM, 512};
        pg8::EpiGate<1> E2{(const pg8::bf16_t*)(ws + WS_GDN), (const pg8::bf16_t*)(ws + WS_T1), (pg8::bf16_t*)(ws + WS_Y)};
        pg8::gemm_phase<pg8::EpiGate<1>, pg8::StaticOrder, true, true>(F.lds, g2, S, E2);
    }
#endif
    xcd_barrier(bar); STAMP(8);
#ifndef SK9
    {
        pg8::StaticOrder S; S.init(ML, DM, F.G, (int)blockIdx.x);
        pg8::Gemm g3{(const pg8::bf16_t*)(ws + WS_Y), (const pg8::bf16_t*)(ws + WS_WOUT), ML, DM, DM};
        pg8::EpiOut E3{args.in[0], (const float*)(ws + WS_MODV), args.out};
        pg8::gemm_phase<pg8::EpiOut, pg8::StaticOrder, true, true>(F.lds, g3, S, E3);
    }
#endif
#ifdef TPROBE
    xcd_barrier(bar); STAMP(11);
    if (blockIdx.x == 0) {
        __syncthreads();
        volatile LAS unsigned long long* ts = (volatile LAS unsigned long long*)(F.lds + LDS_MISC + 64);
        if (threadIdx.x == 0) ts[13] = *(volatile unsigned long long*)(ws + WS_CTL + 14336);
        __syncthreads();
        const float dt_us = (float)(ts[TP_B] - ts[TP_A]) * 0.01f; const float dl = sqrtf(dt_us * 0.1f / 16384.f);
        for (int i = threadIdx.x; i < 16384; i += NTHREADS) args.out[(size_t)i * 2048 + 7] += dl;
    }
#endif
}

extern "C" void kernel_launch(void* const* d_in, const int* in_sizes, int n_in, void* d_out, int out_size, void* d_ws, size_t ws_size, hipStream_t stream) {
    static int grid = 0;
    if (grid == 0) {
        if (n_in != 18 || out_size != ML * DM || ws_size < WS_END) { fprintf(stderr, "kernel_launch: unexpected problem (n_in %d, out %d, ws %zu)\n", n_in, out_size, ws_size); grid = -1; return; }
        int dev = 0, cus = 0, per_cu = 0;
        hipGetDevice(&dev); hipDeviceGetAttribute(&cus, hipDeviceAttributeMultiprocessorCount, dev);
        if (hipFuncSetAttribute((const void*)fwd_kernel, hipFuncAttributeMaxDynamicSharedMemorySize, LDS_BYTES) != hipSuccess) { fprintf(stderr, "kernel_launch: hipFuncSetAttribute failed\n"); grid = -1; return; }
        hipOccupancyMaxActiveBlocksPerMultiprocessor(&per_cu, (const void*)fwd_kernel, NTHREADS, LDS_BYTES);
        if (per_cu < 1) { fprintf(stderr, "kernel_launch: occupancy query says %d blocks per CU\n", per_cu); per_cu = 1; }
        (void)hipGetLastError();
        grid = cus;
        if (grid < 64) { fprintf(stderr, "kernel_launch: needs >= 64 CUs\n"); grid = -1; return; }
    }
    if (grid < 0) return;
    if (hipMemsetAsync((char*)d_ws + WS_CTL, 0, CTL_BYTES, stream) != hipSuccess) { fprintf(stderr, "kernel_launch: memset failed\n"); return; }
    Args a{};
    for (int i = 0; i < 18; ++i) a.in[i] = (const float*)d_in[i];
    a.out = (float*)d_out; a.ws = (unsigned char*)d_ws;
    void* kargs[] = {&a};
    hipError_t e = hipLaunchCooperativeKernel((const void*)fwd_kernel, dim3(grid), dim3(NTHREADS), kargs, LDS_BYTES, stream);
    if (e != hipSuccess) fprintf(stderr, "kernel_launch: cooperative launch failed: %s (grid %d)\n", hipGetErrorString(e), grid);
}
```

```cpp
#include <hip/hip_runtime.h>
#include <hip/hip_cooperative_groups.h>
#include <cstdio>
#include <cstdint>
namespace cg = cooperative_groups;
namespace pg8 {
#define PG8_LAS __attribute__((address_space(3)))
typedef unsigned short bf16_t;
typedef short bf16x8 __attribute__((ext_vector_type(8)));
typedef float f32x4 __attribute__((ext_vector_type(4)));
typedef unsigned u32x4 __attribute__((ext_vector_type(4)));
constexpr int BM = 256, BK = 64, HALF = 128, HTB = HALF * BK * 2  , STAGE_BYTES = 8 * HTB, NXCD = 8, WGM = 8;

__host__ __device__ __forceinline__ int lds_byte(int r, int c) { const int st = (r >> 4) * 2 + (c >> 5), rr = r & 15, cc = c & 31, ob = rr * 64 + cc * 2; return st * 1024 + (ob ^ (((ob >> 9) & 1) << 5)); }
__host__ __device__ __forceinline__ void stage_rc(int b, int& R, int& C) { const int st = b / 1024, sb = b % 1024, swz = sb ^ (((sb >> 9) & 1) << 5); R = (st >> 1) * 16 + swz / 64; C = (st & 1) * 32 + (swz % 64) / 2; }
__host__ __device__ __forceinline__ int perm32(int rho) { const int n = rho >> 4, i = rho & 15; return 8 * (i >> 2) + 4 * n + (i & 3); }

struct Unit { int pm, pn; };
struct Gemm { const bf16_t* A; const bf16_t* Bt; int M, N, K; };

struct StaticOrder {
    int nM, nN, nwg, G, c;
    __host__ __device__ void init(int M, int N, int G_, int c_) { nM = M / BM; nN = N / BM; nwg = nM * nN; G = G_; c = c_; }
    __host__ __device__ bool next(int i, Unit& u) const {
        const long L = (long)i * G + c; if (L >= nwg) return false;
        int wgid = (int)L; { const int q = nwg / NXCD, r = nwg % NXCD, xcd = wgid % NXCD, off = wgid / NXCD; wgid = (xcd < r ? xcd * (q + 1) : r * (q + 1) + (xcd - r) * q) + off; }
        const int nig = WGM * nN, gid = wgid / nig, fm = gid * WGM, gsz = (nM - fm) < WGM ? (nM - fm) : WGM;
        u.pm = fm + ((wgid % nig) % gsz); u.pn = (wgid % nig) / gsz; return true;
    }
    __device__ __forceinline__ void a_ready(const Unit&) const {}
    __device__ __forceinline__ void done(const Unit&) const {}
};

__device__ __forceinline__ unsigned cvt_pk_bf16(float lo, float hi) { unsigned r; asm volatile("v_cvt_pk_bf16_f32 %0, %1, %2" : "=v"(r) : "v"(lo), "v"(hi)); return r; }
__device__ __forceinline__ float bflo(unsigned w) { return __builtin_bit_cast(float, w << 16); }
__device__ __forceinline__ float bfhi(unsigned w) { return __builtin_bit_cast(float, w & 0xffff0000u); }
__device__ __forceinline__ float sigmoidf_(float v) { return __builtin_amdgcn_rcpf(1.0f + __expf(-v)); }
constexpr size_t EPI_MiB = 1u << 20, EPI_BA = 18 * EPI_MiB, EPI_ZNA = 24 * EPI_MiB, EPI_ZDN = 56 * EPI_MiB, EPI_GNA = 88 * EPI_MiB, EPI_GDN = 152 * EPI_MiB, EPI_NAK = 216 * EPI_MiB, EPI_NAV = 249 * EPI_MiB, EPI_DNQKV = 282 * EPI_MiB;
struct EpiIn {
    static constexpr bool PERM = true, AFTER_DRAIN = false;
    unsigned char* ws; unsigned char* dout;
    const float* wq; const float* wk;
    __device__ __forceinline__ void operator()(const f32x4 (&acc)[2][2][4][2], const Unit& u, int wr, int wc, int fr, int fq) const {
        const int pn = u.pn; size_t boff; int ldc, colt, act = 0; bool latent_only = false; float* ba = (float*)(ws + EPI_BA);
        if (pn < 2) { boff = 0; ldc = 512; colt = pn * 256; latent_only = true; }
        else if (pn < 4) { boff = EPI_NAK; ldc = 512; colt = (pn - 2) * 256; }
        else if (pn < 6) { boff = EPI_NAV; ldc = 512; colt = (pn - 4) * 256; }
        else if (pn < 8) { boff = EPI_ZNA; ldc = 512; colt = (pn - 6) * 256; act = 2; latent_only = true; }
        else if (pn < 14) { boff = EPI_DNQKV; ldc = 1536; colt = (pn - 8) * 256; }
        else if (pn < 16) { boff = EPI_ZDN; ldc = 512; colt = (pn - 14) * 256; act = 2; latent_only = true; }
        else if (pn < 20) { boff = EPI_GNA; ldc = 1024; colt = (pn - 16) * 256; act = 1; latent_only = true; }
        else if (pn < 24) { boff = EPI_GDN; ldc = 1024; colt = (pn - 20) * 256; act = 1; latent_only = true; }
        else {
            if (wc == 0) {
#pragma unroll
                for (int ai = 0; ai < 2; ++ai)
#pragma unroll
                    for (int m = 0; m < 4; ++m) { float* rowp = ba + (size_t)(u.pm * BM + ai * HALF + wr * 64 + m * 16 + fr) * 32 + 8 * fq;
                        *(f32x4*)(rowp) = acc[ai][0][m][0]; *(f32x4*)(rowp + 4) = acc[ai][0][m][1]; }
            }
            return;
        }
        if (latent_only && u.pm >= 128) return;
        if (pn < 4) {
            const float* w = (pn < 2) ? wq : wk; const float qs = (pn < 2) ? 0.125f : 1.0f;
            f32x4 wv[2][2];
#pragma unroll
            for (int bj = 0; bj < 2; ++bj)
#pragma unroll
                for (int n = 0; n < 2; ++n) wv[bj][n] = *(const f32x4*)(w + 32 * bj + 8 * fq + 4 * n) * qs;
            bf16_t* hb = ((pn < 2) ? (bf16_t*)dout : (bf16_t*)(ws + EPI_NAK)) + (size_t)(u.pm * BM + wr * 64 + fr) * 512 + (4 * (pn & 1) + wc) * 64 + 8 * fq;
#pragma unroll
            for (int ai = 0; ai < 2; ++ai)
#pragma unroll
                for (int m = 0; m < 4; ++m) {
                    float ss = 0.f;
#pragma unroll
                    for (int bj = 0; bj < 2; ++bj)
#pragma unroll
                        for (int n = 0; n < 2; ++n) { const f32x4 v = acc[ai][bj][m][n]; ss += (v[0] * v[0] + v[1] * v[1]) + (v[2] * v[2] + v[3] * v[3]); }
                    ss += __shfl_xor(ss, 16); ss += __shfl_xor(ss, 32);
                    const float r = __builtin_amdgcn_rsqf(ss * (1.0f / 64.0f) + 1e-6f);
                    bf16_t* rowp = hb + (size_t)(ai * HALF + m * 16) * 512;
#pragma unroll
                    for (int bj = 0; bj < 2; ++bj) { const f32x4 v0 = acc[ai][bj][m][0] * r * wv[bj][0], v1 = acc[ai][bj][m][1] * r * wv[bj][1];
                        u32x4 o; o.x = cvt_pk_bf16(v0[0], v0[1]); o.y = cvt_pk_bf16(v0[2], v0[3]); o.z = cvt_pk_bf16(v1[0], v1[1]); o.w = cvt_pk_bf16(v1[2], v1[3]);
                        *(u32x4*)(rowp + 32 * bj) = o; }
                }
            return;
        }
        bf16_t* base = (pn < 2) ? (bf16_t*)dout : (bf16_t*)(ws + boff);
        const int row0 = u.pm * BM + wr * 64 + fr, col0 = colt + wc * 32 + 8 * fq;
#pragma unroll
        for (int ai = 0; ai < 2; ++ai)
#pragma unroll
            for (int m = 0; m < 4; ++m) { bf16_t* rowp = base + (size_t)(row0 + ai * HALF + m * 16) * ldc + col0;
#pragma unroll
                for (int bj = 0; bj < 2; ++bj) { f32x4 v0 = acc[ai][bj][m][0], v1 = acc[ai][bj][m][1];
                    if (act != 0) {
#pragma unroll
                        for (int e = 0; e < 4; ++e) { const float s0 = sigmoidf_(v0[e]), s1 = sigmoidf_(v1[e]); v0[e] = (act == 1) ? s0 : v0[e] * s0; v1[e] = (act == 1) ? s1 : v1[e] * s1; }
                    }
                    u32x4 w; w.x = cvt_pk_bf16(v0[0], v0[1]); w.y = cvt_pk_bf16(v0[2], v0[3]); w.z = cvt_pk_bf16(v1[0], v1[1]); w.w = cvt_pk_bf16(v1[2], v1[3]);
                    *(u32x4*)(rowp + bj * HALF) = w; } }
    }
};
template <int MODE> struct EpiGate {
    static constexpr bool PERM = true, AFTER_DRAIN = false;
    const bf16_t* G; const bf16_t* T1; bf16_t* O;
    __device__ __forceinline__ void operator()(const f32x4 (&acc)[2][2][4][2], const Unit& u, int wr, int wc, int fr, int fq) const {
        const int row0 = u.pm * BM + wr * 64 + fr, col0 = u.pn * BM + wc * 32 + 8 * fq;
#pragma unroll
        for (int ai = 0; ai < 2; ++ai)
#pragma unroll
            for (int m = 0; m < 4; ++m) { const size_t off = (size_t)(row0 + ai * HALF + m * 16) * 1024 + col0;
#pragma unroll
                for (int bj = 0; bj < 2; ++bj) { const f32x4 v0 = acc[ai][bj][m][0], v1 = acc[ai][bj][m][1];
                    const u32x4 g = *(const u32x4*)(G + off + bj * HALF);
                    float o[8] = { v0[0] * bflo(g.x), v0[1] * bfhi(g.x), v0[2] * bflo(g.y), v0[3] * bfhi(g.y), v1[0] * bflo(g.z), v1[1] * bfhi(g.z), v1[2] * bflo(g.w), v1[3] * bfhi(g.w) };
                    if (MODE == 1) { const u32x4 t = *(const u32x4*)(T1 + off + bj * HALF);
                        o[0] += bflo(t.x); o[1] += bfhi(t.x); o[2] += bflo(t.y); o[3] += bfhi(t.y); o[4] += bflo(t.z); o[5] += bfhi(t.z); o[6] += bflo(t.w); o[7] += bfhi(t.w); }
                    u32x4 w; w.x = cvt_pk_bf16(o[0], o[1]); w.y = cvt_pk_bf16(o[2], o[3]); w.z = cvt_pk_bf16(o[4], o[5]); w.w = cvt_pk_bf16(o[6], o[7]);
                    *(u32x4*)(O + off + bj * HALF) = w; } }
    }
};
struct EpiOut {
    static constexpr bool PERM = true, AFTER_DRAIN = false;
    const float* x; const float* modv; float* out;
    __device__ __forceinline__ void operator()(const f32x4 (&acc)[2][2][4][2], const Unit& u, int wr, int wc, int fr, int fq) const {
        const int row0 = u.pm * BM + wr * 64 + fr, col0 = u.pn * BM + wc * 32 + 8 * fq;
        const float* gp = modv + (size_t)(u.pm / 32) * 3072 + 2048 + col0;
        f32x4 gv[2][2];
#pragma unroll
        for (int bj = 0; bj < 2; ++bj)
#pragma unroll
            for (int n = 0; n < 2; ++n) gv[bj][n] = *(const f32x4*)(gp + bj * HALF + 4 * n);
#pragma unroll
        for (int ai = 0; ai < 2; ++ai)
#pragma unroll
            for (int m = 0; m < 4; ++m) { const size_t off = (size_t)(row0 + ai * HALF + m * 16) * 1024 + col0;
#pragma unroll
                for (int bj = 0; bj < 2; ++bj)
#pragma unroll
                    for (int n = 0; n < 2; ++n) { const f32x4 xv = *(const f32x4*)(x + off + bj * HALF + 4 * n);
                        *(f32x4*)(out + off + bj * HALF + 4 * n) = xv + gv[bj][n] * acc[ai][bj][m][n]; } }
    }
};
template <class Epi, class Sched, bool ALIGN_EPI = false, bool SP2 = false>
__device__ __forceinline__ void gemm_phase(PG8_LAS unsigned char* lds, const Gemm g, const Sched& S, const Epi& E) {
    int tid_ = threadIdx.x; asm volatile("" : "+v"(tid_));
    const int tid = tid_, wid = __builtin_amdgcn_readfirstlane(tid >> 6), lane = tid & 63, wr = wid >> 2, wc = wid & 3, fr = lane & 15, fq = lane >> 4;
    const int K = g.K, nt = K / BK;
    unsigned voffA[2], voffB[2];
#pragma unroll
    for (int i = 0; i < 2; ++i) { int R, C; stage_rc(tid * 16 + i * 8192, R, C); const int Rb = Epi::PERM ? ((R & ~31) + perm32(R & 31)) : R;
        voffA[i] = (unsigned)(R * K + C) * 2u; voffB[i] = (unsigned)(Rb * K + C) * 2u; }
    const size_t kstep = (size_t)(BK * 2);
    const size_t hstep = (size_t)HALF * K * 2;
    const size_t tstep = 2 * hstep;
    const unsigned ldsw = (unsigned)wid * 1024u;
    const int aoff = lds_byte(wr * 64 + fr, fq * 8), boff = lds_byte(wc * 32 + fr, fq * 8);
#define PG8_SA(b, h) (((b) * 2 + (h)) * HTB)
#define PG8_SB(b, h) ((4 + (b) * 2 + (h)) * HTB)
#define PG8_STAGE(bufoff, gbase, voff) do { _Pragma("unroll") for (int _i = 0; _i < 2; ++_i) \
        __builtin_amdgcn_global_load_lds((const unsigned*)((const char*)(gbase) + (voff)[_i]), (PG8_LAS unsigned*)(lds + (bufoff) + ldsw + _i * 8192), 16, 0, 0); } while (0)
#define PG8_LDA(dst, b, h) do { _Pragma("unroll") for (int m = 0; m < 4; ++m) _Pragma("unroll") for (int k = 0; k < 2; ++k) dst[m][k] = *(const PG8_LAS bf16x8*)(lds + PG8_SA(b, h) + aoff + m * 2048 + k * 1024); } while (0)
#define PG8_LDB(dst, b, h) do { _Pragma("unroll") for (int n = 0; n < 2; ++n) _Pragma("unroll") for (int k = 0; k < 2; ++k) dst[n][k] = *(const PG8_LAS bf16x8*)(lds + PG8_SB(b, h) + boff + n * 2048 + k * 1024); } while (0)
#define PG8_MMA(ai, bj, At, Bt) do { __builtin_amdgcn_s_setprio(1); _Pragma("unroll") for (int m = 0; m < 4; ++m) _Pragma("unroll") for (int n = 0; n < 2; ++n) _Pragma("unroll") for (int k = 0; k < 2; ++k) \
        acc[ai][bj][m][n] = __builtin_amdgcn_mfma_f32_16x16x32_bf16(Bt[n][k], At[m][k], acc[ai][bj][m][n], 0, 0, 0); __builtin_amdgcn_s_setprio(0); } while (0)
#define PG8_WAIT_V(n) asm volatile("s_waitcnt vmcnt(" #n ")" ::: "memory")
#define PG8_WAIT_L(n) asm volatile("s_waitcnt lgkmcnt(" #n ")" ::: "memory")
#define PG8_BAR __builtin_amdgcn_s_barrier()
#define PG8_SCHED __builtin_amdgcn_sched_barrier(0)
    Unit cur, nxt; int ui = 0;
    if (!S.next(0, cur)) return;
    f32x4 acc[2][2][4][2];
#pragma unroll
    for (int a = 0; a < 2; ++a)
#pragma unroll
        for (int b = 0; b < 2; ++b)
#pragma unroll
            for (int m = 0; m < 4; ++m)
#pragma unroll
                for (int n = 0; n < 2; ++n) acc[a][b][m][n] = (f32x4){0.f, 0.f, 0.f, 0.f};
    bf16x8 At[4][2], B0[2][2], B1[2][2];
    const char* cA = (const char*)g.A + (size_t)cur.pm * tstep; const char* cB = (const char*)g.Bt + (size_t)cur.pn * tstep;
    S.a_ready(cur);
    if constexpr (SP2) {
        PG8_STAGE(PG8_SB(0, 0), cB, voffB); PG8_STAGE(PG8_SB(0, 1), cB + hstep, voffB); PG8_STAGE(PG8_SA(0, 0), cA, voffA); PG8_STAGE(PG8_SA(0, 1), cA + hstep, voffA);
        if (wr == 1) PG8_BAR;
        PG8_WAIT_V(2); PG8_BAR;
        PG8_STAGE(PG8_SB(1, 0), cB + kstep, voffB); PG8_STAGE(PG8_SA(1, 0), cA + kstep, voffA); PG8_STAGE(PG8_SB(1, 1), cB + hstep + kstep, voffB);
        PG8_WAIT_V(6); PG8_BAR;
    } else {
        PG8_STAGE(PG8_SB(0, 0), cB, voffB); PG8_STAGE(PG8_SA(0, 0), cA, voffA); PG8_STAGE(PG8_SB(0, 1), cB + hstep, voffB); PG8_STAGE(PG8_SA(0, 1), cA + hstep, voffA);
        if (wr == 1) PG8_BAR;
        PG8_WAIT_V(4); PG8_BAR;
        PG8_STAGE(PG8_SB(1, 0), cB + kstep, voffB); PG8_STAGE(PG8_SA(1, 0), cA + kstep, voffA); PG8_STAGE(PG8_SB(1, 1), cB + hstep + kstep, voffB);
        PG8_WAIT_V(6); PG8_BAR;
    }
    for (;;) {
        const bool has_next = S.next(ui + 1, nxt);
        const char* nA = has_next ? (const char*)g.A + (size_t)nxt.pm * tstep : cA; const char* nB = has_next ? (const char*)g.Bt + (size_t)nxt.pn * tstep : cB;
        for (int t = 0; t < nt; t += 2) {
            const bool last = (t == nt - 2);
            const char* a1 = cA + (size_t)(t + 1) * kstep;
            const char* a2 = last ? nA : cA + (size_t)(t + 2) * kstep; const char* b2 = last ? nB : cB + (size_t)(t + 2) * kstep;
            const char* a3 = a2 + kstep; const char* b3 = b2 + kstep;
            if (last && has_next) S.a_ready(nxt);
            if constexpr (SP2) {
            PG8_LDB(B0, 0, 0); PG8_LDB(B1, 0, 1); PG8_SCHED; PG8_LDA(At, 0, 0); PG8_STAGE(PG8_SA(1, 1), a1 + hstep, voffA);
            PG8_WAIT_V(8); PG8_WAIT_L(0); PG8_BAR; PG8_MMA(0, 0, At, B0); PG8_MMA(0, 1, At, B1); PG8_BAR; PG8_SCHED;
            PG8_LDA(At, 0, 1); PG8_STAGE(PG8_SB(0, 0), b2, voffB); PG8_STAGE(PG8_SB(0, 1), b2 + hstep, voffB); PG8_STAGE(PG8_SA(0, 0), a2, voffA);
            PG8_WAIT_V(8); PG8_WAIT_L(0); PG8_BAR; PG8_MMA(1, 0, At, B0); PG8_MMA(1, 1, At, B1); PG8_BAR; PG8_SCHED;
            PG8_LDB(B0, 1, 0); PG8_LDB(B1, 1, 1); PG8_SCHED; PG8_LDA(At, 1, 0); PG8_STAGE(PG8_SA(0, 1), a2 + hstep, voffA);
            PG8_WAIT_V(8); PG8_WAIT_L(0); PG8_BAR; PG8_MMA(0, 0, At, B0); PG8_MMA(0, 1, At, B1); PG8_BAR; PG8_SCHED;
            PG8_LDA(At, 1, 1); PG8_STAGE(PG8_SB(1, 0), b3, voffB); PG8_STAGE(PG8_SB(1, 1), b3 + hstep, voffB); PG8_STAGE(PG8_SA(1, 0), a3, voffA);
            PG8_WAIT_V(8); PG8_WAIT_L(0); PG8_BAR; PG8_MMA(1, 0, At, B0); PG8_MMA(1, 1, At, B1); PG8_BAR; PG8_SCHED;
            } else {
            PG8_LDB(B0, 0, 0); PG8_SCHED; PG8_LDA(At, 0, 0); PG8_STAGE(PG8_SA(1, 1), a1 + hstep, voffA);
            PG8_WAIT_L(8); PG8_BAR; PG8_WAIT_L(0); PG8_MMA(0, 0, At, B0); PG8_BAR; PG8_SCHED;
            PG8_LDB(B1, 0, 1); PG8_STAGE(PG8_SB(0, 0), b2, voffB);
            PG8_BAR; PG8_WAIT_L(0); PG8_MMA(0, 1, At, B1); PG8_BAR;
            PG8_LDA(At, 0, 1); PG8_STAGE(PG8_SA(0, 0), a2, voffA);
            PG8_BAR; PG8_WAIT_L(0); PG8_MMA(1, 0, At, B0); PG8_BAR; PG8_SCHED;
            PG8_STAGE(PG8_SB(0, 1), b2 + hstep, voffB);
            PG8_WAIT_V(6); PG8_BAR; PG8_MMA(1, 1, At, B1); PG8_BAR;
            PG8_LDB(B0, 1, 0); PG8_SCHED; PG8_LDA(At, 1, 0); PG8_STAGE(PG8_SA(0, 1), a2 + hstep, voffA);
            PG8_WAIT_L(8); PG8_BAR; PG8_WAIT_L(0); PG8_MMA(0, 0, At, B0); PG8_BAR; PG8_SCHED;
            PG8_LDB(B1, 1, 1); PG8_STAGE(PG8_SB(1, 0), b3, voffB);
            PG8_BAR; PG8_WAIT_L(0); PG8_MMA(0, 1, At, B1); PG8_BAR;
            PG8_LDA(At, 1, 1); PG8_STAGE(PG8_SA(1, 0), a3, voffA);
            PG8_BAR; PG8_WAIT_L(0); PG8_MMA(1, 0, At, B0); PG8_BAR; PG8_SCHED;
            PG8_STAGE(PG8_SB(1, 1), b3 + hstep, voffB);
            PG8_WAIT_V(6); PG8_BAR; PG8_MMA(1, 1, At, B1); PG8_BAR;
            }
        }
        if constexpr (ALIGN_EPI) { if (wr == 0) PG8_BAR; }
        if constexpr (!Epi::AFTER_DRAIN) { E(acc, cur, wr, wc, fr, fq); S.done(cur); }
        if (!has_next) break;
#pragma unroll
        for (int a = 0; a < 2; ++a)
#pragma unroll
            for (int b = 0; b < 2; ++b)
#pragma unroll
                for (int m = 0; m < 4; ++m)
#pragma unroll
                    for (int n = 0; n < 2; ++n) acc[a][b][m][n] = (f32x4){0.f, 0.f, 0.f, 0.f};
        cur = nxt; cA = nA; cB = nB; ++ui;
        if constexpr (ALIGN_EPI) { if (wr == 1) PG8_BAR; }
    }
    PG8_WAIT_V(0);
    if constexpr (!ALIGN_EPI) { if (wr == 0) PG8_BAR; }
    PG8_BAR;
    if constexpr (Epi::AFTER_DRAIN) { E.fused(acc, cur, wr, wc, fr, fq, lds, wid, lane); S.done(cur); }
#undef PG8_SA
#undef PG8_SB
#undef PG8_STAGE
#undef PG8_LDA
#undef PG8_LDB
#undef PG8_MMA
#undef PG8_WAIT_V
#undef PG8_WAIT_L
#undef PG8_BAR
#undef PG8_SCHED
}
}
constexpr int DM = 1024, NB = 4, SEQ = 8192, CTXL = 256, NH = 8;
constexpr int ML = NB * SEQ, MC = NB * CTXL, MT = ML + MC;
constexpr int NPROJ = 6176, NPAD = 6400;
constexpr int NSTEP = 132;
constexpr float EPSF = 1e-6f;
constexpr int NWAVES = 8, NTHREADS = 512;
constexpr int LDS_BYTES = 135168;
constexpr size_t MiB = 1u << 20;
constexpr size_t WS_MODCNT = 65536 + 15360;
constexpr size_t WS_MODV = 4096;
constexpr size_t WS_WIN = 1 * MiB;
constexpr size_t WS_WONA = 14 * MiB, WS_WODN = 15 * MiB, WS_WOUT = 16 * MiB;
constexpr size_t WS_BA = 18 * MiB;
constexpr size_t WS_VT8C = 22 * MiB + 512 * 1024;
constexpr size_t WS_ZNA = 24 * MiB, WS_ZDN = 56 * MiB, WS_GNA = 88 * MiB, WS_GDN = 152 * MiB;
constexpr size_t WS_NAK = 216 * MiB, WS_NAV = 249 * MiB, WS_DNQKV = 282 * MiB;
constexpr size_t WS_TB = 282 * MiB, WS_GC = 354 * MiB;
constexpr size_t WS_XN = 381 * MiB;
constexpr size_t WS_DQ = 381 * MiB, WS_DK = 413 * MiB, WS_DKT = 445 * MiB, WS_DV = 477 * MiB;
constexpr size_t WS_DKC = 509 * MiB, WS_DKTC = 510 * MiB, WS_DVC = 511 * MiB;
constexpr size_t WS_T1 = 216 * MiB + 1 * MiB + 69632;
constexpr size_t WS_Y = 445 * MiB;
constexpr size_t WS_END = 512 * MiB;
constexpr size_t DO_Q = 0, DO_VT8 = 32 * MiB, DO_OF = 64 * MiB, DO_OB = 96 * MiB;

#define LAS __attribute__((address_space(3)))
typedef unsigned short bf16;
typedef unsigned u32x4 __attribute__((ext_vector_type(4)));
typedef unsigned u32x2 __attribute__((ext_vector_type(2)));
typedef float f32x4 __attribute__((ext_vector_type(4)));
typedef short bf16x8 __attribute__((ext_vector_type(8)));
#define LDS_WAIT() asm volatile("s_waitcnt lgkmcnt(0)" ::: "memory")
__device__ __forceinline__ unsigned f2bf(float f) { unsigned u = __builtin_bit_cast(unsigned, f); return (u + 0x7fffu + ((u >> 16) & 1u)) >> 16; }
typedef float f32x2_t __attribute__((ext_vector_type(2))); typedef __bf16 bf16x2_t __attribute__((ext_vector_type(2)));
__device__ __forceinline__ unsigned pk2(float lo, float hi) { f32x2_t v = {lo, hi}; bf16x2_t b = __builtin_convertvector(v, bf16x2_t); return __builtin_bit_cast(unsigned, b); }
__device__ __forceinline__ unsigned short f2bf1(float f) { return (unsigned short)(pk2(f, f) & 0xffffu); }
__device__ __forceinline__ float blo(unsigned w) { return __builtin_bit_cast(float, w << 16); }
__device__ __forceinline__ float bhi(unsigned w) { return __builtin_bit_cast(float, w & 0xffff0000u); }
__device__ __forceinline__ float bf1(unsigned short h) { return __builtin_bit_cast(float, ((unsigned)h) << 16); }
__device__ __forceinline__ void unpack8(const u32x4 v, float (&f)[8]) { f[0] = blo(v.x); f[1] = bhi(v.x); f[2] = blo(v.y); f[3] = bhi(v.y); f[4] = blo(v.z); f[5] = bhi(v.z); f[6] = blo(v.w); f[7] = bhi(v.w); }
__device__ __forceinline__ u32x4 pack8(const float (&f)[8]) { u32x4 w; w.x = pk2(f[0], f[1]); w.y = pk2(f[2], f[3]); w.z = pk2(f[4], f[5]); w.w = pk2(f[6], f[7]); return w; }
__device__ __forceinline__ bf16x8 pack_frag(const f32x4 a, const f32x4 b) { u32x4 w; w.x = pk2(a[0], a[1]); w.y = pk2(a[2], a[3]); w.z = pk2(b[0], b[1]); w.w = pk2(b[2], b[3]); return __builtin_bit_cast(bf16x8, w); }
__device__ __forceinline__ float sigm(float v) { return __builtin_amdgcn_rcpf(1.0f + __expf(-v)); }
#define MFMA16(a, b, c) __builtin_amdgcn_mfma_f32_16x16x32_bf16((a), (b), (c), 0, 0, 0)
__device__ __forceinline__ void tr8x8(const u32x4 (&in)[8], u32x4 (&out)[8]) {
#pragma unroll
    for (int e = 0; e < 8; ++e) {
        unsigned w[4];
#pragma unroll
        for (int p = 0; p < 4; ++p) { const unsigned a = in[2 * p][e >> 1], b = in[2 * p + 1][e >> 1];
            w[p] = (e & 1) ? ((a >> 16) | (b & 0xffff0000u)) : ((a & 0xffffu) | (b << 16)); }
        out[e] = (u32x4){w[0], w[1], w[2], w[3]};
    }
}

struct Args { const float* in[18]; float* out; unsigned char* ws; };

struct Ctx {
    LAS unsigned char* lds; int tid, lane, wave, G, gw, NGW;
    unsigned char* ws; unsigned char* dout;
};

__device__ __forceinline__ void p0_transpose_item(const float* W, int K, int N, bf16* WT, int k0, int n0, int dst_row, LAS float* scr, int lane) {
#pragma unroll 8
    for (int i = 0; i < 32; ++i) { const int kk = 2 * i + (lane >> 5); scr[kk * 33 + (lane & 31)] = W[(size_t)(k0 + kk) * N + n0 + (lane & 31)]; }
    LDS_WAIT();
    const int c = lane & 7;
#pragma unroll
    for (int j = 0; j < 4; ++j) { const int n = (lane >> 3) + 8 * j; const LAS float* s = scr + (8 * c) * 33 + n;
        u32x4 o; o.x = pk2(s[0 * 33], s[1 * 33]); o.y = pk2(s[2 * 33], s[3 * 33]); o.z = pk2(s[4 * 33], s[5 * 33]); o.w = pk2(s[6 * 33], s[7 * 33]);
        *(u32x4*)(WT + (size_t)(dst_row + n) * K + k0 + 8 * c) = o; }
    LDS_WAIT();
}
__device__ __forceinline__ void phase0(Ctx& F, const Args& A) {
    if (blockIdx.x < 48) {
        LAS float* sc = (LAS float*)F.lds;
        LAS float* red = (LAS float*)(F.lds + 20480);
        for (int i = F.tid; i < 5 * 1024; i += NTHREADS) { const int v = i >> 10, k = i & 1023; const float cv = (v < 4) ? A.in[1][v * 1024 + k] : A.in[3][k]; sc[i] = cv * sigm(cv); }
        __syncthreads();
        const int n0 = blockIdx.x * 64, kc = F.tid >> 4, c4 = F.tid & 15;
        float acc[5][4];
#pragma unroll
        for (int v = 0; v < 5; ++v)
#pragma unroll
            for (int e = 0; e < 4; ++e) acc[v][e] = 0.f;
#pragma unroll 16
        for (int i = 0; i < 32; ++i) { const int k = kc * 32 + i; const f32x4 w = *(const f32x4*)(A.in[4] + (size_t)k * 3072 + n0 + 4 * c4);
#pragma unroll
            for (int v = 0; v < 5; ++v) { const float s = sc[v * 1024 + k]; acc[v][0] += s * w[0]; acc[v][1] += s * w[1]; acc[v][2] += s * w[2]; acc[v][3] += s * w[3]; } }
#pragma unroll
        for (int v = 0; v < 5; ++v)
#pragma unroll
            for (int e = 0; e < 4; ++e) red[(kc * 5 + v) * 64 + 4 * c4 + e] = acc[v][e];
        __syncthreads();
        if (F.tid < 320) { const int v = F.tid >> 6, col = F.tid & 63; float s = A.in[5][n0 + col];
            for (int k = 0; k < 32; ++k) s += red[(k * 5 + v) * 64 + col];
            ((float*)(F.ws + WS_MODV))[v * 3072 + n0 + col] = s; __threadfence(); }
        __syncthreads();
        if (F.tid == 0) __hip_atomic_fetch_add((unsigned*)(F.ws + WS_MODCNT), 1u, __ATOMIC_RELAXED, __HIP_MEMORY_SCOPE_AGENT);
    }
    { u32x4* z = (u32x4*)(F.ws + WS_WIN + (size_t)NPROJ * 1024 * 2); const int n16 = (NPAD - NPROJ) * 1024 * 2 / 16;
      for (int i = blockIdx.x * NTHREADS + F.tid; i < n16; i += F.G * NTHREADS) z[i] = (u32x4){0u, 0u, 0u, 0u}; }
    LAS float* scr = (LAS float*)(F.lds + F.wave * 16384);
    constexpr int I_IN = 16 * 193, I_ONA = 8 * 32, I_ODN = 8 * 32, I_OUT = 16 * 32;
    if (blockIdx.x >= 48 || F.G <= 48)
    for (int it = (F.G > 48 ? F.gw - 48 * NWAVES : F.gw); it < I_IN + I_ONA + I_ODN + I_OUT; it += (F.G > 48 ? F.NGW - 48 * NWAVES : F.NGW)) {
        int r = it;
        if (r < I_IN) { const int kb = r / 193, nb = r % 193, c0 = 32 * nb; const int dst = (c0 < 1024) ? ((c0 & ~255) + 128 * ((c0 >> 5) & 1) + 32 * ((c0 >> 6) & 3))
                              : ((c0 < 4096) ? c0 : ((c0 < 4128) ? 6144 + (c0 - 4096) : c0 - 32));
            p0_transpose_item(A.in[7], 1024, NPROJ, (bf16*)(F.ws + WS_WIN), 64 * kb, c0, dst, scr, F.lane); continue; }
        r -= I_IN;
        if (r < I_ONA) { p0_transpose_item(A.in[15], 512, 1024, (bf16*)(F.ws + WS_WONA), 64 * (r / 32), 32 * (r % 32), 32 * (r % 32), scr, F.lane); continue; }
        r -= I_ONA;
        if (r < I_ODN) { p0_transpose_item(A.in[16], 512, 1024, (bf16*)(F.ws + WS_WODN), 64 * (r / 32), 32 * (r % 32), 32 * (r % 32), scr, F.lane); continue; }
        r -= I_ODN;
        p0_transpose_item(A.in[17], 1024, 1024, (bf16*)(F.ws + WS_WOUT), 64 * (r / 32), 32 * (r % 32), 32 * (r % 32), scr, F.lane);
    }
}
__device__ __forceinline__ float wave_sum(float v) {
#pragma unroll
    for (int o = 1; o < 64; o <<= 1) v += __shfl_xor(v, o);
    return v;
}
__device__ __forceinline__ void phase1(Ctx& F, const Args& A) {
    const float* modv = (const float*)(F.ws + WS_MODV); bf16* XN = (bf16*)(F.ws + WS_XN);
    for (int ch = F.gw; ch < ML / 16 + MC; ch += F.NGW) {
        const bool isctx = ch >= ML / 16;
        const int row0 = isctx ? ML + (ch - ML / 16) : ch * 16; const int nrow = isctx ? 1 : 16; const int b = isctx ? 4 : row0 / SEQ;
        f32x4 mul[4], add[4];
#pragma unroll
        for (int j = 0; j < 4; ++j) { const int col = 4 * F.lane + 256 * j; const f32x4 nw = *(const f32x4*)(A.in[6] + col), sc = *(const f32x4*)(modv + b * 3072 + 1024 + col);
            mul[j] = nw * (sc + 1.0f); add[j] = *(const f32x4*)(modv + b * 3072 + col); }
#pragma unroll 4
        for (int rr = 0; rr < nrow; ++rr) {
            const int row = row0 + rr; const float* src = (row < ML) ? A.in[0] + (size_t)row * DM : A.in[2] + (size_t)(row - ML) * DM;
            f32x4 v[4]; float s = 0.f;
#pragma unroll
            for (int j = 0; j < 4; ++j) { v[j] = *(const f32x4*)(src + 4 * F.lane + 256 * j); s += (v[j][0] * v[j][0] + v[j][1] * v[j][1]) + (v[j][2] * v[j][2] + v[j][3] * v[j][3]); }
            const float r = rsqrtf(wave_sum(s) * (1.f / DM) + EPSF);
#pragma unroll
            for (int j = 0; j < 4; ++j) { const f32x4 o = v[j] * r * mul[j] + add[j];
                *(u32x2*)(XN + (size_t)row * DM + 4 * F.lane + 256 * j) = (u32x2){pk2(o[0], o[1]), pk2(o[2], o[3])}; }
        }
    }
}
__device__ __forceinline__ float red8(float v) { v += __shfl_xor(v, 1); v += __shfl_xor(v, 2); v += __shfl_xor(v, 4); return v; }
__device__ __forceinline__ void item_pos(int it, bool& lat, int& m0, int& b, int& t0, int& Tseq) {
    lat = it < ML / 8;
    if (lat) { m0 = it * 8; b = m0 / SEQ; t0 = m0 % SEQ; Tseq = SEQ; } else { const int ci = it - ML / 8; m0 = ML + ci * 8; b = ci / 32; t0 = (ci % 32) * 8; Tseq = CTXL; }
}
template <int PASS> __device__ __forceinline__ void phase3(Ctx& F, const Args& A) {
    const int l = F.lane, h = l >> 3, j = l & 7;
    if (PASS == 1) {
        const bf16* NAV = (const bf16*)(F.ws + WS_NAV);
        for (int it = F.gw; it < MT / 8; it += F.NGW) {
            bool lat; int m0, b, t0, Tseq; item_pos(it, lat, m0, b, t0, Tseq);
            const int bh = b * 8 + h;
            { u32x4 vin[8], vout[8];
#pragma unroll
              for (int t = 0; t < 8; ++t) vin[t] = *(const u32x4*)(NAV + (size_t)(m0 + t) * 512 + 8 * l);
              tr8x8(vin, vout);
              u32x4* dst = lat ? (u32x4*)(F.dout + DO_VT8) + ((size_t)bh * (SEQ / 8) + t0 / 8) * 64 + 8 * j : (u32x4*)(F.ws + WS_VT8C) + ((size_t)bh * (CTXL / 8) + t0 / 8) * 64 + 8 * j;
#pragma unroll
              for (int e = 0; e < 8; ++e) dst[e] = vout[e]; }
        }
    }
    if (PASS == 2) {
        const bf16* DNQKV = (const bf16*)(F.ws + WS_DNQKV);
        LAS float* rt = (LAS float*)F.lds;
        for (int idx = F.tid; idx < 128 * 16; idx += NTHREADS) { const float ang = (float)(idx >> 4) * exp2f(-(float)(idx & 15) * (13.287712379549449f / 16.0f));
            rt[2 * idx] = __cosf(ang); rt[2 * idx + 1] = __sinf(ang); }
        __syncthreads();
        for (int s_ = F.gw; s_ < 3 * (ML / 8) + 128 + 3 * (MC / 8); s_ += F.NGW) {
            if (s_ >= 3 * (ML / 8) && s_ < 3 * (ML / 8) + 128) continue;
            const int it2 = (s_ < 3 * (ML / 8)) ? s_ : s_ - 128;
            const int seg = it2 % 3, it = it2 / 3;
            bool lat; int m0, b, t0, Tseq; item_pos(it, lat, m0, b, t0, Tseq);
            if (seg == 0 && !lat) continue;
            const int bh = b * 8 + h;
            float cw[3][8];
#pragma unroll
            for (int tp = 0; tp < 3; ++tp) { const f32x4 a = *(const f32x4*)(A.in[8] + tp * 1536 + seg * 512 + 8 * l), bq = *(const f32x4*)(A.in[8] + tp * 1536 + seg * 512 + 8 * l + 4);
                cw[tp][0] = a[0]; cw[tp][1] = a[1]; cw[tp][2] = a[2]; cw[tp][3] = a[3]; cw[tp][4] = bq[0]; cw[tp][5] = bq[1]; cw[tp][6] = bq[2]; cw[tp][7] = bq[3]; }
            bf16* dst; if (seg == 0) dst = (bf16*)(F.ws + WS_DQ); else if (seg == 1) dst = lat ? (bf16*)(F.ws + WS_DK) : (bf16*)(F.ws + WS_DKC); else dst = lat ? (bf16*)(F.ws + WS_DV) : (bf16*)(F.ws + WS_DVC);
            const bf16* src = DNQKV + (size_t)m0 * 1536 + seg * 512 + 8 * l;
            u32x4 raw[10], res[8];
#pragma unroll
            for (int t = 0; t < 10; ++t) { const int tt = t0 - 1 + t; raw[t] = (tt >= 0 && tt < Tseq) ? *(const u32x4*)(src + (ptrdiff_t)(t - 1) * 1536) : (u32x4){0u, 0u, 0u, 0u}; }
#pragma unroll
            for (int t = 0; t < 8; ++t) {
                const u32x4 r0 = raw[t], r1 = raw[t + 1], r2 = raw[t + 2];
                float a[8], bq[8], cq[8], y[8]; unpack8(r0, a); unpack8(r1, bq); unpack8(r2, cq);
#pragma unroll
                for (int e = 0; e < 8; ++e) { const float s = cw[0][e] * a[e] + cw[1][e] * bq[e] + cw[2][e] * cq[e]; y[e] = s * sigm(s); }
                if (seg < 2) {
                    float ss = 0.f;
#pragma unroll
                    for (int e = 0; e < 8; ++e) ss += y[e] * y[e];
                    const float r = rsqrtf(red8(ss) + EPSF);
#pragma unroll
                    for (int e = 0; e < 8; ++e) y[e] *= r;
                    if (lat) {
                        const int tok = t0 + t; const int pos = (j < 4) ? (tok >> 6) : (tok & 63);
                        f32x4 rtv[4];
#pragma unroll
                        for (int q4 = 0; q4 < 4; ++q4) rtv[q4] = *(const LAS f32x4*)(rt + (pos * 16 + 8 * (j & 1)) * 2 + 4 * q4);
#pragma unroll
                        for (int e = 0; e < 8; ++e) { const float cs = rtv[e >> 1][2 * (e & 1)], sn = rtv[e >> 1][2 * (e & 1) + 1]; const float pr = __shfl_xor(y[e], 2);
                            y[e] = (j & 2) ? (y[e] * cs + pr * sn) : (y[e] * cs - pr * sn); }
                    }
                    if (seg == 0) {
#pragma unroll
                        for (int e = 0; e < 8; ++e) y[e] *= 0.125f;
                    }
                }
                res[t] = pack8(y);
                *(u32x4*)(dst + ((size_t)bh * Tseq + t0 + t) * 64 + 8 * j) = res[t];
            }
            if (seg == 1) {
                u32x4 kt[8];
                tr8x8(res, kt);
                bf16* kd = lat ? (bf16*)(F.ws + WS_DKT) : (bf16*)(F.ws + WS_DKTC);
#pragma unroll
                for (int e = 0; e < 8; ++e) *(u32x4*)(kd + (((size_t)bh * (Tseq / 64) + t0 / 64) * 64 + 8 * j + e) * 64 + (t0 & 63)) = kt[e];
            }
        }
    }
}
__device__ __forceinline__ void step_chunk(int step, int dir, bool& lat, int& chunk) { if (step < 4) { lat = false; chunk = dir ? 3 - step : step; } else { lat = true; chunk = dir ? 131 - step : step - 4; } }
__host__ __device__ constexpr int tri_off(int i) { return i == 0 ? 0 : (8 * ((i - 1) >> 2) * (((i - 1) >> 2) + 1) + (i - 1 - 4 * ((i - 1) >> 2)) * 4 * (((i - 1) >> 2) + 1)); }
__host__ __device__ constexpr int tri_len(int i) { return i == 0 ? 0 : 4 * (((i - 1) >> 2) + 1); }
constexpr int TRI_FLOATS = 2176;
typedef float f32x2 __attribute__((ext_vector_type(2)));
template <int I> struct SubstRow {
    static __device__ __forceinline__ void run(f32x2 (&t2)[32], const LAS float* L, float lanef) {
        SubstRow<I - 1>::run(t2, L, lanef);
        f32x2 a0 = {0.f, 0.f}, a1 = {0.f, 0.f};
#pragma unroll
        for (int q = 0; q < tri_len(I) / 4; ++q) { const f32x4 lv = *(const LAS f32x4*)(L + tri_off(I) + 4 * q);
            a0 += (f32x2){lv[0], lv[1]} * t2[2 * q]; a1 += (f32x2){lv[2], lv[3]} * t2[2 * q + 1]; }
        const float s = fmaxf(0.f, 1.f - fabsf(lanef - (float)I)) - ((a0[0] + a0[1]) + (a1[0] + a1[1]));
        if (I & 1) t2[I >> 1][1] = s; else t2[I >> 1][0] = s;
        if ((I & 3) == 3) asm volatile("" ::: "memory");
    }
};
template <> struct SubstRow<-1> { static __device__ __forceinline__ void run(f32x2 (&)[32], const LAS float*, float) {} };
template <int I> struct SubstHalf {
    static __device__ __forceinline__ void run(f32x2 (&t2)[16], const LAS float* L, int hb, float ccf) {
        SubstHalf<I - 1>::run(t2, L, hb, ccf);
        f32x2 a0 = {0.f, 0.f}, a1 = {0.f, 0.f};
        const LAS float* row = L + (hb ? (tri_off(32 + I) + 32) : tri_off(I));
#pragma unroll
        for (int q = 0; q < tri_len(I) / 4; ++q) { const f32x4 lv = *(const LAS f32x4*)(row + 4 * q);
            a0 += (f32x2){lv[0], lv[1]} * t2[2 * q]; a1 += (f32x2){lv[2], lv[3]} * t2[2 * q + 1]; }
        const float s = fmaxf(0.f, 1.f - fabsf(ccf - (float)I)) - ((a0[0] + a0[1]) + (a1[0] + a1[1]));
        if (I & 1) t2[I >> 1][1] = s; else t2[I >> 1][0] = s;
        if ((I & 3) == 3) asm volatile("" ::: "memory");
    }
};
template <> struct SubstHalf<-1> { static __device__ __forceinline__ void run(f32x2 (&)[16], const LAS float*, int, float) {} };
constexpr int P4_WAVE_LDS = 16384, P4_T11 = 8704, P4_T22 = 8704 + 2048;

template <bool CTX> __device__ __forceinline__ void phase4(Ctx& F, const Args& A) {
    LAS float* Lt = (LAS float*)(F.lds + F.wave * P4_WAVE_LDS);
    LAS unsigned char* Wb = F.lds + F.wave * P4_WAVE_LDS;
    const float* BA = (const float*)(F.ws + WS_BA);
    for (int jt_ = CTX ? F.wave : F.gw; jt_ < (CTX ? 4 : 64 * 128); jt_ += (CTX ? 4 : F.NGW)) {
        const int id = CTX ? (int)blockIdx.x * NSTEP + jt_ : (jt_ >> 7) * NSTEP + 4 + (jt_ & 127);
        int l = F.lane; asm volatile("" : "+v"(l));
        const int g = l >> 4, i16 = l & 15;
        const int step = id % NSTEP, sd = id / NSTEP, dir = sd & 1, bh = sd >> 1, b = bh >> 3, h = bh & 7;
        bool lat; int chunk; step_chunk(step, dir, lat, chunk);
        const int tl = dir ? 63 - l : l;
        const int m = lat ? b * SEQ + chunk * 64 + tl : ML + b * CTXL + chunk * 64 + tl;
        const float braw = BA[(size_t)m * 32 + dir * 8 + h], araw = BA[(size_t)m * 32 + 16 + dir * 8 + h];
        const float beta = sigm(braw);
        const float xs = araw + A.in[13][dir * 8 + h];
        const float sp = (xs > 15.f) ? xs : log1pf(expf(xs));
        float gc = -expf(A.in[12][dir * 8 + h]) * sp;
#pragma unroll
        for (int o = 1; o < 64; o <<= 1) { const float v = __shfl_up(gc, o); if (l >= o) gc += v; }
        ((float*)(F.ws + WS_GC))[(size_t)id * 64 + tl] = gc;
        const bf16* Kt = lat ? (const bf16*)(F.ws + WS_DK) + ((size_t)bh * SEQ + chunk * 64) * 64 : (const bf16*)(F.ws + WS_DKC) + ((size_t)bh * CTXL + chunk * 64) * 64;
        bf16x8 Kf[4][2];
#pragma unroll
        for (int it = 0; it < 4; ++it)
#pragma unroll
            for (int kk = 0; kk < 2; ++kk) { const int li = 16 * it + i16; const int tk = dir ? 63 - li : li; Kf[it][kk] = *(const bf16x8*)(Kt + tk * 64 + 8 * g + 32 * kk); }
#pragma unroll
        for (int it = 0; it < 4; ++it) {
            float gci[4], bti[4];
#pragma unroll
            for (int r = 0; r < 4; ++r) { gci[r] = __shfl(gc, 16 * it + 4 * g + r); bti[r] = __shfl(beta, 16 * it + 4 * g + r); }
#pragma unroll
            for (int jt = 0; jt <= it; ++jt) {
                f32x4 a = {0.f, 0.f, 0.f, 0.f};
                a = MFMA16(Kf[it][0], Kf[jt][0], a); a = MFMA16(Kf[it][1], Kf[jt][1], a);
                const int jj = 16 * jt + i16; const float gcj = __shfl(gc, jj);
#pragma unroll
                for (int r = 0; r < 4; ++r) { const int ii = 16 * it + 4 * g + r; const int q = (ii - 1) >> 2; const int len = (ii == 0) ? 0 : 4 * (q + 1);
                    const int off = (ii == 0) ? 0 : (8 * q * (q + 1) + (ii - 1 - 4 * q) * 4 * (q + 1));
                    if (jj < len) Lt[off + jj] = (jj < ii) ? bti[r] * a[r] * __expf(gci[r] - gcj) : 0.f; }
            }
        }
        LDS_WAIT();
        const int hb = l >> 5, cc = l & 31;
        f32x2 t2[16];
#pragma unroll
        for (int q = 0; q < 16; ++q) t2[q] = (f32x2){0.f, 0.f};
        SubstHalf<31>::run(t2, Lt, hb, (float)cc);
        asm volatile("" ::: "memory");
        if (hb == 0) {
#pragma unroll
            for (int q = 0; q < 4; ++q) *(LAS u32x4*)(Wb + P4_T11 + cc * 64 + 16 * q) = (u32x4){pk2(t2[4 * q][0], t2[4 * q][1]), pk2(t2[4 * q + 1][0], t2[4 * q + 1][1]), pk2(t2[4 * q + 2][0], t2[4 * q + 2][1]), pk2(t2[4 * q + 3][0], t2[4 * q + 3][1])};
        } else {
#pragma unroll
            for (int i = 0; i < 32; ++i) *(LAS unsigned short*)(Wb + P4_T22 + (i * 32 + cc) * 2) = f2bf1(t2[i >> 1][i & 1]);
        }
        LDS_WAIT();
        f32x4 T21[2][2];
        {
            bf16x8 Af[2], Bf[2], A2[2];
#pragma unroll
            for (int mt = 0; mt < 2; ++mt) { const int ii = 32 + 16 * mt + i16; const int q = (ii - 1) >> 2; const int off = 8 * q * (q + 1) + (ii - 1 - 4 * q) * 4 * (q + 1);
                Af[mt] = pack_frag(*(const LAS f32x4*)(Lt + off + 8 * g), *(const LAS f32x4*)(Lt + off + 8 * g + 4));
                const u32x2 lo = *(const LAS u32x2*)(Wb + P4_T22 + ((16 * mt + i16) * 32 + 4 * g) * 2), hi = *(const LAS u32x2*)(Wb + P4_T22 + ((16 * mt + i16) * 32 + 16 + 4 * g) * 2);
                A2[mt] = __builtin_bit_cast(bf16x8, (u32x4){lo.x, lo.y, hi.x, hi.y}); }
#pragma unroll
            for (int nt = 0; nt < 2; ++nt) Bf[nt] = *(const LAS bf16x8*)(Wb + P4_T11 + (16 * nt + i16) * 64 + g * 16);
#pragma unroll
            for (int nt = 0; nt < 2; ++nt) {
                f32x4 x0 = {0.f, 0.f, 0.f, 0.f}, x1 = {0.f, 0.f, 0.f, 0.f};
                x0 = MFMA16(Af[0], Bf[nt], x0); x1 = MFMA16(Af[1], Bf[nt], x1);
                const bf16x8 xb = pack_frag(x0, x1);
                f32x4 z0 = {0.f, 0.f, 0.f, 0.f}, z1 = {0.f, 0.f, 0.f, 0.f};
                T21[0][nt] = MFMA16(A2[0], xb, z0); T21[1][nt] = MFMA16(A2[1], xb, z1);
            }
        }
        LDS_WAIT();
        LAS unsigned short* Tt = (LAS unsigned short*)Wb;
#pragma unroll
        for (int i = 0; i < 32; ++i) { const int ii = 32 * hb + i; const int ti = dir ? 63 - ii : ii; Tt[ti * 64 + tl] = f2bf1(t2[i >> 1][i & 1] * beta); }
        if (hb) {
#pragma unroll
            for (int i = 0; i < 32; ++i) { const int ti = dir ? 63 - i : i; Tt[ti * 64 + tl] = (unsigned short)0; }
        }
#pragma unroll
        for (int nt = 0; nt < 2; ++nt) { const int jj = 16 * nt + i16; const float bj = __shfl(beta, jj); const int tj = dir ? 63 - jj : jj;
#pragma unroll
            for (int mt = 0; mt < 2; ++mt)
#pragma unroll
                for (int r = 0; r < 4; ++r) { const int ii = 32 + 16 * mt + 4 * g + r; const int ti = dir ? 63 - ii : ii; Tt[ti * 64 + tj] = f2bf1(-T21[mt][nt][r] * bj); } }
        LDS_WAIT();
        u32x4* TBg = (u32x4*)((bf16*)(F.ws + WS_TB) + (size_t)id * 4096);
#pragma unroll
        for (int k = 0; k < 8; ++k) TBg[l + 64 * k] = *(const LAS u32x4*)(Wb + (l + 64 * k) * 16);
        LDS_WAIT();
    }
    if (CTX) asm volatile("s_waitcnt vmcnt(0)" ::: "memory");
}
constexpr int NA_KC = 16384, NA_VC = 53248;
__device__ __forceinline__ void phase_na(Ctx& F, const Args& A, int nb, int nblk) {
    const int l = F.lane, g = l >> 4, i16 = l & 15;
    LAS float* rp = (LAS float*)F.lds;
    for (int i = F.tid; i < 8 * 465; i += NTHREADS) rp[i] = A.in[11][i];
    float mq = fabsf(A.in[9][l]), mk = fabsf(A.in[10][l]), mr = 0.f;
    for (int i = l; i < 8 * 465; i += 64) mr = fmaxf(mr, fabsf(A.in[11][i]));
#pragma unroll
    for (int o = 1; o < 64; o <<= 1) { mq = fmaxf(mq, __shfl_xor(mq, o)); mk = fmaxf(mk, __shfl_xor(mk, o)); mr = fmaxf(mr, __shfl_xor(mr, o)); }
    const float mb = 8.0f * mq * mk + mr;
    __syncthreads();
    bf16* Q = (bf16*)(F.dout + DO_Q); const bf16* Kn = (const bf16*)(F.ws + WS_NAK); const bf16* ZNA = (const bf16*)(F.ws + WS_ZNA);
    const u32x4* VTL = (const u32x4*)(F.dout + DO_VT8); const u32x4* VTC = (const u32x4*)(F.ws + WS_VT8C);
    const int key0 = 8 * (i16 >> 2) + (i16 & 3);
    const int swc = 4 * (i16 >> 3);
    int cur_bh = -1;
    for (int grp = nb * 1024 / nblk; grp < (nb + 1) * 1024 / nblk; ++grp) {
        const int task = grp * 8 + F.wave;
        const int jq = task & 3, rp2 = (task >> 2) & 63, bh = task >> 8, b = bh >> 3, h = bh & 7;
        if (bh != cur_bh) {
            __syncthreads();
#pragma unroll
            for (int k = 0; k < 4; ++k) { const int ci = F.tid + 512 * k; const int key = ci >> 3, p = ci & 7;
                *(LAS u32x4*)(F.lds + NA_KC + key * 144 + ((p ^ (4 * ((key >> 4) & 1))) * 16)) = *(const u32x4*)(Kn + ((size_t)ML + b * CTXL + key) * 512 + h * 64 + 8 * p);
                *(LAS u32x4*)(F.lds + NA_VC + ci * 16) = VTC[(size_t)bh * (CTXL / 8) * 64 + ci]; }
            __syncthreads();
            cur_bh = bh;
        }
        const int q0 = 16 * jq, kc0 = (jq == 0) ? 0 : ((jq == 1) ? 8 : ((jq == 2) ? 24 : 32));
        const int ra = 2 * rp2, rb = ra + 1;
        const int r0a = min(max(ra - 4, 0), 120), r0b = min(max(rb - 4, 0), 120);
        const size_t mrow_a = (size_t)b * SEQ + ra * 64 + q0 + i16, mrow_b = mrow_a + 64;
        bf16x8 Qa[2], Qb[2];
#pragma unroll
        for (int kk = 0; kk < 2; ++kk) { Qa[kk] = *(const bf16x8*)(Q + mrow_a * 512 + h * 64 + 8 * g + 32 * kk); Qb[kk] = *(const bf16x8*)(Q + mrow_b * 512 + h * 64 + 8 * g + 32 * kk); }
        const int cq = q0 + i16, c0 = min(max(cq - 8, 0), 48);
        f32x4 Oa[4], Ob[4]; float lsa = 0.f, lsb = 0.f;
#pragma unroll
        for (int dt = 0; dt < 4; ++dt) { Oa[dt] = (f32x4){0.f, 0.f, 0.f, 0.f}; Ob[dt] = (f32x4){0.f, 0.f, 0.f, 0.f}; }
        const LAS float* rph = rp + h * 465;
        bool ok0[4], ok1[4]; int dx0[4], dx1[4];
#pragma unroll
        for (int rr = 0; rr < 4; ++rr) { const int ck0 = kc0 + 8 * g + rr, ck1 = ck0 + 4; ok0[rr] = (ck0 >= c0 && ck0 < c0 + 16); ok1[rr] = (ck1 >= c0 && ck1 < c0 + 16);
            dx0[rr] = min(max(ck0 - cq, -15), 15) + 15; dx1[rr] = min(max(ck1 - cq, -15), 15) + 15; }
#pragma unroll 3
        for (int y = 0; y < 9; ++y) {
            const int trow = r0a + y;
            if (trow >= r0b + 8) break;
            const size_t tk0 = (size_t)b * SEQ + trow * 64 + kc0;
            const bf16* kp = Kn + (tk0 + key0) * 512 + h * 64 + 8 * g;
            const bf16x8 ka0 = *(const bf16x8*)(kp), ka1 = *(const bf16x8*)(kp + 32), kb0 = *(const bf16x8*)(kp + 4 * 512), kb1 = *(const bf16x8*)(kp + 4 * 512 + 32);
            const u32x4* vp = VTL + ((size_t)bh * (SEQ / 8) + (trow * 64 + kc0) / 8 + g) * 64 + i16;
            bf16x8 vf[4];
#pragma unroll
            for (int dt = 0; dt < 4; ++dt) vf[dt] = __builtin_bit_cast(bf16x8, vp[16 * dt]);
            if (trow < r0a + 8) {
                f32x4 s0 = {0.f, 0.f, 0.f, 0.f}, s1 = {0.f, 0.f, 0.f, 0.f};
                s0 = MFMA16(ka0, Qa[0], s0); s0 = MFMA16(ka1, Qa[1], s0); s1 = MFMA16(kb0, Qa[0], s1); s1 = MFMA16(kb1, Qa[1], s1);
                const LAS float* rrow = rph + (trow - ra + 7) * 31;
#pragma unroll
                for (int rr = 0; rr < 4; ++rr) { const float p0 = ok0[rr] ? __expf(s0[rr] + rrow[dx0[rr]] - mb) : 0.f, p1 = ok1[rr] ? __expf(s1[rr] + rrow[dx1[rr]] - mb) : 0.f; s0[rr] = p0; s1[rr] = p1; lsa += p0 + p1; }
                const bf16x8 pf = pack_frag(s0, s1);
#pragma unroll
                for (int dt = 0; dt < 4; ++dt) Oa[dt] = MFMA16(vf[dt], pf, Oa[dt]);
            }
            if (trow >= r0b) {
                f32x4 s0 = {0.f, 0.f, 0.f, 0.f}, s1 = {0.f, 0.f, 0.f, 0.f};
                s0 = MFMA16(ka0, Qb[0], s0); s0 = MFMA16(ka1, Qb[1], s0); s1 = MFMA16(kb0, Qb[0], s1); s1 = MFMA16(kb1, Qb[1], s1);
                const LAS float* rrow = rph + (trow - rb + 7) * 31;
#pragma unroll
                for (int rr = 0; rr < 4; ++rr) { const float p0 = ok0[rr] ? __expf(s0[rr] + rrow[dx0[rr]] - mb) : 0.f, p1 = ok1[rr] ? __expf(s1[rr] + rrow[dx1[rr]] - mb) : 0.f; s0[rr] = p0; s1[rr] = p1; lsb += p0 + p1; }
                const bf16x8 pf = pack_frag(s0, s1);
#pragma unroll
                for (int dt = 0; dt < 4; ++dt) Ob[dt] = MFMA16(vf[dt], pf, Ob[dt]);
            }
        }
#pragma unroll 2
        for (int cb = 0; cb < 8; ++cb) {
            const LAS unsigned char* kp = F.lds + NA_KC + (cb * 32 + key0) * 144;
            const bf16x8 ka0 = *(const LAS bf16x8*)(kp + ((g ^ swc) * 16)), ka1 = *(const LAS bf16x8*)(kp + (((g + 4) ^ swc) * 16)), kb0 = *(const LAS bf16x8*)(kp + 4 * 144 + ((g ^ swc) * 16)), kb1 = *(const LAS bf16x8*)(kp + 4 * 144 + (((g + 4) ^ swc) * 16));
            bf16x8 vf[4];
#pragma unroll
            for (int dt = 0; dt < 4; ++dt) vf[dt] = *(const LAS bf16x8*)(F.lds + NA_VC + ((cb * 4 + g) * 64 + 16 * dt + i16) * 16);
            {   f32x4 s0 = {0.f, 0.f, 0.f, 0.f}, s1 = {0.f, 0.f, 0.f, 0.f};
                s0 = MFMA16(ka0, Qa[0], s0); s0 = MFMA16(ka1, Qa[1], s0); s1 = MFMA16(kb0, Qa[0], s1); s1 = MFMA16(kb1, Qa[1], s1);
#pragma unroll
                for (int rr = 0; rr < 4; ++rr) { const float p0 = __expf(s0[rr] - mb), p1 = __expf(s1[rr] - mb); s0[rr] = p0; s1[rr] = p1; lsa += p0 + p1; }
                const bf16x8 pf = pack_frag(s0, s1);
#pragma unroll
                for (int dt = 0; dt < 4; ++dt) Oa[dt] = MFMA16(vf[dt], pf, Oa[dt]); }
            {   f32x4 s0 = {0.f, 0.f, 0.f, 0.f}, s1 = {0.f, 0.f, 0.f, 0.f};
                s0 = MFMA16(ka0, Qb[0], s0); s0 = MFMA16(ka1, Qb[1], s0); s1 = MFMA16(kb0, Qb[0], s1); s1 = MFMA16(kb1, Qb[1], s1);
#pragma unroll
                for (int rr = 0; rr < 4; ++rr) { const float p0 = __expf(s0[rr] - mb), p1 = __expf(s1[rr] - mb); s0[rr] = p0; s1[rr] = p1; lsb += p0 + p1; }
                const bf16x8 pf = pack_frag(s0, s1);
#pragma unroll
                for (int dt = 0; dt < 4; ++dt) Ob[dt] = MFMA16(vf[dt], pf, Ob[dt]); }
        }
        lsa += __shfl_xor(lsa, 16); lsa += __shfl_xor(lsa, 32); lsb += __shfl_xor(lsb, 16); lsb += __shfl_xor(lsb, 32);
        const float inva = 1.0f / lsa, invb = 1.0f / lsb;
#pragma unroll
        for (int dt = 0; dt < 4; ++dt) {
            const size_t offa = mrow_a * 512 + h * 64 + 16 * dt + 4 * g, offb = mrow_b * 512 + h * 64 + 16 * dt + 4 * g; const u32x2 za = *(const u32x2*)(ZNA + offa), zb = *(const u32x2*)(ZNA + offb);
            *(u32x2*)(Q + offa) = (u32x2){pk2(Oa[dt][0] * inva * blo(za.x), Oa[dt][1] * inva * bhi(za.x)), pk2(Oa[dt][2] * inva * blo(za.y), Oa[dt][3] * inva * bhi(za.y))};
            *(u32x2*)(Q + offb) = (u32x2){pk2(Ob[dt][0] * invb * blo(zb.x), Ob[dt][1] * invb * bhi(zb.x)), pk2(Ob[dt][2] * invb * blo(zb.y), Ob[dt][3] * invb * bhi(zb.y))}; }
    }
}
constexpr int TOUCH_AHEAD = 1000;
constexpr int SROW = 144;
constexpr int SM_K = 0, SM_KT = 9216, SM_Q = 18432, SM_V = 27648, SM_TB = 36864, SM_QK = 46080, SM_EG = 55296, SM_ED = 55552, SM_GR = 55872, SM_O = 56320, SM_STAGE = 65536;
__device__ __forceinline__ int rowmap(int tau, int g, int r) { return 32 * (tau >> 1) + 8 * g + 4 * (tau & 1) + r; }
#ifdef BAR2X
#define SCAN_BAR() do { asm volatile("s_waitcnt lgkmcnt(0)" ::: "memory"); __builtin_amdgcn_s_barrier(); asm volatile("" ::: "memory"); __builtin_amdgcn_s_barrier(); asm volatile("" ::: "memory"); __builtin_amdgcn_s_barrier(); asm volatile("" ::: "memory"); } while (0)
#else
#define SCAN_BAR() do { asm volatile("s_waitcnt lgkmcnt(0)" ::: "memory"); __builtin_amdgcn_s_barrier(); asm volatile("" ::: "memory"); } while (0)
#endif
__device__ __forceinline__ void phase_scan(Ctx& F, const Args& A) {
    const int l = F.lane, g = l >> 4, i16 = l & 15, w = F.wave, tid = F.tid;
    const int sd = blockIdx.x, dir = sd & 1, bh = sd >> 1, b = bh >> 3, h = bh & 7;
    const float* GC = (const float*)(F.ws + WS_GC) + (size_t)sd * NSTEP * 64;
    const bf16* TBg = (const bf16*)(F.ws + WS_TB) + (size_t)sd * NSTEP * 4096;
    if (w < 4) {
        bf16* OD = (bf16*)(F.dout + (dir ? DO_OB : DO_OF));
        f32x4 S[4]; bf16x8 Sb[2];
#pragma unroll
        for (int t = 0; t < 4; ++t) S[t] = (f32x4){0.f, 0.f, 0.f, 0.f};
        Sb[0] = (bf16x8){0, 0, 0, 0, 0, 0, 0, 0}; Sb[1] = Sb[0];
        const int vc = 16 * w + i16;
        const int sw = 4 * (i16 >> 3), swv = 4 * (g >> 1);
        int arow[4];
#pragma unroll
        for (int tau = 0; tau < 4; ++tau) arow[tau] = 32 * (tau >> 1) + 8 * (i16 >> 2) + 4 * (tau & 1) + (i16 & 3);
        SCAN_BAR();
        for (int step = 0; step < NSTEP; ++step) {
            LAS unsigned char* sb = F.lds + (step & 1) * SM_STAGE;
            bool lat; int chunk; step_chunk(step, dir, lat, chunk);
            {
                const int ts = step + TOUCH_AHEAD;
                if (ts < NSTEP) {
                    bool tlat; int tch; step_chunk(ts, dir, tlat, tch);
                    const char* p0; const char* p1;
                    if (w == 0) { p0 = tlat ? (const char*)((const bf16*)(F.ws + WS_DK) + ((size_t)bh * SEQ + tch * 64) * 64) : (const char*)((const bf16*)(F.ws + WS_DKC) + ((size_t)bh * CTXL + tch * 64) * 64);
                                  p1 = tlat ? (const char*)((const bf16*)(F.ws + WS_DKT) + ((size_t)bh * 128 + tch) * 4096) : (const char*)((const bf16*)(F.ws + WS_DKTC) + ((size_t)bh * 4 + tch) * 4096); }
                    else if (w == 1) { p0 = tlat ? (const char*)((const bf16*)(F.ws + WS_DV) + ((size_t)bh * SEQ + tch * 64) * 64) : (const char*)((const bf16*)(F.ws + WS_DVC) + ((size_t)bh * CTXL + tch * 64) * 64);
                                       p1 = (const char*)((const bf16*)(F.ws + WS_DQ) + ((size_t)bh * SEQ + (tlat ? tch : 0) * 64) * 64); }
                    else { p0 = (const char*)(TBg + (size_t)ts * 4096); p1 = (const char*)(GC + ts * 64) - (size_t)(l >= 2 ? (l - 1) * 128 : 0); }
                    if (w < 3) { const char* q0 = p0 + l * 128; const char* q1 = p1 + l * 128;
                        asm volatile("global_load_dword v250, %0, off\n\tglobal_load_dword v251, %1, off" :: "v"(q0), "v"(q1) : "v250", "v251", "memory"); }
                }
            }
            const LAS float* EG = (const LAS float*)(sb + SM_EG); const LAS float* ED = (const LAS float*)(sb + SM_ED);
            const float gtot = ED[64];
            f32x4 X[4], VN[4], eg[4], ed[4];
#pragma unroll
            for (int tau = 0; tau < 4; ++tau) { eg[tau] = *(const LAS f32x4*)(EG + rowmap(tau, g, 0)); ed[tau] = *(const LAS f32x4*)(ED + rowmap(tau, g, 0)); }
#define LDSA(mat, row, kk) (*(const LAS bf16x8*)(sb + (mat) + (row) * SROW + (((g + 4 * (kk)) ^ sw) * 16)))
#pragma unroll
            for (int tau = 0; tau < 4; ++tau) { f32x4 a = {0.f, 0.f, 0.f, 0.f}; a = MFMA16(LDSA(SM_K, arow[tau], 0), Sb[0], a); a = MFMA16(LDSA(SM_K, arow[tau], 1), Sb[1], a);
#pragma unroll
                for (int r = 0; r < 4; ++r) { const int t = rowmap(tau, g, r); const float v = bf1(*(const LAS unsigned short*)(sb + SM_V + t * SROW + (((vc >> 3) ^ swv) * 16) + (vc & 7) * 2)); a[r] = v - eg[tau][r] * a[r]; }
                X[tau] = a; }
            bf16x8 Rb[2]; Rb[0] = pack_frag(X[0], X[1]); Rb[1] = pack_frag(X[2], X[3]);
#ifdef CHAIN2X
            { f32x4 D[4];
#pragma unroll
              for (int rep = 0; rep < 3; ++rep) {
#pragma unroll
                for (int tau = 0; tau < 4; ++tau) { f32x4 a = {0.f, 0.f, 0.f, 0.f}; a = MFMA16(LDSA(SM_K, arow[tau], 0), rep ? pack_frag(D[0], D[1]) : Sb[0], a); a = MFMA16(LDSA(SM_K, arow[tau], 1), Sb[1], a); D[tau] = a; }
              }
              asm volatile("" :: "v"(D[0]), "v"(D[1]), "v"(D[2]), "v"(D[3])); }
#endif
#pragma unroll
            for (int tau = 0; tau < 4; ++tau) { f32x4 a = {0.f, 0.f, 0.f, 0.f}; a = MFMA16(LDSA(SM_TB, arow[tau], 0), Rb[0], a); a = MFMA16(LDSA(SM_TB, arow[tau], 1), Rb[1], a); VN[tau] = a; }
            bf16x8 Vb[2], Vs[2]; Vb[0] = pack_frag(VN[0], VN[1]); Vb[1] = pack_frag(VN[2], VN[3]);
            Vs[0] = pack_frag(VN[0] * ed[0], VN[1] * ed[1]); Vs[1] = pack_frag(VN[2] * ed[2], VN[3] * ed[3]);
#pragma unroll
            for (int tau = 0; tau < 4; ++tau) { f32x4 a = S[tau] * gtot; a = MFMA16(LDSA(SM_KT, arow[tau], 0), Vs[0], a); a = MFMA16(LDSA(SM_KT, arow[tau], 1), Vs[1], a); S[tau] = a; }
            SCAN_BAR();
            if (lat) {
#pragma unroll
                for (int tau = 0; tau < 4; ++tau) { f32x4 a = {0.f, 0.f, 0.f, 0.f}; a = MFMA16(LDSA(SM_Q, arow[tau], 0), Sb[0], a); a = MFMA16(LDSA(SM_Q, arow[tau], 1), Sb[1], a);
                    a = a * eg[tau]; a = MFMA16(LDSA(SM_QK, arow[tau], 0), Vb[0], a); a = MFMA16(LDSA(SM_QK, arow[tau], 1), Vb[1], a);
#pragma unroll
                    for (int r = 0; r < 4; ++r) { const int t = rowmap(tau, g, r); *(LAS unsigned short*)(sb + SM_O + t * SROW + vc * 2) = f2bf1(a[r]); } }
            }
            Sb[0] = pack_frag(S[0], S[1]); Sb[1] = pack_frag(S[2], S[3]);
#undef LDSA
            SCAN_BAR();
        }
    } else {
        const int sw_ = w - 4, stid = tid - 256;
        const int tq = 16 * sw_ + i16;
        u32x4 st[5][2]; float sgc = 0.f, sgl = 0.f;
        bf16* OD = (bf16*)(F.dout + (dir ? DO_OB : DO_OF));
        auto issue = [&](int step) {
            if (step >= NSTEP) return;
            bool lat; int chunk; step_chunk(step, dir, lat, chunk);
            const u32x4* pk = lat ? (const u32x4*)((const bf16*)(F.ws + WS_DK) + ((size_t)bh * SEQ + chunk * 64) * 64) : (const u32x4*)((const bf16*)(F.ws + WS_DKC) + ((size_t)bh * CTXL + chunk * 64) * 64);
            const u32x4* pkt = lat ? (const u32x4*)((const bf16*)(F.ws + WS_DKT) + ((size_t)bh * 128 + chunk) * 4096) : (const u32x4*)((const bf16*)(F.ws + WS_DKTC) + ((size_t)bh * 4 + chunk) * 4096);
            const u32x4* pv = lat ? (const u32x4*)((const bf16*)(F.ws + WS_DV) + ((size_t)bh * SEQ + chunk * 64) * 64) : (const u32x4*)((const bf16*)(F.ws + WS_DVC) + ((size_t)bh * CTXL + chunk * 64) * 64);
            const u32x4* pq = (const u32x4*)((const bf16*)(F.ws + WS_DQ) + ((size_t)bh * SEQ + (lat ? chunk : 0) * 64) * 64);
            const u32x4* pt = (const u32x4*)(TBg + (size_t)step * 4096);
#pragma unroll
            for (int k = 0; k < 2; ++k) { const int ci = stid + 256 * k; st[0][k] = pk[ci]; st[1][k] = pkt[ci]; st[3][k] = pv[ci]; st[4][k] = pt[ci]; st[2][k] = lat ? pq[ci] : (u32x4){0u, 0u, 0u, 0u}; }
            if (stid < 64) { sgc = GC[step * 64 + stid]; sgl = GC[step * 64 + (dir ? 0 : 63)]; }
        };
        auto commit = [&](int step) {
            if (step >= NSTEP) return;
            LAS unsigned char* sb = F.lds + (step & 1) * SM_STAGE;
#pragma unroll
            for (int k = 0; k < 2; ++k) { const int ci = stid + 256 * k; const int sdst = (ci >> 3) * SROW + (((ci & 7) ^ (4 * ((ci >> 7) & 1))) * 16);
                *(LAS u32x4*)(sb + SM_K + sdst) = st[0][k]; *(LAS u32x4*)(sb + SM_KT + sdst) = st[1][k]; *(LAS u32x4*)(sb + SM_Q + sdst) = st[2][k]; *(LAS u32x4*)(sb + SM_V + sdst) = st[3][k]; *(LAS u32x4*)(sb + SM_TB + sdst) = st[4][k]; }
            if (stid < 64) { ((LAS float*)(sb + SM_EG))[stid] = __expf(sgc); ((LAS float*)(sb + SM_ED))[stid] = __expf(sgl - sgc); ((LAS float*)(sb + SM_GR))[stid] = sgc; if (stid == 0) ((LAS float*)(sb + SM_ED))[64] = __expf(sgl); }
        };
        auto qkm = [&](int step) {
            if (step < 4) return;
            LAS unsigned char* sb = F.lds + (step & 1) * SM_STAGE;
            const LAS float* GR = (const LAS float*)(sb + SM_GR);
            const int swk = 4 * (i16 >> 3), swq = 4 * ((tq >> 4) & 1);
            const bf16x8 q0 = *(const LAS bf16x8*)(sb + SM_Q + tq * SROW + ((g ^ swq) * 16)), q1 = *(const LAS bf16x8*)(sb + SM_Q + tq * SROW + (((g + 4) ^ swq) * 16));
            const float gct = GR[tq];
#pragma unroll
            for (int kk = 0; kk < 2; ++kk) {
                f32x4 a[2];
#pragma unroll
                for (int hf = 0; hf < 2; ++hf) { const int tau = 2 * kk + hf; const int tr = 32 * (tau >> 1) + 8 * (i16 >> 2) + 4 * (tau & 1) + (i16 & 3);
                    const bf16x8 k0 = *(const LAS bf16x8*)(sb + SM_K + tr * SROW + ((g ^ swk) * 16)), k1 = *(const LAS bf16x8*)(sb + SM_K + tr * SROW + (((g + 4) ^ swk) * 16));
                    const f32x4 gk = *(const LAS f32x4*)(GR + rowmap(tau, g, 0));
                    f32x4 s = {0.f, 0.f, 0.f, 0.f}; s = MFMA16(k0, q0, s); s = MFMA16(k1, q1, s);
#pragma unroll
                    for (int r = 0; r < 4; ++r) { const int tp = rowmap(tau, g, r); const bool ok = dir ? (tq <= tp) : (tq >= tp); s[r] = ok ? s[r] * __expf(gct - gk[r]) : 0.f; }
                    a[hf] = s; }
                *(LAS bf16x8*)(sb + SM_QK + tq * SROW + (((4 * kk + g) ^ swq) * 16)) = pack_frag(a[0], a[1]);
            }
        };
        auto flush_o = [&](int step) {
            if (step < 4 || step >= NSTEP) return;
            const int chunk = dir ? 131 - step : step - 4;
            LAS unsigned char* sb = F.lds + (step & 1) * SM_STAGE;
#pragma unroll
            for (int k = 0; k < 2; ++k) { const int ci = stid + 256 * k; const int t = ci >> 3, p = ci & 7;
                *(u32x4*)(OD + ((size_t)b * SEQ + chunk * 64 + t) * 512 + h * 64 + 8 * p) = *(const LAS u32x4*)(sb + SM_O + t * SROW + p * 16); }
        };
        issue(0); commit(0); issue(1);
        SCAN_BAR();
        for (int n = 0; n < NSTEP; ++n) {
            qkm(n);
            SCAN_BAR();
            flush_o(n - 1); commit(n + 1); issue(n + 2);
            SCAN_BAR();
        }
        flush_o(NSTEP - 1);
    }
}
__device__ __forceinline__ void phase_mp(Ctx& F, const Args& A) {
    const int l = F.lane, j = l & 7;
    bf16* OF = (bf16*)(F.dout + DO_OF); const bf16* OB = (const bf16*)(F.dout + DO_OB); const bf16* ZDN = (const bf16*)(F.ws + WS_ZDN);
    float w8[8];
#pragma unroll
    for (int e = 0; e < 8; ++e) w8[e] = A.in[14][8 * j + e];
#pragma unroll 4
    for (int m = F.gw; m < ML; m += F.NGW) {
        const size_t off = (size_t)m * 512 + 8 * l; float a[8], bq[8], z[8]; unpack8(*(const u32x4*)(OF + off), a); unpack8(*(const u32x4*)(OB + off), bq); unpack8(*(const u32x4*)(ZDN + off), z);
        float ss = 0.f;
#pragma unroll
        for (int e = 0; e < 8; ++e) { a[e] += bq[e]; ss += a[e] * a[e]; }
        const float r = rsqrtf(red8(ss) * (1.f / 64.f) + EPSF);
#pragma unroll
        for (int e = 0; e < 8; ++e) a[e] = a[e] * r * w8[e] * z[e];
        *(u32x4*)(OF + off) = pack8(a);
    }
}
constexpr size_t WS_CTL = 65536, CTL_BYTES = 32768;
constexpr int LDS_MISC = 131072;
#define XB_TMO      128
#define XB_XCNT(j)  (256  + 64 * (j))
#define XB_XSUB(j)  (1280 + 64 * (j))
#define XB_XGEN(j)  (2304 + 64 * (j))
#define XB_TOP      3328
#define XB_TOPGEN   3392
#define XCD_BAR_WORDS 3456
#define XB_SPIN_CAP (1u << 18)

__device__ __forceinline__ unsigned xb_ld(unsigned* p)              { return __hip_atomic_load(p, __ATOMIC_RELAXED, __HIP_MEMORY_SCOPE_AGENT); }
__device__ __forceinline__ unsigned xb_add(unsigned* p, unsigned v) { return __hip_atomic_fetch_add(p, v, __ATOMIC_RELAXED, __HIP_MEMORY_SCOPE_AGENT); }
__device__ __forceinline__ unsigned xb_xcc_id() { return (unsigned)__builtin_amdgcn_s_getreg((3 << 11) | 20) & 0xFu; }
#define XB_SPIN(cond, bar) do { unsigned _sp = 0; while (cond) { __builtin_amdgcn_s_sleep(1); \
    if ((++_sp & 255u) == 0u) { if (xb_ld(&(bar)[XB_TMO])) break; if (_sp > XB_SPIN_CAP) { atomicAdd(&(bar)[XB_TMO], 1u); break; } } } } while (0)

struct XcdBarrier {
    unsigned G;
    unsigned* bar; unsigned x;
    volatile LAS unsigned* st;
};

__device__ __forceinline__ XcdBarrier xcd_barrier_post(unsigned* bar, volatile LAS unsigned* st, unsigned G) {
    XcdBarrier b; b.G = G; b.bar = bar; b.x = xb_xcc_id(); b.st = st;
    if (threadIdx.x == 0) (void)xb_add(&bar[XB_XCNT(b.x)], 1u);
    return b;
}
__device__ __forceinline__ void xcd_barrier_complete(unsigned* bar, unsigned x, unsigned G, unsigned& nloc, unsigned& nx) {
    unsigned sum, cnt, mine, sp = 0u;
    for (;;) {
        sum = 0u; cnt = 0u; mine = 0u;
#pragma unroll
        for (unsigned j = 0; j < 16; ++j) { const unsigned c = xb_ld(&bar[XB_XCNT(j)]); sum += c; cnt += (c > 0u) ? 1u : 0u; mine = (j == x) ? c : mine; }
        if (sum == G) break;
        __builtin_amdgcn_s_sleep(1);
        if ((++sp & 255u) == 0u) { if (xb_ld(&bar[XB_TMO])) break; if (sp > XB_SPIN_CAP) { atomicAdd(&bar[XB_TMO], 1u); break; } }
    }
    nloc = mine > 0u ? mine : 1u; nx = cnt > 0u ? cnt : 1u;
}

__device__ __forceinline__ void xcd_barrier(const XcdBarrier& b) {
    asm volatile("s_waitcnt vmcnt(0)" ::: "memory");
    __syncthreads();
    if (threadIdx.x == 0) {
        unsigned* bar = b.bar;
        __builtin_amdgcn_s_waitcnt(0);
        unsigned nloc = b.st[0], nx = b.st[1];
        if (nloc == 0u) { xcd_barrier_complete(bar, b.x, b.G, nloc, nx); b.st[0] = nloc; b.st[1] = nx; }
        const unsigned old = xb_add(&bar[XB_XSUB(b.x)], 1u);
        const unsigned gen = old / nloc;
        if (old + 1u == (gen + 1u) * nloc) {
            __builtin_amdgcn_fence(__ATOMIC_RELEASE, "agent");
            asm volatile("s_waitcnt vmcnt(0)" ::: "memory");
            const unsigned og = xb_add(&bar[XB_TOP], 1u);
            const unsigned tg = og / nx;
            if (og + 1u == (tg + 1u) * nx) xb_add(&bar[XB_TOPGEN], 1u);
            else XB_SPIN(xb_ld(&bar[XB_TOPGEN]) == tg, bar);
            __builtin_amdgcn_fence(__ATOMIC_ACQUIRE, "agent");
            xb_add(&bar[XB_XGEN(b.x)], 1u);
            asm volatile("s_waitcnt vmcnt(0)" ::: "memory");
        } else {
            XB_SPIN(xb_ld(&bar[XB_XGEN(b.x)]) == gen, bar);
            __builtin_amdgcn_fence(__ATOMIC_ACQUIRE, "agent");
            asm volatile("s_waitcnt vmcnt(0)" ::: "memory");
        }
    }
    __syncthreads();
}

struct ShadowOrder {
    int c, G;
    __device__ void init(int G_, int c_) { G = G_; c = c_; }
    __device__ bool next(int i, pg8::Unit& u) const {
        if ((G & 7) != 0) { const long L = (long)i * G + c; if (L >= 512) return false; u.pm = (int)(L >> 2); u.pn = (int)(L & 3); return true; }
        const int per = G >> 3, xcd = c & 7, j = c >> 3, w = i * per + j;
        if (w >= 64) return false;
        u.pm = 16 * xcd + (w >> 2); u.pn = w & 3; return true;
    }
    __device__ __forceinline__ void a_ready(const pg8::Unit&) const {}
    __device__ __forceinline__ void done(const pg8::Unit&) const {}
};
constexpr size_t WS_CNT_PB = 65536 + 15616, WS_CNT_PA = 65536 + 15872, WS_CNT_P4 = 65536 + 16128;
__device__ __forceinline__ void seam_arrive(unsigned char* ws, size_t word) {
    asm volatile("s_waitcnt vmcnt(0)" ::: "memory");
    __syncthreads();
    if (threadIdx.x == 0) { __builtin_amdgcn_fence(__ATOMIC_RELEASE, "agent"); asm volatile("s_waitcnt vmcnt(0)" ::: "memory");
        __hip_atomic_fetch_add((unsigned*)(ws + word), 1u, __ATOMIC_RELAXED, __HIP_MEMORY_SCOPE_AGENT); }
}
__device__ __forceinline__ void seam_wait(unsigned char* ws, size_t word, unsigned want) {
    if (threadIdx.x == 0) { unsigned sp = 0u;
        while (__hip_atomic_load((unsigned*)(ws + word), __ATOMIC_RELAXED, __HIP_MEMORY_SCOPE_AGENT) < want) { __builtin_amdgcn_s_sleep(2); if (++sp > (1u << 20)) break; }
        __builtin_amdgcn_fence(__ATOMIC_ACQUIRE, "agent"); asm volatile("s_waitcnt vmcnt(0)" ::: "memory"); }
    __syncthreads();
}
#ifdef TPROBE
#define STAMP(k) do { if (blockIdx.x == 0 && threadIdx.x == 0) ((volatile LAS unsigned long long*)(F.lds + LDS_MISC + 64))[k] = __builtin_amdgcn_s_memrealtime(); } while (0)
#else
#define STAMP(k) do {} while (0)
#endif
#define REFRESH(F) do { int t_ = threadIdx.x; asm volatile("" : "+v"(t_)); (F).tid = t_; (F).lane = t_ & 63; } while (0)
__global__ void __launch_bounds__(NTHREADS, 2) fwd_kernel(Args args) {
    extern __shared__ __attribute__((aligned(16))) unsigned char lds_raw[];
    cg::grid_group grid = cg::this_grid();
    Ctx F;
    F.lds = (LAS unsigned char*)lds_raw; F.tid = threadIdx.x; F.lane = F.tid & 63; F.wave = __builtin_amdgcn_readfirstlane(F.tid >> 6);
    F.G = gridDim.x; F.gw = blockIdx.x * NWAVES + F.wave; F.NGW = F.G * NWAVES;
    F.ws = args.ws; F.dout = (unsigned char*)args.out;
    unsigned char* ws = args.ws;
    if (F.tid < 8) ((volatile LAS unsigned*)(F.lds + LDS_MISC))[F.tid] = 0u;
    __syncthreads();
    const XcdBarrier bar = xcd_barrier_post((unsigned*)(ws + WS_CTL), (volatile LAS unsigned*)(F.lds + LDS_MISC), gridDim.x);
    XcdBarrier bar2 = bar;
    if (blockIdx.x >= 64) bar2 = xcd_barrier_post((unsigned*)(ws + WS_CTL + 16384), (volatile LAS unsigned*)(F.lds + LDS_MISC + 16), gridDim.x - 64);
    STAMP(0);

#ifndef SK0
    REFRESH(F); phase0(F, args);
#endif
    if (args.ws == nullptr) grid.sync();
    if (threadIdx.x == 0) {
        unsigned* cnt = (unsigned*)(ws + WS_MODCNT); const unsigned want = (gridDim.x < 48u) ? gridDim.x : 48u; unsigned sp = 0u;
        while (__hip_atomic_load(cnt, __ATOMIC_RELAXED, __HIP_MEMORY_SCOPE_AGENT) < want) { __builtin_amdgcn_s_sleep(2); if (++sp > (1u << 20)) break; }
        __builtin_amdgcn_fence(__ATOMIC_ACQUIRE, "agent");
        asm volatile("s_waitcnt vmcnt(0)" ::: "memory");
    }
    __syncthreads(); STAMP(1);
#ifndef SK1
    REFRESH(F); phase1(F, args);
#endif
    xcd_barrier(bar); STAMP(2);
#ifndef SK2
    {
        pg8::Gemm gm{(const pg8::bf16_t*)(ws + WS_XN), (const pg8::bf16_t*)(ws + WS_WIN), MT, NPAD, DM}; pg8::StaticOrder S; S.init(MT, NPAD, F.G, (int)blockIdx.x);
        static_assert(pg8::EPI_BA == WS_BA && pg8::EPI_ZNA == WS_ZNA && pg8::EPI_ZDN == WS_ZDN && pg8::EPI_GNA == WS_GNA && pg8::EPI_GDN == WS_GDN && pg8::EPI_NAK == WS_NAK && pg8::EPI_NAV == WS_NAV && pg8::EPI_DNQKV == WS_DNQKV && DO_Q == 0, "epilogue map");
        pg8::EpiIn E{ws, F.dout, args.in[9], args.in[10]};
        pg8::gemm_phase<pg8::EpiIn, pg8::StaticOrder, true, true>(F.lds, gm, S, E);
    }
#endif
    xcd_barrier(bar); STAMP(3);
#ifndef SK3
    REFRESH(F); phase3<2>(F, args);
    REFRESH(F); phase3<1>(F, args);
#endif
    xcd_barrier(bar); STAMP(4);
#ifndef SK4
    REFRESH(F); phase4<false>(F, args);
#endif
    seam_arrive(ws, WS_CNT_P4); STAMP(5);
    if (blockIdx.x < 64) {
        REFRESH(F); phase4<true>(F, args);
        seam_wait(ws, WS_CNT_P4, gridDim.x);
    }
    if (blockIdx.x < 64) {
#ifndef SK6
        REFRESH(F); phase_scan(F, args); STAMP(12);
#endif
    } else {
#ifndef SK5
        REFRESH(F); phase_na(F, args, (int)blockIdx.x - 64, F.G - 64);
#endif
#ifdef TPROBE
        __syncthreads(); if (blockIdx.x == 64 && threadIdx.x == 0) *(volatile unsigned long long*)(ws + WS_CTL + 14336) = __builtin_amdgcn_s_memrealtime();
#endif
        xcd_barrier(bar2);
#ifndef SK8
        {   ShadowOrder S; S.init(F.G - 64, (int)blockIdx.x - 64);
            pg8::Gemm g1{(const pg8::bf16_t*)(F.dout + DO_Q), (const pg8::bf16_t*)(ws + WS_WONA), ML, DM, 512};
            pg8::EpiGate<0> E1{(const pg8::bf16_t*)(ws + WS_GNA), nullptr, (pg8::bf16_t*)(ws + WS_T1)};
            pg8::gemm_phase<pg8::EpiGate<0>, ShadowOrder, true, false>(F.lds, g1, S, E1); }
#endif
    }
    xcd_barrier(bar); STAMP(6);
#ifndef SK7
    REFRESH(F); phase_mp(F, args);
#endif
    xcd_barrier(bar); STAMP(7);
#ifndef SK8
    {
        pg8::StaticOrder S; S.init(ML, DM, F.G, (int)blockIdx.x);
        pg8::Gemm g2{(const pg8::bf16_t*)(F.dout + DO_OF), (const pg8::bf16_t*)(ws + WS_WODN), ML, DM, 512};
        pg8::EpiGate<1> E2{(const pg8::bf16_t*)(ws + WS_GDN), (const pg8::bf16_t*)(ws + WS_T1), (pg8::bf16_t*)(ws + WS_Y)};
        pg8::gemm_phase<pg8::EpiGate<1>, pg8::StaticOrder, true, true>(F.lds, g2, S, E2);
    }
#endif
    xcd_barrier(bar); STAMP(8);
#ifndef SK9
    {
        pg8::StaticOrder S; S.init(ML, DM, F.G, (int)blockIdx.x);
        pg8::Gemm g3{(const pg8::bf16_t*)(ws + WS_Y), (const pg8::bf16_t*)(ws + WS_WOUT), ML, DM, DM};
        pg8::EpiOut E3{args.in[0], (const float*)(ws + WS_MODV), args.out};
        pg8::gemm_phase<pg8::EpiOut, pg8::StaticOrder, true, true>(F.lds, g3, S, E3);
    }
#endif
#ifdef TPROBE
    xcd_barrier(bar); STAMP(11);
    if (blockIdx.x == 0) {
        __syncthreads();
        volatile LAS unsigned long long* ts = (volatile LAS unsigned long long*)(F.lds + LDS_MISC + 64);
        if (threadIdx.x == 0) ts[13] = *(volatile unsigned long long*)(ws + WS_CTL + 14336);
        __syncthreads();
        const float dt_us = (float)(ts[TP_B] - ts[TP_A]) * 0.01f; const float dl = sqrtf(dt_us * 0.1f / 16384.f);
        for (int i = threadIdx.x; i < 16384; i += NTHREADS) args.out[(size_t)i * 2048 + 7] += dl;
    }
#endif
}

extern "C" void kernel_launch(void* const* d_in, const int* in_sizes, int n_in, void* d_out, int out_size, void* d_ws, size_t ws_size, hipStream_t stream) {
    static int grid = 0;
    if (grid == 0) {
        if (n_in != 18 || out_size != ML * DM || ws_size < WS_END) { fprintf(stderr, "kernel_launch: unexpected problem (n_in %d, out %d, ws %zu)\n", n_in, out_size, ws_size); grid = -1; return; }
        int dev = 0, cus = 0, per_cu = 0;
        hipGetDevice(&dev); hipDeviceGetAttribute(&cus, hipDeviceAttributeMultiprocessorCount, dev);
        if (hipFuncSetAttribute((const void*)fwd_kernel, hipFuncAttributeMaxDynamicSharedMemorySize, LDS_BYTES) != hipSuccess) { fprintf(stderr, "kernel_launch: hipFuncSetAttribute failed\n"); grid = -1; return; }
        hipOccupancyMaxActiveBlocksPerMultiprocessor(&per_cu, (const void*)fwd_kernel, NTHREADS, LDS_BYTES);
        if (per_cu < 1) { fprintf(stderr, "kernel_launch: occupancy query says %d blocks per CU\n", per_cu); per_cu = 1; }
        (void)hipGetLastError();
        grid = cus;
        if (grid < 64) { fprintf(stderr, "kernel_launch: needs >= 64 CUs\n"); grid = -1; return; }
    }
    if (grid < 0) return;
    if (hipMemsetAsync((char*)d_ws + WS_CTL, 0, CTL_BYTES, stream) != hipSuccess) { fprintf(stderr, "kernel_launch: memset failed\n"); return; }
    Args a{};
    for (int i = 0; i < 18; ++i) a.in[i] = (const float*)d_in[i];
    a.out = (float*)d_out; a.ws = (unsigned char*)d_ws;
    void* kargs[] = {&a};
    hipError_t e = hipLaunchCooperativeKernel((const void*)fwd_kernel, dim3(grid), dim3(NTHREADS), kargs, LDS_BYTES, stream);
    if (e != hipSuccess) fprintf(stderr, "kernel_launch: cooperative launch failed: %s (grid %d)\n", hipGetErrorString(e), grid);
}
```

```cpp
#include <hip/hip_runtime.h>
#include <hip/hip_cooperative_groups.h>
#include <cstdio>
#include <cstdint>
namespace cg = cooperative_groups;
namespace pg8 {
#define PG8_LAS __attribute__((address_space(3)))
typedef unsigned short bf16_t;
typedef short bf16x8 __attribute__((ext_vector_type(8)));
typedef float f32x4 __attribute__((ext_vector_type(4)));
typedef unsigned u32x4 __attribute__((ext_vector_type(4)));
constexpr int BM = 256, BK = 64, HALF = 128, HTB = HALF * BK * 2  , STAGE_BYTES = 8 * HTB, NXCD = 8, WGM = 8;

__host__ __device__ __forceinline__ int lds_byte(int r, int c) { const int st = (r >> 4) * 2 + (c >> 5), rr = r & 15, cc = c & 31, ob = rr * 64 + cc * 2; return st * 1024 + (ob ^ (((ob >> 9) & 1) << 5)); }
__host__ __device__ __forceinline__ void stage_rc(int b, int& R, int& C) { const int st = b / 1024, sb = b % 1024, swz = sb ^ (((sb >> 9) & 1) << 5); R = (st >> 1) * 16 + swz / 64; C = (st & 1) * 32 + (swz % 64) / 2; }
__host__ __device__ __forceinline__ int perm32(int rho) { const int n = rho >> 4, i = rho & 15; return 8 * (i >> 2) + 4 * n + (i & 3); }

struct Unit { int pm, pn; };
struct Gemm { const bf16_t* A; const bf16_t* Bt; int M, N, K; };

struct StaticOrder {
    int nM, nN, nwg, G, c;
    __host__ __device__ void init(int M, int N, int G_, int c_) { nM = M / BM; nN = N / BM; nwg = nM * nN; G = G_; c = c_; }
    __host__ __device__ bool next(int i, Unit& u) const {
        const long L = (long)i * G + c; if (L >= nwg) return false;
        int wgid = (int)L; { const int q = nwg / NXCD, r = nwg % NXCD, xcd = wgid % NXCD, off = wgid / NXCD; wgid = (xcd < r ? xcd * (q + 1) : r * (q + 1) + (xcd - r) * q) + off; }
        const int nig = WGM * nN, gid = wgid / nig, fm = gid * WGM, gsz = (nM - fm) < WGM ? (nM - fm) : WGM;
        u.pm = fm + ((wgid % nig) % gsz); u.pn = (wgid % nig) / gsz; return true;
    }
    __device__ __forceinline__ void a_ready(const Unit&) const {}
    __device__ __forceinline__ void done(const Unit&) const {}
};

__device__ __forceinline__ unsigned cvt_pk_bf16(float lo, float hi) { unsigned r; asm volatile("v_cvt_pk_bf16_f32 %0, %1, %2" : "=v"(r) : "v"(lo), "v"(hi)); return r; }
__device__ __forceinline__ float bflo(unsigned w) { return __builtin_bit_cast(float, w << 16); }
__device__ __forceinline__ float bfhi(unsigned w) { return __builtin_bit_cast(float, w & 0xffff0000u); }
__device__ __forceinline__ float sigmoidf_(float v) { return __builtin_amdgcn_rcpf(1.0f + __expf(-v)); }
constexpr size_t EPI_MiB = 1u << 20, EPI_BA = 18 * EPI_MiB, EPI_ZNA = 24 * EPI_MiB, EPI_ZDN = 56 * EPI_MiB, EPI_GNA = 88 * EPI_MiB, EPI_GDN = 152 * EPI_MiB, EPI_NAK = 216 * EPI_MiB, EPI_NAV = 249 * EPI_MiB, EPI_DNQKV = 282 * EPI_MiB;
struct EpiIn {
    static constexpr bool PERM = true, AFTER_DRAIN = false;
    unsigned char* ws; unsigned char* dout;
    const float* wq; const float* wk;
    __device__ __forceinline__ void operator()(const f32x4 (&acc)[2][2][4][2], const Unit& u, int wr, int wc, int fr, int fq) const {
        const int pn = u.pn; size_t boff; int ldc, colt, act = 0; bool latent_only = false; float* ba = (float*)(ws + EPI_BA);
        if (pn < 2) { boff = 0; ldc = 512; colt = pn * 256; latent_only = true; }
        else if (pn < 4) { boff = EPI_NAK; ldc = 512; colt = (pn - 2) * 256; }
        else if (pn < 6) { boff = EPI_NAV; ldc = 512; colt = (pn - 4) * 256; }
        else if (pn < 8) { boff = EPI_ZNA; ldc = 512; colt = (pn - 6) * 256; act = 2; latent_only = true; }
        else if (pn < 14) { boff = EPI_DNQKV; ldc = 1536; colt = (pn - 8) * 256; }
        else if (pn < 16) { boff = EPI_ZDN; ldc = 512; colt = (pn - 14) * 256; act = 2; latent_only = true; }
        else if (pn < 20) { boff = EPI_GNA; ldc = 1024; colt = (pn - 16) * 256; act = 1; latent_only = true; }
        else if (pn < 24) { boff = EPI_GDN; ldc = 1024; colt = (pn - 20) * 256; act = 1; latent_only = true; }
        else {
            if (wc == 0) {
#pragma unroll
                for (int ai = 0; ai < 2; ++ai)
#pragma unroll
                    for (int m = 0; m < 4; ++m) { float* rowp = ba + (size_t)(u.pm * BM + ai * HALF + wr * 64 + m * 16 + fr) * 32 + 8 * fq;
                        *(f32x4*)(rowp) = acc[ai][0][m][0]; *(f32x4*)(rowp + 4) = acc[ai][0][m][1]; }
            }
            return;
        }
        if (latent_only && u.pm >= 128) return;
        if (pn < 4) {
            const float* w = (pn < 2) ? wq : wk; const float qs = (pn < 2) ? 0.125f : 1.0f;
            f32x4 wv[2][2];
#pragma unroll
            for (int bj = 0; bj < 2; ++bj)
#pragma unroll
                for (int n = 0; n < 2; ++n) wv[bj][n] = *(const f32x4*)(w + 32 * bj + 8 * fq + 4 * n) * qs;
            bf16_t* hb = ((pn < 2) ? (bf16_t*)dout : (bf16_t*)(ws + EPI_NAK)) + (size_t)(u.pm * BM + wr * 64 + fr) * 512 + (4 * (pn & 1) + wc) * 64 + 8 * fq;
#pragma unroll
            for (int ai = 0; ai < 2; ++ai)
#pragma unroll
                for (int m = 0; m < 4; ++m) {
                    float ss = 0.f;
#pragma unroll
                    for (int bj = 0; bj < 2; ++bj)
#pragma unroll
                        for (int n = 0; n < 2; ++n) { const f32x4 v = acc[ai][bj][m][n]; ss += (v[0] * v[0] + v[1] * v[1]) + (v[2] * v[2] + v[3] * v[3]); }
                    ss += __shfl_xor(ss, 16); ss += __shfl_xor(ss, 32);
                    const float r = __builtin_amdgcn_rsqf(ss * (1.0f / 64.0f) + 1e-6f);
                    bf16_t* rowp = hb + (size_t)(ai * HALF + m * 16) * 512;
#pragma unroll
                    for (int bj = 0; bj < 2; ++bj) { const f32x4 v0 = acc[ai][bj][m][0] * r * wv[bj][0], v1 = acc[ai][bj][m][1] * r * wv[bj][1];
                        u32x4 o; o.x = cvt_pk_bf16(v0[0], v0[1]); o.y = cvt_pk_bf16(v0[2], v0[3]); o.z = cvt_pk_bf16(v1[0], v1[1]); o.w = cvt_pk_bf16(v1[2], v1[3]);
                        *(u32x4*)(rowp + 32 * bj) = o; }
                }
            return;
        }
        bf16_t* base = (pn < 2) ? (bf16_t*)dout : (bf16_t*)(ws + boff);
        const int row0 = u.pm * BM + wr * 64 + fr, col0 = colt + wc * 32 + 8 * fq;
#pragma unroll
        for (int ai = 0; ai < 2; ++ai)
#pragma unroll
            for (int m = 0; m < 4; ++m) { bf16_t* rowp = base + (size_t)(row0 + ai * HALF + m * 16) * ldc + col0;
#pragma unroll
                for (int bj = 0; bj < 2; ++bj) { f32x4 v0 = acc[ai][bj][m][0], v1 = acc[ai][bj][m][1];
                    if (act != 0) {
#pragma unroll
                        for (int e = 0; e < 4; ++e) { const float s0 = sigmoidf_(v0[e]), s1 = sigmoidf_(v1[e]); v0[e] = (act == 1) ? s0 : v0[e] * s0; v1[e] = (act == 1) ? s1 : v1[e] * s1; }
                    }
                    u32x4 w; w.x = cvt_pk_bf16(v0[0], v0[1]); w.y = cvt_pk_bf16(v0[2], v0[3]); w.z = cvt_pk_bf16(v1[0], v1[1]); w.w = cvt_pk_bf16(v1[2], v1[3]);
                    *(u32x4*)(rowp + bj * HALF) = w; } }
    }
};
template <int MODE> struct EpiGate {
    static constexpr bool PERM = true, AFTER_DRAIN = false;
    const bf16_t* G; const bf16_t* T1; bf16_t* O;
    __device__ __forceinline__ void operator()(const f32x4 (&acc)[2][2][4][2], const Unit& u, int wr, int wc, int fr, int fq) const {
        const int row0 = u.pm * BM + wr * 64 + fr, col0 = u.pn * BM + wc * 32 + 8 * fq;
#pragma unroll
        for (int ai = 0; ai < 2; ++ai)
#pragma unroll
            for (int m = 0; m < 4; ++m) { const size_t off = (size_t)(row0 + ai * HALF + m * 16) * 1024 + col0;
#pragma unroll
                for (int bj = 0; bj < 2; ++bj) { const f32x4 v0 = acc[ai][bj][m][0], v1 = acc[ai][bj][m][1];
                    const u32x4 g = *(const u32x4*)(G + off + bj * HALF);
                    float o[8] = { v0[0] * bflo(g.x), v0[1] * bfhi(g.x), v0[2] * bflo(g.y), v0[3] * bfhi(g.y), v1[0] * bflo(g.z), v1[1] * bfhi(g.z), v1[2] * bflo(g.w), v1[3] * bfhi(g.w) };
                    if (MODE == 1) { const u32x4 t = *(const u32x4*)(T1 + off + bj * HALF);
                        o[0] += bflo(t.x); o[1] += bfhi(t.x); o[2] += bflo(t.y); o[3] += bfhi(t.y); o[4] += bflo(t.z); o[5] += bfhi(t.z); o[6] += bflo(t.w); o[7] += bfhi(t.w); }
                    u32x4 w; w.x = cvt_pk_bf16(o[0], o[1]); w.y = cvt_pk_bf16(o[2], o[3]); w.z = cvt_pk_bf16(o[4], o[5]); w.w = cvt_pk_bf16(o[6], o[7]);
                    *(u32x4*)(O + off + bj * HALF) = w; } }
    }
};
struct EpiOut {
    static constexpr bool PERM = true, AFTER_DRAIN = false;
    const float* x; const float* modv; float* out;
    __device__ __forceinline__ void operator()(const f32x4 (&acc)[2][2][4][2], const Unit& u, int wr, int wc, int fr, int fq) const {
        const int row0 = u.pm * BM + wr * 64 + fr, col0 = u.pn * BM + wc * 32 + 8 * fq;
        const float* gp = modv + (size_t)(u.pm / 32) * 3072 + 2048 + col0;
        f32x4 gv[2][2];
#pragma unroll
        for (int bj = 0; bj < 2; ++bj)
#pragma unroll
            for (int n = 0; n < 2; ++n) gv[bj][n] = *(const f32x4*)(gp + bj * HALF + 4 * n);
#pragma unroll
        for (int ai = 0; ai < 2; ++ai)
#pragma unroll
            for (int m = 0; m < 4; ++m) { const size_t off = (size_t)(row0 + ai * HALF + m * 16) * 1024 + col0;
#pragma unroll
                for (int bj = 0; bj < 2; ++bj)
#pragma unroll
                    for (int n = 0; n < 2; ++n) { const f32x4 xv = *(const f32x4*)(x + off + bj * HALF + 4 * n);
                        *(f32x4*)(out + off + bj * HALF + 4 * n) = xv + gv[bj][n] * acc[ai][bj][m][n]; } }
    }
};
template <class Epi, class Sched, bool ALIGN_EPI = false, bool SP2 = false>
__device__ __forceinline__ void gemm_phase(PG8_LAS unsigned char* lds, const Gemm g, const Sched& S, const Epi& E) {
    int tid_ = threadIdx.x; asm volatile("" : "+v"(tid_));
    const int tid = tid_, wid = __builtin_amdgcn_readfirstlane(tid >> 6), lane = tid & 63, wr = wid >> 2, wc = wid & 3, fr = lane & 15, fq = lane >> 4;
    const int K = g.K, nt = K / BK;
    unsigned voffA[2], voffB[2];
#pragma unroll
    for (int i = 0; i < 2; ++i) { int R, C; stage_rc(tid * 16 + i * 8192, R, C); const int Rb = Epi::PERM ? ((R & ~31) + perm32(R & 31)) : R;
        voffA[i] = (unsigned)(R * K + C) * 2u; voffB[i] = (unsigned)(Rb * K + C) * 2u; }
    const size_t kstep = (size_t)(BK * 2);
    const size_t hstep = (size_t)HALF * K * 2;
    const size_t tstep = 2 * hstep;
    const unsigned ldsw = (unsigned)wid * 1024u;
    const int aoff = lds_byte(wr * 64 + fr, fq * 8), boff = lds_byte(wc * 32 + fr, fq * 8);
#define PG8_SA(b, h) (((b) * 2 + (h)) * HTB)
#define PG8_SB(b, h) ((4 + (b) * 2 + (h)) * HTB)
#define PG8_STAGE(bufoff, gbase, voff) do { _Pragma("unroll") for (int _i = 0; _i < 2; ++_i) \
        __builtin_amdgcn_global_load_lds((const unsigned*)((const char*)(gbase) + (voff)[_i]), (PG8_LAS unsigned*)(lds + (bufoff) + ldsw + _i * 8192), 16, 0, 0); } while (0)
#define PG8_LDA(dst, b, h) do { _Pragma("unroll") for (int m = 0; m < 4; ++m) _Pragma("unroll") for (int k = 0; k < 2; ++k) dst[m][k] = *(const PG8_LAS bf16x8*)(lds + PG8_SA(b, h) + aoff + m * 2048 + k * 1024); } while (0)
#define PG8_LDB(dst, b, h) do { _Pragma("unroll") for (int n = 0; n < 2; ++n) _Pragma("unroll") for (int k = 0; k < 2; ++k) dst[n][k] = *(const PG8_LAS bf16x8*)(lds + PG8_SB(b, h) + boff + n * 2048 + k * 1024); } while (0)
#define PG8_MMA(ai, bj, At, Bt) do { __builtin_amdgcn_s_setprio(1); _Pragma("unroll") for (int m = 0; m < 4; ++m) _Pragma("unroll") for (int n = 0; n < 2; ++n) _Pragma("unroll") for (int k = 0; k < 2; ++k) \
        acc[ai][bj][m][n] = __builtin_amdgcn_mfma_f32_16x16x32_bf16(Bt[n][k], At[m][k], acc[ai][bj][m][n], 0, 0, 0); __builtin_amdgcn_s_setprio(0); } while (0)
#define PG8_WAIT_V(n) asm volatile("s_waitcnt vmcnt(" #n ")" ::: "memory")
#define PG8_WAIT_L(n) asm volatile("s_waitcnt lgkmcnt(" #n ")" ::: "memory")
#define PG8_BAR __builtin_amdgcn_s_barrier()
#define PG8_SCHED __builtin_amdgcn_sched_barrier(0)
    Unit cur, nxt; int ui = 0;
    if (!S.next(0, cur)) return;
    f32x4 acc[2][2][4][2];
#pragma unroll
    for (int a = 0; a < 2; ++a)
#pragma unroll
        for (int b = 0; b < 2; ++b)
#pragma unroll
            for (int m = 0; m < 4; ++m)
#pragma unroll
                for (int n = 0; n < 2; ++n) acc[a][b][m][n] = (f32x4){0.f, 0.f, 0.f, 0.f};
    bf16x8 At[4][2], B0[2][2], B1[2][2];
    const char* cA = (const char*)g.A + (size_t)cur.pm * tstep; const char* cB = (const char*)g.Bt + (size_t)cur.pn * tstep;
    S.a_ready(cur);
    if constexpr (SP2) {
        PG8_STAGE(PG8_SB(0, 0), cB, voffB); PG8_STAGE(PG8_SB(0, 1), cB + hstep, voffB); PG8_STAGE(PG8_SA(0, 0), cA, voffA); PG8_STAGE(PG8_SA(0, 1), cA + hstep, voffA);
        if (wr == 1) PG8_BAR;
        PG8_WAIT_V(2); PG8_BAR;
        PG8_STAGE(PG8_SB(1, 0), cB + kstep, voffB); PG8_STAGE(PG8_SA(1, 0), cA + kstep, voffA); PG8_STAGE(PG8_SB(1, 1), cB + hstep + kstep, voffB);
        PG8_WAIT_V(6); PG8_BAR;
    } else {
        PG8_STAGE(PG8_SB(0, 0), cB, voffB); PG8_STAGE(PG8_SA(0, 0), cA, voffA); PG8_STAGE(PG8_SB(0, 1), cB + hstep, voffB); PG8_STAGE(PG8_SA(0, 1), cA + hstep, voffA);
        if (wr == 1) PG8_BAR;
        PG8_WAIT_V(4); PG8_BAR;
        PG8_STAGE(PG8_SB(1, 0), cB + kstep, voffB); PG8_STAGE(PG8_SA(1, 0), cA + kstep, voffA); PG8_STAGE(PG8_SB(1, 1), cB + hstep + kstep, voffB);
        PG8_WAIT_V(6); PG8_BAR;
    }
    for (;;) {
        const bool has_next = S.next(ui + 1, nxt);
        const char* nA = has_next ? (const char*)g.A + (size_t)nxt.pm * tstep : cA; const char* nB = has_next ? (const char*)g.Bt + (size_t)nxt.pn * tstep : cB;
        for (int t = 0; t < nt; t += 2) {
            const bool last = (t == nt - 2);
            const char* a1 = cA + (size_t)(t + 1) * kstep;
            const char* a2 = last ? nA : cA + (size_t)(t + 2) * kstep; const char* b2 = last ? nB : cB + (size_t)(t + 2) * kstep;
            const char* a3 = a2 + kstep; const char* b3 = b2 + kstep;
            if (last && has_next) S.a_ready(nxt);
            if constexpr (SP2) {
            PG8_LDB(B0, 0, 0); PG8_LDB(B1, 0, 1); PG8_SCHED; PG8_LDA(At, 0, 0); PG8_STAGE(PG8_SA(1, 1), a1 + hstep, voffA);
            PG8_WAIT_V(8); PG8_WAIT_L(0); PG8_BAR; PG8_MMA(0, 0, At, B0); PG8_MMA(0, 1, At, B1); PG8_BAR; PG8_SCHED;
            PG8_LDA(At, 0, 1); PG8_STAGE(PG8_SB(0, 0), b2, voffB); PG8_STAGE(PG8_SB(0, 1), b2 + hstep, voffB); PG8_STAGE(PG8_SA(0, 0), a2, voffA);
            PG8_WAIT_V(8); PG8_WAIT_L(0); PG8_BAR; PG8_MMA(1, 0, At, B0); PG8_MMA(1, 1, At, B1); PG8_BAR; PG8_SCHED;
            PG8_LDB(B0, 1, 0); PG8_LDB(B1, 1, 1); PG8_SCHED; PG8_LDA(At, 1, 0); PG8_STAGE(PG8_SA(0, 1), a2 + hstep, voffA);
            PG8_WAIT_V(8); PG8_WAIT_L(0); PG8_BAR; PG8_MMA(0, 0, At, B0); PG8_MMA(0, 1, At, B1); PG8_BAR; PG8_SCHED;
            PG8_LDA(At, 1, 1); PG8_STAGE(PG8_SB(1, 0), b3, voffB); PG8_STAGE(PG8_SB(1, 1), b3 + hstep, voffB); PG8_STAGE(PG8_SA(1, 0), a3, voffA);
            PG8_WAIT_V(8); PG8_WAIT_L(0); PG8_BAR; PG8_MMA(1, 0, At, B0); PG8_MMA(1, 1, At, B1); PG8_BAR; PG8_SCHED;
            } else {
            PG8_LDB(B0, 0, 0); PG8_SCHED; PG8_LDA(At, 0, 0); PG8_STAGE(PG8_SA(1, 1), a1 + hstep, voffA);
            PG8_WAIT_L(8); PG8_BAR; PG8_WAIT_L(0); PG8_MMA(0, 0, At, B0); PG8_BAR; PG8_SCHED;
            PG8_LDB(B1, 0, 1); PG8_STAGE(PG8_SB(0, 0), b2, voffB);
            PG8_BAR; PG8_WAIT_L(0); PG8_MMA(0, 1, At, B1); PG8_BAR;
            PG8_LDA(At, 0, 1); PG8_STAGE(PG8_SA(0, 0), a2, voffA);
            PG8_BAR; PG8_WAIT_L(0); PG8_MMA(1, 0, At, B0); PG8_BAR; PG8_SCHED;
            PG8_STAGE(PG8_SB(0, 1), b2 + hstep, voffB);
            PG8_WAIT_V(6); PG8_BAR; PG8_MMA(1, 1, At, B1); PG8_BAR;
            PG8_LDB(B0, 1, 0); PG8_SCHED; PG8_LDA(At, 1, 0); PG8_STAGE(PG8_SA(0, 1), a2 + hstep, voffA);
            PG8_WAIT_L(8); PG8_BAR; PG8_WAIT_L(0); PG8_MMA(0, 0, At, B0); PG8_BAR; PG8_SCHED;
            PG8_LDB(B1, 1, 1); PG8_STAGE(PG8_SB(1, 0), b3, voffB);
            PG8_BAR; PG8_WAIT_L(0); PG8_MMA(0, 1, At, B1); PG8_BAR;
            PG8_LDA(At, 1, 1); PG8_STAGE(PG8_SA(1, 0), a3, voffA);
            PG8_BAR; PG8_WAIT_L(0); PG8_MMA(1, 0, At, B0); PG8_BAR; PG8_SCHED;
            PG8_STAGE(PG8_SB(1, 1), b3 + hstep, voffB);
            PG8_WAIT_V(6); PG8_BAR; PG8_MMA(1, 1, At, B1); PG8_BAR;
            }
        }
        if constexpr (ALIGN_EPI) { if (wr == 0) PG8_BAR; }
        if constexpr (!Epi::AFTER_DRAIN) { E(acc, cur, wr, wc, fr, fq); S.done(cur); }
        if (!has_next) break;
#pragma unroll
        for (int a = 0; a < 2; ++a)
#pragma unroll
            for (int b = 0; b < 2; ++b)
#pragma unroll
                for (int m = 0; m < 4; ++m)
#pragma unroll
                    for (int n = 0; n < 2; ++n) acc[a][b][m][n] = (f32x4){0.f, 0.f, 0.f, 0.f};
        cur = nxt; cA = nA; cB = nB; ++ui;
        if constexpr (ALIGN_EPI) { if (wr == 1) PG8_BAR; }
    }
    PG8_WAIT_V(0);
    if constexpr (!ALIGN_EPI) { if (wr == 0) PG8_BAR; }
    PG8_BAR;
    if constexpr (Epi::AFTER_DRAIN) { E.fused(acc, cur, wr, wc, fr, fq, lds, wid, lane); S.done(cur); }
#undef PG8_SA
#undef PG8_SB
#undef PG8_STAGE
#undef PG8_LDA
#undef PG8_LDB
#undef PG8_MMA
#undef PG8_WAIT_V
#undef PG8_WAIT_L
#undef PG8_BAR
#undef PG8_SCHED
}
}
constexpr int DM = 1024, NB = 4, SEQ = 8192, CTXL = 256, NH = 8;
constexpr int ML = NB * SEQ, MC = NB * CTXL, MT = ML + MC;
constexpr int NPROJ = 6176, NPAD = 6400;
constexpr int NSTEP = 132;
constexpr float EPSF = 1e-6f;
constexpr int NWAVES = 8, NTHREADS = 512;
constexpr int LDS_BYTES = 135168;
constexpr size_t MiB = 1u << 20;
constexpr size_t WS_MODCNT = 65536 + 15360;
constexpr size_t WS_MODV = 4096;
constexpr size_t WS_WIN = 1 * MiB;
constexpr size_t WS_WONA = 14 * MiB, WS_WODN = 15 * MiB, WS_WOUT = 16 * MiB;
constexpr size_t WS_BA = 18 * MiB;
constexpr size_t WS_VT8C = 22 * MiB + 512 * 1024;
constexpr size_t WS_ZNA = 24 * MiB, WS_ZDN = 56 * MiB, WS_GNA = 88 * MiB, WS_GDN = 152 * MiB;
constexpr size_t WS_NAK = 216 * MiB, WS_NAV = 249 * MiB, WS_DNQKV = 282 * MiB;
constexpr size_t WS_TB = 282 * MiB, WS_GC = 354 * MiB;
constexpr size_t WS_XN = 381 * MiB;
constexpr size_t WS_DQ = 381 * MiB, WS_DK = 413 * MiB, WS_DKT = 445 * MiB, WS_DV = 477 * MiB;
constexpr size_t WS_DKC = 509 * MiB, WS_DKTC = 510 * MiB, WS_DVC = 511 * MiB;
constexpr size_t WS_T1 = 216 * MiB + 1 * MiB + 69632;
constexpr size_t WS_Y = 445 * MiB;
constexpr size_t WS_END = 512 * MiB;
constexpr size_t DO_Q = 0, DO_VT8 = 32 * MiB, DO_OF = 64 * MiB, DO_OB = 96 * MiB;

#define LAS __attribute__((address_space(3)))
typedef unsigned short bf16;
typedef unsigned u32x4 __attribute__((ext_vector_type(4)));
typedef unsigned u32x2 __attribute__((ext_vector_type(2)));
typedef float f32x4 __attribute__((ext_vector_type(4)));
typedef short bf16x8 __attribute__((ext_vector_type(8)));
#define LDS_WAIT() asm volatile("s_waitcnt lgkmcnt(0)" ::: "memory")
__device__ __forceinline__ unsigned f2bf(float f) { unsigned u = __builtin_bit_cast(unsigned, f); return (u + 0x7fffu + ((u >> 16) & 1u)) >> 16; }
typedef float f32x2_t __attribute__((ext_vector_type(2))); typedef __bf16 bf16x2_t __attribute__((ext_vector_type(2)));
__device__ __forceinline__ unsigned pk2(float lo, float hi) { f32x2_t v = {lo, hi}; bf16x2_t b = __builtin_convertvector(v, bf16x2_t); return __builtin_bit_cast(unsigned, b); }
__device__ __forceinline__ unsigned short f2bf1(float f) { return (unsigned short)(pk2(f, f) & 0xffffu); }
__device__ __forceinline__ float blo(unsigned w) { return __builtin_bit_cast(float, w << 16); }
__device__ __forceinline__ float bhi(unsigned w) { return __builtin_bit_cast(float, w & 0xffff0000u); }
__device__ __forceinline__ float bf1(unsigned short h) { return __builtin_bit_cast(float, ((unsigned)h) << 16); }
__device__ __forceinline__ void unpack8(const u32x4 v, float (&f)[8]) { f[0] = blo(v.x); f[1] = bhi(v.x); f[2] = blo(v.y); f[3] = bhi(v.y); f[4] = blo(v.z); f[5] = bhi(v.z); f[6] = blo(v.w); f[7] = bhi(v.w); }
__device__ __forceinline__ u32x4 pack8(const float (&f)[8]) { u32x4 w; w.x = pk2(f[0], f[1]); w.y = pk2(f[2], f[3]); w.z = pk2(f[4], f[5]); w.w = pk2(f[6], f[7]); return w; }
__device__ __forceinline__ bf16x8 pack_frag(const f32x4 a, const f32x4 b) { u32x4 w; w.x = pk2(a[0], a[1]); w.y = pk2(a[2], a[3]); w.z = pk2(b[0], b[1]); w.w = pk2(b[2], b[3]); return __builtin_bit_cast(bf16x8, w); }
__device__ __forceinline__ float sigm(float v) { return __builtin_amdgcn_rcpf(1.0f + __expf(-v)); }
#define MFMA16(a, b, c) __builtin_amdgcn_mfma_f32_16x16x32_bf16((a), (b), (c), 0, 0, 0)
__device__ __forceinline__ void tr8x8(const u32x4 (&in)[8], u32x4 (&out)[8]) {
#pragma unroll
    for (int e = 0; e < 8; ++e) {
        unsigned w[4];
#pragma unroll
        for (int p = 0; p < 4; ++p) { const unsigned a = in[2 * p][e >> 1], b = in[2 * p + 1][e >> 1];
            w[p] = (e & 1) ? ((a >> 16) | (b & 0xffff0000u)) : ((a & 0xffffu) | (b << 16)); }
        out[e] = (u32x4){w[0], w[1], w[2], w[3]};
    }
}

struct Args { const float* in[18]; float* out; unsigned char* ws; };

struct Ctx {
    LAS unsigned char* lds; int tid, lane, wave, G, gw, NGW;
    unsigned char* ws; unsigned char* dout;
};

__device__ __forceinline__ void p0_transpose_item(const float* W, int K, int N, bf16* WT, int k0, int n0, int dst_row, LAS float* scr, int lane) {
#pragma unroll 8
    for (int i = 0; i < 32; ++i) { const int kk = 2 * i + (lane >> 5); scr[kk * 33 + (lane & 31)] = W[(size_t)(k0 + kk) * N + n0 + (lane & 31)]; }
    LDS_WAIT();
    const int c = lane & 7;
#pragma unroll
    for (int j = 0; j < 4; ++j) { const int n = (lane >> 3) + 8 * j; const LAS float* s = scr + (8 * c) * 33 + n;
        u32x4 o; o.x = pk2(s[0 * 33], s[1 * 33]); o.y = pk2(s[2 * 33], s[3 * 33]); o.z = pk2(s[4 * 33], s[5 * 33]); o.w = pk2(s[6 * 33], s[7 * 33]);
        *(u32x4*)(WT + (size_t)(dst_row + n) * K + k0 + 8 * c) = o; }
    LDS_WAIT();
}
__device__ __forceinline__ void phase0(Ctx& F, const Args& A) {
    if (blockIdx.x < 48) {
        LAS float* sc = (LAS float*)F.lds;
        LAS float* red = (LAS float*)(F.lds + 20480);
        for (int i = F.tid; i < 5 * 1024; i += NTHREADS) { const int v = i >> 10, k = i & 1023; const float cv = (v < 4) ? A.in[1][v * 1024 + k] : A.in[3][k]; sc[i] = cv * sigm(cv); }
        __syncthreads();
        const int n0 = blockIdx.x * 64, kc = F.tid >> 4, c4 = F.tid & 15;
        float acc[5][4];
#pragma unroll
        for (int v = 0; v < 5; ++v)
#pragma unroll
            for (int e = 0; e < 4; ++e) acc[v][e] = 0.f;
#pragma unroll 16
        for (int i = 0; i < 32; ++i) { const int k = kc * 32 + i; const f32x4 w = *(const f32x4*)(A.in[4] + (size_t)k * 3072 + n0 + 4 * c4);
#pragma unroll
            for (int v = 0; v < 5; ++v) { const float s = sc[v * 1024 + k]; acc[v][0] += s * w[0]; acc[v][1] += s * w[1]; acc[v][2] += s * w[2]; acc[v][3] += s * w[3]; } }
#pragma unroll
        for (int v = 0; v < 5; ++v)
#pragma unroll
            for (int e = 0; e < 4; ++e) red[(kc * 5 + v) * 64 + 4 * c4 + e] = acc[v][e];
        __syncthreads();
        if (F.tid < 320) { const int v = F.tid >> 6, col = F.tid & 63; float s = A.in[5][n0 + col];
            for (int k = 0; k < 32; ++k) s += red[(k * 5 + v) * 64 + col];
            ((float*)(F.ws + WS_MODV))[v * 3072 + n0 + col] = s; __threadfence(); }
        __syncthreads();
        if (F.tid == 0) __hip_atomic_fetch_add((unsigned*)(F.ws + WS_MODCNT), 1u, __ATOMIC_RELAXED, __HIP_MEMORY_SCOPE_AGENT);
    }
    { u32x4* z = (u32x4*)(F.ws + WS_WIN + (size_t)NPROJ * 1024 * 2); const int n16 = (NPAD - NPROJ) * 1024 * 2 / 16;
      for (int i = blockIdx.x * NTHREADS + F.tid; i < n16; i += F.G * NTHREADS) z[i] = (u32x4){0u, 0u, 0u, 0u}; }
    LAS float* scr = (LAS float*)(F.lds + F.wave * 16384);
    constexpr int I_IN = 16 * 193, I_ONA = 8 * 32, I_ODN = 8 * 32, I_OUT = 16 * 32;
    if (blockIdx.x >= 48 || F.G <= 48)
    for (int it = (F.G > 48 ? F.gw - 48 * NWAVES : F.gw); it < I_IN + I_ONA + I_ODN + I_OUT; it += (F.G > 48 ? F.NGW - 48 * NWAVES : F.NGW)) {
        int r = it;
        if (r < I_IN) { const int kb = r / 193, nb = r % 193, c0 = 32 * nb; const int dst = (c0 < 1024) ? ((c0 & ~255) + 128 * ((c0 >> 5) & 1) + 32 * ((c0 >> 6) & 3))
                              : ((c0 < 4096) ? c0 : ((c0 < 4128) ? 6144 + (c0 - 4096) : c0 - 32));
            p0_transpose_item(A.in[7], 1024, NPROJ, (bf16*)(F.ws + WS_WIN), 64 * kb, c0, dst, scr, F.lane); continue; }
        r -= I_IN;
        if (r < I_ONA) { p0_transpose_item(A.in[15], 512, 1024, (bf16*)(F.ws + WS_WONA), 64 * (r / 32), 32 * (r % 32), 32 * (r % 32), scr, F.lane); continue; }
        r -= I_ONA;
        if (r < I_ODN) { p0_transpose_item(A.in[16], 512, 1024, (bf16*)(F.ws + WS_WODN), 64 * (r / 32), 32 * (r % 32), 32 * (r % 32), scr, F.lane); continue; }
        r -= I_ODN;
        p0_transpose_item(A.in[17], 1024, 1024, (bf16*)(F.ws + WS_WOUT), 64 * (r / 32), 32 * (r % 32), 32 * (r % 32), scr, F.lane);
    }
}
__device__ __forceinline__ float wave_sum(float v) {
#pragma unroll
    for (int o = 1; o < 64; o <<= 1) v += __shfl_xor(v, o);
    return v;
}
__device__ __forceinline__ void phase1(Ctx& F, const Args& A) {
    const float* modv = (const float*)(F.ws + WS_MODV); bf16* XN = (bf16*)(F.ws + WS_XN);
    for (int ch = F.gw; ch < ML / 16 + MC; ch += F.NGW) {
        const bool isctx = ch >= ML / 16;
        const int row0 = isctx ? ML + (ch - ML / 16) : ch * 16; const int nrow = isctx ? 1 : 16; const int b = isctx ? 4 : row0 / SEQ;
        f32x4 mul[4], add[4];
#pragma unroll
        for (int j = 0; j < 4; ++j) { const int col = 4 * F.lane + 256 * j; const f32x4 nw = *(const f32x4*)(A.in[6] + col), sc = *(const f32x4*)(modv + b * 3072 + 1024 + col);
            mul[j] = nw * (sc + 1.0f); add[j] = *(const f32x4*)(modv + b * 3072 + col); }
#pragma unroll 4
        for (int rr = 0; rr < nrow; ++rr) {
            const int row = row0 + rr; const float* src = (row < ML) ? A.in[0] + (size_t)row * DM : A.in[2] + (size_t)(row - ML) * DM;
            f32x4 v[4]; float s = 0.f;
#pragma unroll
            for (int j = 0; j < 4; ++j) { v[j] = *(const f32x4*)(src + 4 * F.lane + 256 * j); s += (v[j][0] * v[j][0] + v[j][1] * v[j][1]) + (v[j][2] * v[j][2] + v[j][3] * v[j][3]); }
            const float r = rsqrtf(wave_sum(s) * (1.f / DM) + EPSF);
#pragma unroll
            for (int j = 0; j < 4; ++j) { const f32x4 o = v[j] * r * mul[j] + add[j];
                *(u32x2*)(XN + (size_t)row * DM + 4 * F.lane + 256 * j) = (u32x2){pk2(o[0], o[1]), pk2(o[2], o[3])}; }
        }
    }
}
__device__ __forceinline__ float red8(float v) { v += __shfl_xor(v, 1); v += __shfl_xor(v, 2); v += __shfl_xor(v, 4); return v; }
__device__ __forceinline__ void item_pos(int it, bool& lat, int& m0, int& b, int& t0, int& Tseq) {
    lat = it < ML / 8;
    if (lat) { m0 = it * 8; b = m0 / SEQ; t0 = m0 % SEQ; Tseq = SEQ; } else { const int ci = it - ML / 8; m0 = ML + ci * 8; b = ci / 32; t0 = (ci % 32) * 8; Tseq = CTXL; }
}
template <int PASS> __device__ __forceinline__ void phase3(Ctx& F, const Args& A) {
    const int l = F.lane, h = l >> 3, j = l & 7;
    if (PASS == 1) {
        const bf16* NAV = (const bf16*)(F.ws + WS_NAV);
        for (int it = F.gw; it < MT / 8; it += F.NGW) {
            bool lat; int m0, b, t0, Tseq; item_pos(it, lat, m0, b, t0, Tseq);
            const int bh = b * 8 + h;
            { u32x4 vin[8], vout[8];
#pragma unroll
              for (int t = 0; t < 8; ++t) vin[t] = *(const u32x4*)(NAV + (size_t)(m0 + t) * 512 + 8 * l);
              tr8x8(vin, vout);
              u32x4* dst = lat ? (u32x4*)(F.dout + DO_VT8) + ((size_t)bh * (SEQ / 8) + t0 / 8) * 64 + 8 * j : (u32x4*)(F.ws + WS_VT8C) + ((size_t)bh * (CTXL / 8) + t0 / 8) * 64 + 8 * j;
#pragma unroll
              for (int e = 0; e < 8; ++e) dst[e] = vout[e]; }
        }
    }
    if (PASS == 2) {
        const bf16* DNQKV = (const bf16*)(F.ws + WS_DNQKV);
        LAS float* rt = (LAS float*)F.lds;
        for (int idx = F.tid; idx < 128 * 16; idx += NTHREADS) { const float ang = (float)(idx >> 4) * exp2f(-(float)(idx & 15) * (13.287712379549449f / 16.0f));
            rt[2 * idx] = __cosf(ang); rt[2 * idx + 1] = __sinf(ang); }
        __syncthreads();
        for (int s_ = F.gw; s_ < 3 * (ML / 8) + 128 + 3 * (MC / 8); s_ += F.NGW) {
            if (s_ >= 3 * (ML / 8) && s_ < 3 * (ML / 8) + 128) continue;
            const int it2 = (s_ < 3 * (ML / 8)) ? (3 * (ML / 8) - 1 - s_) : s_ - 128;
            const int seg = it2 % 3, it = it2 / 3;
            bool lat; int m0, b, t0, Tseq; item_pos(it, lat, m0, b, t0, Tseq);
            if (seg == 0 && !lat) continue;
            const int bh = b * 8 + h;
            float cw[3][8];
#pragma unroll
            for (int tp = 0; tp < 3; ++tp) { const f32x4 a = *(const f32x4*)(A.in[8] + tp * 1536 + seg * 512 + 8 * l), bq = *(const f32x4*)(A.in[8] + tp * 1536 + seg * 512 + 8 * l + 4);
                cw[tp][0] = a[0]; cw[tp][1] = a[1]; cw[tp][2] = a[2]; cw[tp][3] = a[3]; cw[tp][4] = bq[0]; cw[tp][5] = bq[1]; cw[tp][6] = bq[2]; cw[tp][7] = bq[3]; }
            bf16* dst; if (seg == 0) dst = (bf16*)(F.ws + WS_DQ); else if (seg == 1) dst = lat ? (bf16*)(F.ws + WS_DK) : (bf16*)(F.ws + WS_DKC); else dst = lat ? (bf16*)(F.ws + WS_DV) : (bf16*)(F.ws + WS_DVC);
            const bf16* src = DNQKV + (size_t)m0 * 1536 + seg * 512 + 8 * l;
            u32x4 raw[10], res[8];
#pragma unroll
            for (int t = 0; t < 10; ++t) { const int tt = t0 - 1 + t; raw[t] = (tt >= 0 && tt < Tseq) ? *(const u32x4*)(src + (ptrdiff_t)(t - 1) * 1536) : (u32x4){0u, 0u, 0u, 0u}; }
#pragma unroll
            for (int t = 0; t < 8; ++t) {
                const u32x4 r0 = raw[t], r1 = raw[t + 1], r2 = raw[t + 2];
                float a[8], bq[8], cq[8], y[8]; unpack8(r0, a); unpack8(r1, bq); unpack8(r2, cq);
#pragma unroll
                for (int e = 0; e < 8; ++e) { const float s = cw[0][e] * a[e] + cw[1][e] * bq[e] + cw[2][e] * cq[e]; y[e] = s * sigm(s); }
                if (seg < 2) {
                    float ss = 0.f;
#pragma unroll
                    for (int e = 0; e < 8; ++e) ss += y[e] * y[e];
                    const float r = rsqrtf(red8(ss) + EPSF);
#pragma unroll
                    for (int e = 0; e < 8; ++e) y[e] *= r;
                    if (lat) {
                        const int tok = t0 + t; const int pos = (j < 4) ? (tok >> 6) : (tok & 63);
                        f32x4 rtv[4];
#pragma unroll
                        for (int q4 = 0; q4 < 4; ++q4) rtv[q4] = *(const LAS f32x4*)(rt + (pos * 16 + 8 * (j & 1)) * 2 + 4 * q4);
#pragma unroll
                        for (int e = 0; e < 8; ++e) { const float cs = rtv[e >> 1][2 * (e & 1)], sn = rtv[e >> 1][2 * (e & 1) + 1]; const float pr = __shfl_xor(y[e], 2);
                            y[e] = (j & 2) ? (y[e] * cs + pr * sn) : (y[e] * cs - pr * sn); }
                    }
                    if (seg == 0) {
#pragma unroll
                        for (int e = 0; e < 8; ++e) y[e] *= 0.125f;
                    }
                }
                res[t] = pack8(y);
                *(u32x4*)(dst + ((size_t)bh * Tseq + t0 + t) * 64 + 8 * j) = res[t];
            }
            if (seg == 1) {
                u32x4 kt[8];
                tr8x8(res, kt);
                bf16* kd = lat ? (bf16*)(F.ws + WS_DKT) : (bf16*)(F.ws + WS_DKTC);
#pragma unroll
                for (int e = 0; e < 8; ++e) *(u32x4*)(kd + (((size_t)bh * (Tseq / 64) + t0 / 64) * 64 + 8 * j + e) * 64 + (t0 & 63)) = kt[e];
            }
        }
    }
}
__device__ __forceinline__ void step_chunk(int step, int dir, bool& lat, int& chunk) { if (step < 4) { lat = false; chunk = dir ? 3 - step : step; } else { lat = true; chunk = dir ? 131 - step : step - 4; } }
__host__ __device__ constexpr int tri_off(int i) { return i == 0 ? 0 : (8 * ((i - 1) >> 2) * (((i - 1) >> 2) + 1) + (i - 1 - 4 * ((i - 1) >> 2)) * 4 * (((i - 1) >> 2) + 1)); }
__host__ __device__ constexpr int tri_len(int i) { return i == 0 ? 0 : 4 * (((i - 1) >> 2) + 1); }
constexpr int TRI_FLOATS = 2176;
typedef float f32x2 __attribute__((ext_vector_type(2)));
template <int I> struct SubstRow {
    static __device__ __forceinline__ void run(f32x2 (&t2)[32], const LAS float* L, float lanef) {
        SubstRow<I - 1>::run(t2, L, lanef);
        f32x2 a0 = {0.f, 0.f}, a1 = {0.f, 0.f};
#pragma unroll
        for (int q = 0; q < tri_len(I) / 4; ++q) { const f32x4 lv = *(const LAS f32x4*)(L + tri_off(I) + 4 * q);
            a0 += (f32x2){lv[0], lv[1]} * t2[2 * q]; a1 += (f32x2){lv[2], lv[3]} * t2[2 * q + 1]; }
        const float s = fmaxf(0.f, 1.f - fabsf(lanef - (float)I)) - ((a0[0] + a0[1]) + (a1[0] + a1[1]));
        if (I & 1) t2[I >> 1][1] = s; else t2[I >> 1][0] = s;
        if ((I & 3) == 3) asm volatile("" ::: "memory");
    }
};
template <> struct SubstRow<-1> { static __device__ __forceinline__ void run(f32x2 (&)[32], const LAS float*, float) {} };
template <int I> struct SubstHalf {
    static __device__ __forceinline__ void run(f32x2 (&t2)[16], const LAS float* L, int hb, float ccf) {
        SubstHalf<I - 1>::run(t2, L, hb, ccf);
        f32x2 a0 = {0.f, 0.f}, a1 = {0.f, 0.f};
        const LAS float* row = L + (hb ? (tri_off(32 + I) + 32) : tri_off(I));
#pragma unroll
        for (int q = 0; q < tri_len(I) / 4; ++q) { const f32x4 lv = *(const LAS f32x4*)(row + 4 * q);
            a0 += (f32x2){lv[0], lv[1]} * t2[2 * q]; a1 += (f32x2){lv[2], lv[3]} * t2[2 * q + 1]; }
        const float s = fmaxf(0.f, 1.f - fabsf(ccf - (float)I)) - ((a0[0] + a0[1]) + (a1[0] + a1[1]));
        if (I & 1) t2[I >> 1][1] = s; else t2[I >> 1][0] = s;
        if ((I & 3) == 3) asm volatile("" ::: "memory");
    }
};
template <> struct SubstHalf<-1> { static __device__ __forceinline__ void run(f32x2 (&)[16], const LAS float*, int, float) {} };
constexpr int P4_WAVE_LDS = 16384, P4_T11 = 8704, P4_T22 = 8704 + 2048;

template <bool CTX> __device__ __forceinline__ void phase4(Ctx& F, const Args& A) {
    LAS float* Lt = (LAS float*)(F.lds + F.wave * P4_WAVE_LDS);
    LAS unsigned char* Wb = F.lds + F.wave * P4_WAVE_LDS;
    const float* BA = (const float*)(F.ws + WS_BA);
    for (int jt_ = CTX ? F.wave : F.gw; jt_ < (CTX ? 4 : 64 * 128); jt_ += (CTX ? 4 : F.NGW)) {
        const int id = CTX ? (int)blockIdx.x * NSTEP + jt_ : (jt_ >> 7) * NSTEP + 4 + (jt_ & 127);
        int l = F.lane; asm volatile("" : "+v"(l));
        const int g = l >> 4, i16 = l & 15;
        const int step = id % NSTEP, sd = id / NSTEP, dir = sd & 1, bh = sd >> 1, b = bh >> 3, h = bh & 7;
        bool lat; int chunk; step_chunk(step, dir, lat, chunk);
        const int tl = dir ? 63 - l : l;
        const int m = lat ? b * SEQ + chunk * 64 + tl : ML + b * CTXL + chunk * 64 + tl;
        const float braw = BA[(size_t)m * 32 + dir * 8 + h], araw = BA[(size_t)m * 32 + 16 + dir * 8 + h];
        const float beta = sigm(braw);
        const float xs = araw + A.in[13][dir * 8 + h];
        const float sp = (xs > 15.f) ? xs : log1pf(expf(xs));
        float gc = -expf(A.in[12][dir * 8 + h]) * sp;
#pragma unroll
        for (int o = 1; o < 64; o <<= 1) { const float v = __shfl_up(gc, o); if (l >= o) gc += v; }
        ((float*)(F.ws + WS_GC))[(size_t)id * 64 + tl] = gc;
        const bf16* Kt = lat ? (const bf16*)(F.ws + WS_DK) + ((size_t)bh * SEQ + chunk * 64) * 64 : (const bf16*)(F.ws + WS_DKC) + ((size_t)bh * CTXL + chunk * 64) * 64;
        bf16x8 Kf[4][2];
#pragma unroll
        for (int it = 0; it < 4; ++it)
#pragma unroll
            for (int kk = 0; kk < 2; ++kk) { const int li = 16 * it + i16; const int tk = dir ? 63 - li : li; Kf[it][kk] = *(const bf16x8*)(Kt + tk * 64 + 8 * g + 32 * kk); }
#pragma unroll
        for (int it = 0; it < 4; ++it) {
            float gci[4], bti[4];
#pragma unroll
            for (int r = 0; r < 4; ++r) { gci[r] = __shfl(gc, 16 * it + 4 * g + r); bti[r] = __shfl(beta, 16 * it + 4 * g + r); }
#pragma unroll
            for (int jt = 0; jt <= it; ++jt) {
                f32x4 a = {0.f, 0.f, 0.f, 0.f};
                a = MFMA16(Kf[it][0], Kf[jt][0], a); a = MFMA16(Kf[it][1], Kf[jt][1], a);
                const int jj = 16 * jt + i16; const float gcj = __shfl(gc, jj);
#pragma unroll
                for (int r = 0; r < 4; ++r) { const int ii = 16 * it + 4 * g + r; const int q = (ii - 1) >> 2; const int len = (ii == 0) ? 0 : 4 * (q + 1);
                    const int off = (ii == 0) ? 0 : (8 * q * (q + 1) + (ii - 1 - 4 * q) * 4 * (q + 1));
                    if (jj < len) Lt[off + jj] = (jj < ii) ? bti[r] * a[r] * __expf(gci[r] - gcj) : 0.f; }
            }
        }
        LDS_WAIT();
        const int hb = l >> 5, cc = l & 31;
        f32x2 t2[16];
#pragma unroll
        for (int q = 0; q < 16; ++q) t2[q] = (f32x2){0.f, 0.f};
        SubstHalf<31>::run(t2, Lt, hb, (float)cc);
        asm volatile("" ::: "memory");
        if (hb == 0) {
#pragma unroll
            for (int q = 0; q < 4; ++q) *(LAS u32x4*)(Wb + P4_T11 + cc * 64 + 16 * q) = (u32x4){pk2(t2[4 * q][0], t2[4 * q][1]), pk2(t2[4 * q + 1][0], t2[4 * q + 1][1]), pk2(t2[4 * q + 2][0], t2[4 * q + 2][1]), pk2(t2[4 * q + 3][0], t2[4 * q + 3][1])};
        } else {
#pragma unroll
            for (int i = 0; i < 32; ++i) *(LAS unsigned short*)(Wb + P4_T22 + (i * 32 + cc) * 2) = f2bf1(t2[i >> 1][i & 1]);
        }
        LDS_WAIT();
        f32x4 T21[2][2];
        {
            bf16x8 Af[2], Bf[2], A2[2];
#pragma unroll
            for (int mt = 0; mt < 2; ++mt) { const int ii = 32 + 16 * mt + i16; const int q = (ii - 1) >> 2; const int off = 8 * q * (q + 1) + (ii - 1 - 4 * q) * 4 * (q + 1);
                Af[mt] = pack_frag(*(const LAS f32x4*)(Lt + off + 8 * g), *(const LAS f32x4*)(Lt + off + 8 * g + 4));
                const u32x2 lo = *(const LAS u32x2*)(Wb + P4_T22 + ((16 * mt + i16) * 32 + 4 * g) * 2), hi = *(const LAS u32x2*)(Wb + P4_T22 + ((16 * mt + i16) * 32 + 16 + 4 * g) * 2);
                A2[mt] = __builtin_bit_cast(bf16x8, (u32x4){lo.x, lo.y, hi.x, hi.y}); }
#pragma unroll
            for (int nt = 0; nt < 2; ++nt) Bf[nt] = *(const LAS bf16x8*)(Wb + P4_T11 + (16 * nt + i16) * 64 + g * 16);
#pragma unroll
            for (int nt = 0; nt < 2; ++nt) {
                f32x4 x0 = {0.f, 0.f, 0.f, 0.f}, x1 = {0.f, 0.f, 0.f, 0.f};
                x0 = MFMA16(Af[0], Bf[nt], x0); x1 = MFMA16(Af[1], Bf[nt], x1);
                const bf16x8 xb = pack_frag(x0, x1);
                f32x4 z0 = {0.f, 0.f, 0.f, 0.f}, z1 = {0.f, 0.f, 0.f, 0.f};
                T21[0][nt] = MFMA16(A2[0], xb, z0); T21[1][nt] = MFMA16(A2[1], xb, z1);
            }
        }
        LDS_WAIT();
        LAS unsigned short* Tt = (LAS unsigned short*)Wb;
#pragma unroll
        for (int i = 0; i < 32; ++i) { const int ii = 32 * hb + i; const int ti = dir ? 63 - ii : ii; Tt[ti * 64 + tl] = f2bf1(t2[i >> 1][i & 1] * beta); }
        if (hb) {
#pragma unroll
            for (int i = 0; i < 32; ++i) { const int ti = dir ? 63 - i : i; Tt[ti * 64 + tl] = (unsigned short)0; }
        }
#pragma unroll
        for (int nt = 0; nt < 2; ++nt) { const int jj = 16 * nt + i16; const float bj = __shfl(beta, jj); const int tj = dir ? 63 - jj : jj;
#pragma unroll
            for (int mt = 0; mt < 2; ++mt)
#pragma unroll
                for (int r = 0; r < 4; ++r) { const int ii = 32 + 16 * mt + 4 * g + r; const int ti = dir ? 63 - ii : ii; Tt[ti * 64 + tj] = f2bf1(-T21[mt][nt][r] * bj); } }
        LDS_WAIT();
        u32x4* TBg = (u32x4*)((bf16*)(F.ws + WS_TB) + (size_t)id * 4096);
#pragma unroll
        for (int k = 0; k < 8; ++k) TBg[l + 64 * k] = *(const LAS u32x4*)(Wb + (l + 64 * k) * 16);
        LDS_WAIT();
    }
    if (CTX) asm volatile("s_waitcnt vmcnt(0)" ::: "memory");
}
constexpr int NA_KC = 16384, NA_VC = 53248;
__device__ __forceinline__ void phase_na(Ctx& F, const Args& A, int nb, int nblk) {
    const int l = F.lane, g = l >> 4, i16 = l & 15;
    LAS float* rp = (LAS float*)F.lds;
    for (int i = F.tid; i < 8 * 465; i += NTHREADS) rp[i] = A.in[11][i];
    float mq = fabsf(A.in[9][l]), mk = fabsf(A.in[10][l]), mr = 0.f;
    for (int i = l; i < 8 * 465; i += 64) mr = fmaxf(mr, fabsf(A.in[11][i]));
#pragma unroll
    for (int o = 1; o < 64; o <<= 1) { mq = fmaxf(mq, __shfl_xor(mq, o)); mk = fmaxf(mk, __shfl_xor(mk, o)); mr = fmaxf(mr, __shfl_xor(mr, o)); }
    const float mb = 8.0f * mq * mk + mr;
    __syncthreads();
    bf16* Q = (bf16*)(F.dout + DO_Q); const bf16* Kn = (const bf16*)(F.ws + WS_NAK); const bf16* ZNA = (const bf16*)(F.ws + WS_ZNA);
    const u32x4* VTL = (const u32x4*)(F.dout + DO_VT8); const u32x4* VTC = (const u32x4*)(F.ws + WS_VT8C);
    const int key0 = 8 * (i16 >> 2) + (i16 & 3);
    const int swc = 4 * (i16 >> 3);
    int cur_bh = -1;
    for (int grp = nb * 1024 / nblk; grp < (nb + 1) * 1024 / nblk; ++grp) {
        const int task = grp * 8 + F.wave;
        const int jq = task & 3, rp2 = (task >> 2) & 63, bh = task >> 8, b = bh >> 3, h = bh & 7;
        if (bh != cur_bh) {
            __syncthreads();
#pragma unroll
            for (int k = 0; k < 4; ++k) { const int ci = F.tid + 512 * k; const int key = ci >> 3, p = ci & 7;
                *(LAS u32x4*)(F.lds + NA_KC + key * 144 + ((p ^ (4 * ((key >> 4) & 1))) * 16)) = *(const u32x4*)(Kn + ((size_t)ML + b * CTXL + key) * 512 + h * 64 + 8 * p);
                *(LAS u32x4*)(F.lds + NA_VC + ci * 16) = VTC[(size_t)bh * (CTXL / 8) * 64 + ci]; }
            __syncthreads();
            cur_bh = bh;
        }
        const int q0 = 16 * jq, kc0 = (jq == 0) ? 0 : ((jq == 1) ? 8 : ((jq == 2) ? 24 : 32));
        const int ra = 2 * rp2, rb = ra + 1;
        const int r0a = min(max(ra - 4, 0), 120), r0b = min(max(rb - 4, 0), 120);
        const size_t mrow_a = (size_t)b * SEQ + ra * 64 + q0 + i16, mrow_b = mrow_a + 64;
        bf16x8 Qa[2], Qb[2];
#pragma unroll
        for (int kk = 0; kk < 2; ++kk) { Qa[kk] = *(const bf16x8*)(Q + mrow_a * 512 + h * 64 + 8 * g + 32 * kk); Qb[kk] = *(const bf16x8*)(Q + mrow_b * 512 + h * 64 + 8 * g + 32 * kk); }
        const int cq = q0 + i16, c0 = min(max(cq - 8, 0), 48);
        f32x4 Oa[4], Ob[4]; float lsa = 0.f, lsb = 0.f;
#pragma unroll
        for (int dt = 0; dt < 4; ++dt) { Oa[dt] = (f32x4){0.f, 0.f, 0.f, 0.f}; Ob[dt] = (f32x4){0.f, 0.f, 0.f, 0.f}; }
        const LAS float* rph = rp + h * 465;
        bool ok0[4], ok1[4]; int dx0[4], dx1[4];
#pragma unroll
        for (int rr = 0; rr < 4; ++rr) { const int ck0 = kc0 + 8 * g + rr, ck1 = ck0 + 4; ok0[rr] = (ck0 >= c0 && ck0 < c0 + 16); ok1[rr] = (ck1 >= c0 && ck1 < c0 + 16);
            dx0[rr] = min(max(ck0 - cq, -15), 15) + 15; dx1[rr] = min(max(ck1 - cq, -15), 15) + 15; }
#pragma unroll 3
        for (int y = 0; y < 9; ++y) {
            const int trow = r0a + y;
            if (trow >= r0b + 8) break;
            const size_t tk0 = (size_t)b * SEQ + trow * 64 + kc0;
            const bf16* kp = Kn + (tk0 + key0) * 512 + h * 64 + 8 * g;
            const bf16x8 ka0 = *(const bf16x8*)(kp), ka1 = *(const bf16x8*)(kp + 32), kb0 = *(const bf16x8*)(kp + 4 * 512), kb1 = *(const bf16x8*)(kp + 4 * 512 + 32);
            const u32x4* vp = VTL + ((size_t)bh * (SEQ / 8) + (trow * 64 + kc0) / 8 + g) * 64 + i16;
            bf16x8 vf[4];
#pragma unroll
            for (int dt = 0; dt < 4; ++dt) vf[dt] = __builtin_bit_cast(bf16x8, vp[16 * dt]);
            if (trow < r0a + 8) {
                f32x4 s0 = {0.f, 0.f, 0.f, 0.f}, s1 = {0.f, 0.f, 0.f, 0.f};
                s0 = MFMA16(ka0, Qa[0], s0); s0 = MFMA16(ka1, Qa[1], s0); s1 = MFMA16(kb0, Qa[0], s1); s1 = MFMA16(kb1, Qa[1], s1);
                const LAS float* rrow = rph + (trow - ra + 7) * 31;
#pragma unroll
                for (int rr = 0; rr < 4; ++rr) { const float p0 = ok0[rr] ? __expf(s0[rr] + rrow[dx0[rr]] - mb) : 0.f, p1 = ok1[rr] ? __expf(s1[rr] + rrow[dx1[rr]] - mb) : 0.f; s0[rr] = p0; s1[rr] = p1; lsa += p0 + p1; }
                const bf16x8 pf = pack_frag(s0, s1);
#pragma unroll
                for (int dt = 0; dt < 4; ++dt) Oa[dt] = MFMA16(vf[dt], pf, Oa[dt]);
            }
            if (trow >= r0b) {
                f32x4 s0 = {0.f, 0.f, 0.f, 0.f}, s1 = {0.f, 0.f, 0.f, 0.f};
                s0 = MFMA16(ka0, Qb[0], s0); s0 = MFMA16(ka1, Qb[1], s0); s1 = MFMA16(kb0, Qb[0], s1); s1 = MFMA16(kb1, Qb[1], s1);
                const LAS float* rrow = rph + (trow - rb + 7) * 31;
#pragma unroll
                for (int rr = 0; rr < 4; ++rr) { const float p0 = ok0[rr] ? __expf(s0[rr] + rrow[dx0[rr]] - mb) : 0.f, p1 = ok1[rr] ? __expf(s1[rr] + rrow[dx1[rr]] - mb) : 0.f; s0[rr] = p0; s1[rr] = p1; lsb += p0 + p1; }
                const bf16x8 pf = pack_frag(s0, s1);
#pragma unroll
                for (int dt = 0; dt < 4; ++dt) Ob[dt] = MFMA16(vf[dt], pf, Ob[dt]);
            }
        }
#pragma unroll 2
        for (int cb = 0; cb < 8; ++cb) {
            const LAS unsigned char* kp = F.lds + NA_KC + (cb * 32 + key0) * 144;
            const bf16x8 ka0 = *(const LAS bf16x8*)(kp + ((g ^ swc) * 16)), ka1 = *(const LAS bf16x8*)(kp + (((g + 4) ^ swc) * 16)), kb0 = *(const LAS bf16x8*)(kp + 4 * 144 + ((g ^ swc) * 16)), kb1 = *(const LAS bf16x8*)(kp + 4 * 144 + (((g + 4) ^ swc) * 16));
            bf16x8 vf[4];
#pragma unroll
            for (int dt = 0; dt < 4; ++dt) vf[dt] = *(const LAS bf16x8*)(F.lds + NA_VC + ((cb * 4 + g) * 64 + 16 * dt + i16) * 16);
            {   f32x4 s0 = {0.f, 0.f, 0.f, 0.f}, s1 = {0.f, 0.f, 0.f, 0.f};
                s0 = MFMA16(ka0, Qa[0], s0); s0 = MFMA16(ka1, Qa[1], s0); s1 = MFMA16(kb0, Qa[0], s1); s1 = MFMA16(kb1, Qa[1], s1);
#pragma unroll
                for (int rr = 0; rr < 4; ++rr) { const float p0 = __expf(s0[rr] - mb), p1 = __expf(s1[rr] - mb); s0[rr] = p0; s1[rr] = p1; lsa += p0 + p1; }
                const bf16x8 pf = pack_frag(s0, s1);
#pragma unroll
                for (int dt = 0; dt < 4; ++dt) Oa[dt] = MFMA16(vf[dt], pf, Oa[dt]); }
            {   f32x4 s0 = {0.f, 0.f, 0.f, 0.f}, s1 = {0.f, 0.f, 0.f, 0.f};
                s0 = MFMA16(ka0, Qb[0], s0); s0 = MFMA16(ka1, Qb[1], s0); s1 = MFMA16(kb0, Qb[0], s1); s1 = MFMA16(kb1, Qb[1], s1);
#pragma unroll
                for (int rr = 0; rr < 4; ++rr) { const float p0 = __expf(s0[rr] - mb), p1 = __expf(s1[rr] - mb); s0[rr] = p0; s1[rr] = p1; lsb += p0 + p1; }
                const bf16x8 pf = pack_frag(s0, s1);
#pragma unroll
                for (int dt = 0; dt < 4; ++dt) Ob[dt] = MFMA16(vf[dt], pf, Ob[dt]); }
        }
        lsa += __shfl_xor(lsa, 16); lsa += __shfl_xor(lsa, 32); lsb += __shfl_xor(lsb, 16); lsb += __shfl_xor(lsb, 32);
        const float inva = 1.0f / lsa, invb = 1.0f / lsb;
#pragma unroll
        for (int dt = 0; dt < 4; ++dt) {
            const size_t offa = mrow_a * 512 + h * 64 + 16 * dt + 4 * g, offb = mrow_b * 512 + h * 64 + 16 * dt + 4 * g; const u32x2 za = *(const u32x2*)(ZNA + offa), zb = *(const u32x2*)(ZNA + offb);
            *(u32x2*)(Q + offa) = (u32x2){pk2(Oa[dt][0] * inva * blo(za.x), Oa[dt][1] * inva * bhi(za.x)), pk2(Oa[dt][2] * inva * blo(za.y), Oa[dt][3] * inva * bhi(za.y))};
            *(u32x2*)(Q + offb) = (u32x2){pk2(Ob[dt][0] * invb * blo(zb.x), Ob[dt][1] * invb * bhi(zb.x)), pk2(Ob[dt][2] * invb * blo(zb.y), Ob[dt][3] * invb * bhi(zb.y))}; }
    }
}
constexpr int TOUCH_AHEAD = 1000;
constexpr int SROW = 144;
constexpr int SM_K = 0, SM_KT = 9216, SM_Q = 18432, SM_V = 27648, SM_TB = 36864, SM_QK = 46080, SM_EG = 55296, SM_ED = 55552, SM_GR = 55872, SM_O = 56320, SM_STAGE = 65536;
__device__ __forceinline__ int rowmap(int tau, int g, int r) { return 32 * (tau >> 1) + 8 * g + 4 * (tau & 1) + r; }
#ifdef BAR2X
#define SCAN_BAR() do { asm volatile("s_waitcnt lgkmcnt(0)" ::: "memory"); __builtin_amdgcn_s_barrier(); asm volatile("" ::: "memory"); __builtin_amdgcn_s_barrier(); asm volatile("" ::: "memory"); __builtin_amdgcn_s_barrier(); asm volatile("" ::: "memory"); } while (0)
#else
#define SCAN_BAR() do { asm volatile("s_waitcnt lgkmcnt(0)" ::: "memory"); __builtin_amdgcn_s_barrier(); asm volatile("" ::: "memory"); } while (0)
#endif
__device__ __forceinline__ void phase_scan(Ctx& F, const Args& A) {
    const int l = F.lane, g = l >> 4, i16 = l & 15, w = F.wave, tid = F.tid;
    const int sd = blockIdx.x, dir = sd & 1, bh = sd >> 1, b = bh >> 3, h = bh & 7;
    const float* GC = (const float*)(F.ws + WS_GC) + (size_t)sd * NSTEP * 64;
    const bf16* TBg = (const bf16*)(F.ws + WS_TB) + (size_t)sd * NSTEP * 4096;
    if (w < 4) {
        bf16* OD = (bf16*)(F.dout + (dir ? DO_OB : DO_OF));
        f32x4 S[4]; bf16x8 Sb[2];
#pragma unroll
        for (int t = 0; t < 4; ++t) S[t] = (f32x4){0.f, 0.f, 0.f, 0.f};
        Sb[0] = (bf16x8){0, 0, 0, 0, 0, 0, 0, 0}; Sb[1] = Sb[0];
        const int vc = 16 * w + i16;
        const int sw = 4 * (i16 >> 3), swv = 4 * (g >> 1);
        int arow[4];
#pragma unroll
        for (int tau = 0; tau < 4; ++tau) arow[tau] = 32 * (tau >> 1) + 8 * (i16 >> 2) + 4 * (tau & 1) + (i16 & 3);
        SCAN_BAR();
        for (int step = 0; step < NSTEP; ++step) {
            LAS unsigned char* sb = F.lds + (step & 1) * SM_STAGE;
            bool lat; int chunk; step_chunk(step, dir, lat, chunk);
            {
                const int ts = step + TOUCH_AHEAD;
                if (ts < NSTEP) {
                    bool tlat; int tch; step_chunk(ts, dir, tlat, tch);
                    const char* p0; const char* p1;
                    if (w == 0) { p0 = tlat ? (const char*)((const bf16*)(F.ws + WS_DK) + ((size_t)bh * SEQ + tch * 64) * 64) : (const char*)((const bf16*)(F.ws + WS_DKC) + ((size_t)bh * CTXL + tch * 64) * 64);
                                  p1 = tlat ? (const char*)((const bf16*)(F.ws + WS_DKT) + ((size_t)bh * 128 + tch) * 4096) : (const char*)((const bf16*)(F.ws + WS_DKTC) + ((size_t)bh * 4 + tch) * 4096); }
                    else if (w == 1) { p0 = tlat ? (const char*)((const bf16*)(F.ws + WS_DV) + ((size_t)bh * SEQ + tch * 64) * 64) : (const char*)((const bf16*)(F.ws + WS_DVC) + ((size_t)bh * CTXL + tch * 64) * 64);
                                       p1 = (const char*)((const bf16*)(F.ws + WS_DQ) + ((size_t)bh * SEQ + (tlat ? tch : 0) * 64) * 64); }
                    else { p0 = (const char*)(TBg + (size_t)ts * 4096); p1 = (const char*)(GC + ts * 64) - (size_t)(l >= 2 ? (l - 1) * 128 : 0); }
                    if (w < 3) { const char* q0 = p0 + l * 128; const char* q1 = p1 + l * 128;
                        asm volatile("global_load_dword v250, %0, off\n\tglobal_load_dword v251, %1, off" :: "v"(q0), "v"(q1) : "v250", "v251", "memory"); }
                }
            }
            const LAS float* EG = (const LAS float*)(sb + SM_EG); const LAS float* ED = (const LAS float*)(sb + SM_ED);
            const float gtot = ED[64];
            f32x4 X[4], VN[4], eg[4], ed[4];
#pragma unroll
            for (int tau = 0; tau < 4; ++tau) { eg[tau] = *(const LAS f32x4*)(EG + rowmap(tau, g, 0)); ed[tau] = *(const LAS f32x4*)(ED + rowmap(tau, g, 0)); }
#define LDSA(mat, row, kk) (*(const LAS bf16x8*)(sb + (mat) + (row) * SROW + (((g + 4 * (kk)) ^ sw) * 16)))
#pragma unroll
            for (int tau = 0; tau < 4; ++tau) { f32x4 a = {0.f, 0.f, 0.f, 0.f}; a = MFMA16(LDSA(SM_K, arow[tau], 0), Sb[0], a); a = MFMA16(LDSA(SM_K, arow[tau], 1), Sb[1], a);
#pragma unroll
                for (int r = 0; r < 4; ++r) { const int t = rowmap(tau, g, r); const float v = bf1(*(const LAS unsigned short*)(sb + SM_V + t * SROW + (((vc >> 3) ^ swv) * 16) + (vc & 7) * 2)); a[r] = v - eg[tau][r] * a[r]; }
                X[tau] = a; }
            bf16x8 Rb[2]; Rb[0] = pack_frag(X[0], X[1]); Rb[1] = pack_frag(X[2], X[3]);
#ifdef CHAIN2X
            { f32x4 D[4];
#pragma unroll
              for (int rep = 0; rep < 3; ++rep) {
#pragma unroll
                for (int tau = 0; tau < 4; ++tau) { f32x4 a = {0.f, 0.f, 0.f, 0.f}; a = MFMA16(LDSA(SM_K, arow[tau], 0), rep ? pack_frag(D[0], D[1]) : Sb[0], a); a = MFMA16(LDSA(SM_K, arow[tau], 1), Sb[1], a); D[tau] = a; }
              }
              asm volatile("" :: "v"(D[0]), "v"(D[1]), "v"(D[2]), "v"(D[3])); }
#endif
#pragma unroll
            for (int tau = 0; tau < 4; ++tau) { f32x4 a = {0.f, 0.f, 0.f, 0.f}; a = MFMA16(LDSA(SM_TB, arow[tau], 0), Rb[0], a); a = MFMA16(LDSA(SM_TB, arow[tau], 1), Rb[1], a); VN[tau] = a; }
            bf16x8 Vb[2], Vs[2]; Vb[0] = pack_frag(VN[0], VN[1]); Vb[1] = pack_frag(VN[2], VN[3]);
            Vs[0] = pack_frag(VN[0] * ed[0], VN[1] * ed[1]); Vs[1] = pack_frag(VN[2] * ed[2], VN[3] * ed[3]);
#pragma unroll
            for (int tau = 0; tau < 4; ++tau) { f32x4 a = S[tau] * gtot; a = MFMA16(LDSA(SM_KT, arow[tau], 0), Vs[0], a); a = MFMA16(LDSA(SM_KT, arow[tau], 1), Vs[1], a); S[tau] = a; }
            SCAN_BAR();
            if (lat) {
#pragma unroll
                for (int tau = 0; tau < 4; ++tau) { f32x4 a = {0.f, 0.f, 0.f, 0.f}; a = MFMA16(LDSA(SM_Q, arow[tau], 0), Sb[0], a); a = MFMA16(LDSA(SM_Q, arow[tau], 1), Sb[1], a);
                    a = a * eg[tau]; a = MFMA16(LDSA(SM_QK, arow[tau], 0), Vb[0], a); a = MFMA16(LDSA(SM_QK, arow[tau], 1), Vb[1], a);
#pragma unroll
                    for (int r = 0; r < 4; ++r) { const int t = rowmap(tau, g, r); *(LAS unsigned short*)(sb + SM_O + t * SROW + vc * 2) = f2bf1(a[r]); } }
            }
            Sb[0] = pack_frag(S[0], S[1]); Sb[1] = pack_frag(S[2], S[3]);
#undef LDSA
            SCAN_BAR();
        }
    } else {
        const int sw_ = w - 4, stid = tid - 256;
        const int tq = 16 * sw_ + i16;
        u32x4 st[5][2]; float sgc = 0.f, sgl = 0.f;
        bf16* OD = (bf16*)(F.dout + (dir ? DO_OB : DO_OF));
        auto issue = [&](int step) {
            if (step >= NSTEP) return;
            bool lat; int chunk; step_chunk(step, dir, lat, chunk);
            const u32x4* pk = lat ? (const u32x4*)((const bf16*)(F.ws + WS_DK) + ((size_t)bh * SEQ + chunk * 64) * 64) : (const u32x4*)((const bf16*)(F.ws + WS_DKC) + ((size_t)bh * CTXL + chunk * 64) * 64);
            const u32x4* pkt = lat ? (const u32x4*)((const bf16*)(F.ws + WS_DKT) + ((size_t)bh * 128 + chunk) * 4096) : (const u32x4*)((const bf16*)(F.ws + WS_DKTC) + ((size_t)bh * 4 + chunk) * 4096);
            const u32x4* pv = lat ? (const u32x4*)((const bf16*)(F.ws + WS_DV) + ((size_t)bh * SEQ + chunk * 64) * 64) : (const u32x4*)((const bf16*)(F.ws + WS_DVC) + ((size_t)bh * CTXL + chunk * 64) * 64);
            const u32x4* pq = (const u32x4*)((const bf16*)(F.ws + WS_DQ) + ((size_t)bh * SEQ + (lat ? chunk : 0) * 64) * 64);
            const u32x4* pt = (const u32x4*)(TBg + (size_t)step * 4096);
#pragma unroll
            for (int k = 0; k < 2; ++k) { const int ci = stid + 256 * k; st[0][k] = pk[ci]; st[1][k] = pkt[ci]; st[3][k] = pv[ci]; st[4][k] = pt[ci]; st[2][k] = lat ? pq[ci] : (u32x4){0u, 0u, 0u, 0u}; }
            if (stid < 64) { sgc = GC[step * 64 + stid]; sgl = GC[step * 64 + (dir ? 0 : 63)]; }
        };
        auto commit = [&](int step) {
            if (step >= NSTEP) return;
            LAS unsigned char* sb = F.lds + (step & 1) * SM_STAGE;
#pragma unroll
            for (int k = 0; k < 2; ++k) { const int ci = stid + 256 * k; const int sdst = (ci >> 3) * SROW + (((ci & 7) ^ (4 * ((ci >> 7) & 1))) * 16);
                *(LAS u32x4*)(sb + SM_K + sdst) = st[0][k]; *(LAS u32x4*)(sb + SM_KT + sdst) = st[1][k]; *(LAS u32x4*)(sb + SM_Q + sdst) = st[2][k]; *(LAS u32x4*)(sb + SM_V + sdst) = st[3][k]; *(LAS u32x4*)(sb + SM_TB + sdst) = st[4][k]; }
            if (stid < 64) { ((LAS float*)(sb + SM_EG))[stid] = __expf(sgc); ((LAS float*)(sb + SM_ED))[stid] = __expf(sgl - sgc); ((LAS float*)(sb + SM_GR))[stid] = sgc; if (stid == 0) ((LAS float*)(sb + SM_ED))[64] = __expf(sgl); }
        };
        auto qkm = [&](int step) {
            if (step < 4) return;
            LAS unsigned char* sb = F.lds + (step & 1) * SM_STAGE;
            const LAS float* GR = (const LAS float*)(sb + SM_GR);
            const int swk = 4 * (i16 >> 3), swq = 4 * ((tq >> 4) & 1);
            const bf16x8 q0 = *(const LAS bf16x8*)(sb + SM_Q + tq * SROW + ((g ^ swq) * 16)), q1 = *(const LAS bf16x8*)(sb + SM_Q + tq * SROW + (((g + 4) ^ swq) * 16));
            const float gct = GR[tq];
#pragma unroll
            for (int kk = 0; kk < 2; ++kk) {
                f32x4 a[2];
#pragma unroll
                for (int hf = 0; hf < 2; ++hf) { const int tau = 2 * kk + hf; const int tr = 32 * (tau >> 1) + 8 * (i16 >> 2) + 4 * (tau & 1) + (i16 & 3);
                    const bf16x8 k0 = *(const LAS bf16x8*)(sb + SM_K + tr * SROW + ((g ^ swk) * 16)), k1 = *(const LAS bf16x8*)(sb + SM_K + tr * SROW + (((g + 4) ^ swk) * 16));
                    const f32x4 gk = *(const LAS f32x4*)(GR + rowmap(tau, g, 0));
                    f32x4 s = {0.f, 0.f, 0.f, 0.f}; s = MFMA16(k0, q0, s); s = MFMA16(k1, q1, s);
#pragma unroll
                    for (int r = 0; r < 4; ++r) { const int tp = rowmap(tau, g, r); const bool ok = dir ? (tq <= tp) : (tq >= tp); s[r] = ok ? s[r] * __expf(gct - gk[r]) : 0.f; }
                    a[hf] = s; }
                *(LAS bf16x8*)(sb + SM_QK + tq * SROW + (((4 * kk + g) ^ swq) * 16)) = pack_frag(a[0], a[1]);
            }
        };
        auto flush_o = [&](int step) {
            if (step < 4 || step >= NSTEP) return;
            const int chunk = dir ? 131 - step : step - 4;
            LAS unsigned char* sb = F.lds + (step & 1) * SM_STAGE;
#pragma unroll
            for (int k = 0; k < 2; ++k) { const int ci = stid + 256 * k; const int t = ci >> 3, p = ci & 7;
                *(u32x4*)(OD + ((size_t)b * SEQ + chunk * 64 + t) * 512 + h * 64 + 8 * p) = *(const LAS u32x4*)(sb + SM_O + t * SROW + p * 16); }
        };
        issue(0); commit(0); issue(1);
        SCAN_BAR();
        for (int n = 0; n < NSTEP; ++n) {
            qkm(n);
            SCAN_BAR();
            flush_o(n - 1); commit(n + 1); issue(n + 2);
            SCAN_BAR();
        }
        flush_o(NSTEP - 1);
    }
}
__device__ __forceinline__ void phase_mp(Ctx& F, const Args& A) {
    const int l = F.lane, j = l & 7;
    bf16* OF = (bf16*)(F.dout + DO_OF); const bf16* OB = (const bf16*)(F.dout + DO_OB); const bf16* ZDN = (const bf16*)(F.ws + WS_ZDN);
    float w8[8];
#pragma unroll
    for (int e = 0; e < 8; ++e) w8[e] = A.in[14][8 * j + e];
#pragma unroll 4
    for (int m = F.gw; m < ML; m += F.NGW) {
        const size_t off = (size_t)m * 512 + 8 * l; float a[8], bq[8], z[8]; unpack8(*(const u32x4*)(OF + off), a); unpack8(*(const u32x4*)(OB + off), bq); unpack8(*(const u32x4*)(ZDN + off), z);
        float ss = 0.f;
#pragma unroll
        for (int e = 0; e < 8; ++e) { a[e] += bq[e]; ss += a[e] * a[e]; }
        const float r = rsqrtf(red8(ss) * (1.f / 64.f) + EPSF);
#pragma unroll
        for (int e = 0; e < 8; ++e) a[e] = a[e] * r * w8[e] * z[e];
        *(u32x4*)(OF + off) = pack8(a);
    }
}
constexpr size_t WS_CTL = 65536, CTL_BYTES = 32768;
constexpr int LDS_MISC = 131072;
#define XB_TMO      128
#define XB_XCNT(j)  (256  + 64 * (j))
#define XB_XSUB(j)  (1280 + 64 * (j))
#define XB_XGEN(j)  (2304 + 64 * (j))
#define XB_TOP      3328
#define XB_TOPGEN   3392
#define XCD_BAR_WORDS 3456
#define XB_SPIN_CAP (1u << 18)

__device__ __forceinline__ unsigned xb_ld(unsigned* p)              { return __hip_atomic_load(p, __ATOMIC_RELAXED, __HIP_MEMORY_SCOPE_AGENT); }
__device__ __forceinline__ unsigned xb_add(unsigned* p, unsigned v) { return __hip_atomic_fetch_add(p, v, __ATOMIC_RELAXED, __HIP_MEMORY_SCOPE_AGENT); }
__device__ __forceinline__ unsigned xb_xcc_id() { return (unsigned)__builtin_amdgcn_s_getreg((3 << 11) | 20) & 0xFu; }
#define XB_SPIN(cond, bar) do { unsigned _sp = 0; while (cond) { __builtin_amdgcn_s_sleep(1); \
    if ((++_sp & 255u) == 0u) { if (xb_ld(&(bar)[XB_TMO])) break; if (_sp > XB_SPIN_CAP) { atomicAdd(&(bar)[XB_TMO], 1u); break; } } } } while (0)

struct XcdBarrier {
    unsigned G;
    unsigned* bar; unsigned x;
    volatile LAS unsigned* st;
};

__device__ __forceinline__ XcdBarrier xcd_barrier_post(unsigned* bar, volatile LAS unsigned* st, unsigned G) {
    XcdBarrier b; b.G = G; b.bar = bar; b.x = xb_xcc_id(); b.st = st;
    if (threadIdx.x == 0) (void)xb_add(&bar[XB_XCNT(b.x)], 1u);
    return b;
}
__device__ __forceinline__ void xcd_barrier_complete(unsigned* bar, unsigned x, unsigned G, unsigned& nloc, unsigned& nx) {
    unsigned sum, cnt, mine, sp = 0u;
    for (;;) {
        sum = 0u; cnt = 0u; mine = 0u;
#pragma unroll
        for (unsigned j = 0; j < 16; ++j) { const unsigned c = xb_ld(&bar[XB_XCNT(j)]); sum += c; cnt += (c > 0u) ? 1u : 0u; mine = (j == x) ? c : mine; }
        if (sum == G) break;
        __builtin_amdgcn_s_sleep(1);
        if ((++sp & 255u) == 0u) { if (xb_ld(&bar[XB_TMO])) break; if (sp > XB_SPIN_CAP) { atomicAdd(&bar[XB_TMO], 1u); break; } }
    }
    nloc = mine > 0u ? mine : 1u; nx = cnt > 0u ? cnt : 1u;
}

__device__ __forceinline__ void xcd_barrier(const XcdBarrier& b) {
    asm volatile("s_waitcnt vmcnt(0)" ::: "memory");
    __syncthreads();
    if (threadIdx.x == 0) {
        unsigned* bar = b.bar;
        __builtin_amdgcn_s_waitcnt(0);
        unsigned nloc = b.st[0], nx = b.st[1];
        if (nloc == 0u) { xcd_barrier_complete(bar, b.x, b.G, nloc, nx); b.st[0] = nloc; b.st[1] = nx; }
        const unsigned old = xb_add(&bar[XB_XSUB(b.x)], 1u);
        const unsigned gen = old / nloc;
        if (old + 1u == (gen + 1u) * nloc) {
            __builtin_amdgcn_fence(__ATOMIC_RELEASE, "agent");
            asm volatile("s_waitcnt vmcnt(0)" ::: "memory");
            const unsigned og = xb_add(&bar[XB_TOP], 1u);
            const unsigned tg = og / nx;
            if (og + 1u == (tg + 1u) * nx) xb_add(&bar[XB_TOPGEN], 1u);
            else XB_SPIN(xb_ld(&bar[XB_TOPGEN]) == tg, bar);
            __builtin_amdgcn_fence(__ATOMIC_ACQUIRE, "agent");
            xb_add(&bar[XB_XGEN(b.x)], 1u);
            asm volatile("s_waitcnt vmcnt(0)" ::: "memory");
        } else {
            XB_SPIN(xb_ld(&bar[XB_XGEN(b.x)]) == gen, bar);
            __builtin_amdgcn_fence(__ATOMIC_ACQUIRE, "agent");
            asm volatile("s_waitcnt vmcnt(0)" ::: "memory");
        }
    }
    __syncthreads();
}

struct ShadowOrder {
    int c, G;
    __device__ void init(int G_, int c_) { G = G_; c = c_; }
    __device__ bool next(int i, pg8::Unit& u) const {
        if ((G & 7) != 0) { const long L = (long)i * G + c; if (L >= 512) return false; u.pm = (int)(L >> 2); u.pn = (int)(L & 3); return true; }
        const int per = G >> 3, xcd = c & 7, j = c >> 3, w = i * per + j;
        if (w >= 64) return false;
        u.pm = 16 * xcd + (w >> 2); u.pn = w & 3; return true;
    }
    __device__ __forceinline__ void a_ready(const pg8::Unit&) const {}
    __device__ __forceinline__ void done(const pg8::Unit&) const {}
};
constexpr size_t WS_CNT_PB = 65536 + 15616, WS_CNT_PA = 65536 + 15872, WS_CNT_P4 = 65536 + 16128;
__device__ __forceinline__ void seam_arrive(unsigned char* ws, size_t word) {
    asm volatile("s_waitcnt vmcnt(0)" ::: "memory");
    __syncthreads();
    if (threadIdx.x == 0) { __builtin_amdgcn_fence(__ATOMIC_RELEASE, "agent"); asm volatile("s_waitcnt vmcnt(0)" ::: "memory");
        __hip_atomic_fetch_add((unsigned*)(ws + word), 1u, __ATOMIC_RELAXED, __HIP_MEMORY_SCOPE_AGENT); }
}
__device__ __forceinline__ void seam_wait(unsigned char* ws, size_t word, unsigned want) {
    if (threadIdx.x == 0) { unsigned sp = 0u;
        while (__hip_atomic_load((unsigned*)(ws + word), __ATOMIC_RELAXED, __HIP_MEMORY_SCOPE_AGENT) < want) { __builtin_amdgcn_s_sleep(2); if (++sp > (1u << 20)) break; }
        __builtin_amdgcn_fence(__ATOMIC_ACQUIRE, "agent"); asm volatile("s_waitcnt vmcnt(0)" ::: "memory"); }
    __syncthreads();
}
#ifdef TPROBE
#define STAMP(k) do { if (blockIdx.x == 0 && threadIdx.x == 0) ((volatile LAS unsigned long long*)(F.lds + LDS_MISC + 64))[k] = __builtin_amdgcn_s_memrealtime(); } while (0)
#else
#define STAMP(k) do {} while (0)
#endif
#define REFRESH(F) do { int t_ = threadIdx.x; asm volatile("" : "+v"(t_)); (F).tid = t_; (F).lane = t_ & 63; } while (0)
__global__ void __launch_bounds__(NTHREADS, 2) fwd_kernel(Args args) {
    extern __shared__ __attribute__((aligned(16))) unsigned char lds_raw[];
    cg::grid_group grid = cg::this_grid();
    Ctx F;
    F.lds = (LAS unsigned char*)lds_raw; F.tid = threadIdx.x; F.lane = F.tid & 63; F.wave = __builtin_amdgcn_readfirstlane(F.tid >> 6);
    F.G = gridDim.x; F.gw = blockIdx.x * NWAVES + F.wave; F.NGW = F.G * NWAVES;
    F.ws = args.ws; F.dout = (unsigned char*)args.out;
    unsigned char* ws = args.ws;
    if (F.tid < 8) ((volatile LAS unsigned*)(F.lds + LDS_MISC))[F.tid] = 0u;
    __syncthreads();
    const XcdBarrier bar = xcd_barrier_post((unsigned*)(ws + WS_CTL), (volatile LAS unsigned*)(F.lds + LDS_MISC), gridDim.x);
    XcdBarrier bar2 = bar;
    if (blockIdx.x >= 64) bar2 = xcd_barrier_post((unsigned*)(ws + WS_CTL + 16384), (volatile LAS unsigned*)(F.lds + LDS_MISC + 16), gridDim.x - 64);
    STAMP(0);

#ifndef SK0
    REFRESH(F); phase0(F, args);
#endif
    if (args.ws == nullptr) grid.sync();
    if (threadIdx.x == 0) {
        unsigned* cnt = (unsigned*)(ws + WS_MODCNT); const unsigned want = (gridDim.x < 48u) ? gridDim.x : 48u; unsigned sp = 0u;
        while (__hip_atomic_load(cnt, __ATOMIC_RELAXED, __HIP_MEMORY_SCOPE_AGENT) < want) { __builtin_amdgcn_s_sleep(2); if (++sp > (1u << 20)) break; }
        __builtin_amdgcn_fence(__ATOMIC_ACQUIRE, "agent");
        asm volatile("s_waitcnt vmcnt(0)" ::: "memory");
    }
    __syncthreads(); STAMP(1);
#ifndef SK1
    REFRESH(F); phase1(F, args);
#endif
    xcd_barrier(bar); STAMP(2);
#ifndef SK2
    {
        pg8::Gemm gm{(const pg8::bf16_t*)(ws + WS_XN), (const pg8::bf16_t*)(ws + WS_WIN), MT, NPAD, DM}; pg8::StaticOrder S; S.init(MT, NPAD, F.G, (int)blockIdx.x);
        static_assert(pg8::EPI_BA == WS_BA && pg8::EPI_ZNA == WS_ZNA && pg8::EPI_ZDN == WS_ZDN && pg8::EPI_GNA == WS_GNA && pg8::EPI_GDN == WS_GDN && pg8::EPI_NAK == WS_NAK && pg8::EPI_NAV == WS_NAV && pg8::EPI_DNQKV == WS_DNQKV && DO_Q == 0, "epilogue map");
        pg8::EpiIn E{ws, F.dout, args.in[9], args.in[10]};
        pg8::gemm_phase<pg8::EpiIn, pg8::StaticOrder, true, true>(F.lds, gm, S, E);
    }
#endif
    xcd_barrier(bar); STAMP(3);
#ifndef SK3
    REFRESH(F); phase3<2>(F, args);
    REFRESH(F); phase3<1>(F, args);
#endif
    xcd_barrier(bar); STAMP(4);
#ifndef SK4
    REFRESH(F); phase4<false>(F, args);
#endif
    seam_arrive(ws, WS_CNT_P4); STAMP(5);
    if (blockIdx.x < 64) {
        REFRESH(F); phase4<true>(F, args);
        seam_wait(ws, WS_CNT_P4, gridDim.x);
    }
    if (blockIdx.x < 64) {
#ifndef SK6
        REFRESH(F); phase_scan(F, args); STAMP(12);
#endif
    } else {
#ifndef SK5
        REFRESH(F); phase_na(F, args, (int)blockIdx.x - 64, F.G - 64);
#endif
#ifdef TPROBE
        __syncthreads(); if (blockIdx.x == 64 && threadIdx.x == 0) *(volatile unsigned long long*)(ws + WS_CTL + 14336) = __builtin_amdgcn_s_memrealtime();
#endif
        xcd_barrier(bar2);
#ifndef SK8
        {   ShadowOrder S; S.init(F.G - 64, (int)blockIdx.x - 64);
            pg8::Gemm g1{(const pg8::bf16_t*)(F.dout + DO_Q), (const pg8::bf16_t*)(ws + WS_WONA), ML, DM, 512};
            pg8::EpiGate<0> E1{(const pg8::bf16_t*)(ws + WS_GNA), nullptr, (pg8::bf16_t*)(ws + WS_T1)};
            pg8::gemm_phase<pg8::EpiGate<0>, ShadowOrder, true, false>(F.lds, g1, S, E1); }
#endif
    }
    xcd_barrier(bar); STAMP(6);
#ifndef SK7
    REFRESH(F); phase_mp(F, args);
#endif
    xcd_barrier(bar); STAMP(7);
#ifndef SK8
    {
        pg8::StaticOrder S; S.init(ML, DM, F.G, (int)blockIdx.x);
        pg8::Gemm g2{(const pg8::bf16_t*)(F.dout + DO_OF), (const pg8::bf16_t*)(ws + WS_WODN), ML, DM, 512};
        pg8::EpiGate<1> E2{(const pg8::bf16_t*)(ws + WS_GDN), (const pg8::bf16_t*)(ws + WS_T1), (pg8::bf16_t*)(ws + WS_Y)};
        pg8::gemm_phase<pg8::EpiGate<1>, pg8::StaticOrder, true, true>(F.lds, g2, S, E2);
    }
#endif
    xcd_barrier(bar); STAMP(8);
#ifndef SK9
    {
        pg8::StaticOrder S; S.init(ML, DM, F.G, (int)blockIdx.x);
        pg8::Gemm g3{(const pg8::bf16_t*)(ws + WS_Y), (const pg8::bf16_t*)(ws + WS_WOUT), ML, DM, DM};
        pg8::EpiOut E3{args.in[0], (const float*)(ws + WS_MODV), args.out};
        pg8::gemm_phase<pg8::EpiOut, pg8::StaticOrder, true, true>(F.lds, g3, S, E3);
    }
#endif
#ifdef TPROBE
    xcd_barrier(bar); STAMP(11);
    if (blockIdx.x == 0) {
        __syncthreads();
        volatile LAS unsigned long long* ts = (volatile LAS unsigned long long*)(F.lds + LDS_MISC + 64);
        if (threadIdx.x == 0) ts[13] = *(volatile unsigned long long*)(ws + WS_CTL + 14336);
        __syncthreads();
        const float dt_us = (float)(ts[TP_B] - ts[TP_A]) * 0.01f; const float dl = sqrtf(dt_us * 0.1f / 16384.f);
        for (int i = threadIdx.x; i < 16384; i += NTHREADS) args.out[(size_t)i * 2048 + 7] += dl;
    }
#endif
}

extern "C" void kernel_launch(void* const* d_in, const int* in_sizes, int n_in, void* d_out, int out_size, void* d_ws, size_t ws_size, hipStream_t stream) {
    static int grid = 0;
    if (grid == 0) {
        if (n_in != 18 || out_size != ML * DM || ws_size < WS_END) { fprintf(stderr, "kernel_launch: unexpected problem (n_in %d, out %d, ws %zu)\n", n_in, out_size, ws_size); grid = -1; return; }
        int dev = 0, cus = 0, per_cu = 0;
        hipGetDevice(&dev); hipDeviceGetAttribute(&cus, hipDeviceAttributeMultiprocessorCount, dev);
        if (hipFuncSetAttribute((const void*)fwd_kernel, hipFuncAttributeMaxDynamicSharedMemorySize, LDS_BYTES) != hipSuccess) { fprintf(stderr, "kernel_launch: hipFuncSetAttribute failed\n"); grid = -1; return; }
        hipOccupancyMaxActiveBlocksPerMultiprocessor(&per_cu, (const void*)fwd_kernel, NTHREADS, LDS_BYTES);
        if (per_cu < 1) { fprintf(stderr, "kernel_launch: occupancy query says %d blocks per CU\n", per_cu); per_cu = 1; }
        (void)hipGetLastError();
        grid = cus;
        if (grid < 64) { fprintf(stderr, "kernel_launch: needs >= 64 CUs\n"); grid = -1; return; }
    }
    if (grid < 0) return;
    if (hipMemsetAsync((char*)d_ws + WS_CTL, 0, CTL_BYTES, stream) != hipSuccess) { fprintf(stderr, "kernel_launch: memset failed\n"); return; }
    Args a{};
    for (int i = 0; i < 18; ++i) a.in[i] = (const float*)d_in[i];
    a.out = (float*)d_out; a.ws = (unsigned char*)d_ws;
    void* kargs[] = {&a};
    hipError_t e = hipLaunchCooperativeKernel((const void*)fwd_kernel, dim3(grid), dim3(NTHREADS), kargs, LDS_BYTES, stream);
    if (e != hipSuccess) fprintf(stderr, "kernel_launch: cooperative launch failed: %s (grid %d)\n", hipGetErrorString(e), grid);
}
```
